# Optimizing an MI355X kernel written in HIP

```python
import math
import jax, jax.numpy as jnp
from jax import lax
import numpy as np

D_MODEL = 2048
BATCH = 8
SEQ = 2048
DEPTH = 1

D_MIX = D_MODEL
D_ATTN = D_MIX // 2
D_SSM = D_MIX - D_ATTN
HEAD_DIM = 128
N_HEADS = D_ATTN // HEAD_DIM
N_KV = 2
HEADS_PER_KV = N_HEADS // N_KV
D_KV = N_KV * HEAD_DIM
CMP_LEN = 32
CMP_STRIDE = 16
CMP_HIDDEN = HEAD_DIM
SEL_BLOCK = 64
N_SELECT = 16
WINDOW = 512
WIN_Q_BLOCK = 128
SEL_Q_BLOCK = 32
N_BUCKETS = 32
MAX_DISTANCE = 128
SSM_GROUP = 16
SSM_GROUPS = D_SSM // SSM_GROUP
SSM_STATE = 64
D_FF = 5632
EPS = 1e-6
N_IN = D_ATTN + 6 * D_KV + 3 * N_HEADS + D_SSM
NEG = -1e30

kernel_name = "hymba_nsa_s5_macaron_block"


def rmsnorm(x, g):
    xf = x.astype(jnp.float32)
    y = xf * lax.rsqrt(jnp.mean(xf * xf, axis=-1, keepdims=True) + EPS)
    return (y * g.astype(jnp.float32)).astype(x.dtype)


def swiglu(x, w1, w3, w2):
    return (jax.nn.silu(x @ w1) * (x @ w3)) @ w2


def t5_bucket(dist):
    n = jnp.maximum(dist, 0)
    max_exact = N_BUCKETS // 2
    nf = jnp.maximum(n, 1).astype(jnp.float32)
    large = max_exact + (jnp.log(nf / max_exact) / math.log(MAX_DISTANCE / max_exact)
                         * (N_BUCKETS - max_exact)).astype(jnp.int32)
    large = jnp.minimum(large, N_BUCKETS - 1)
    return jnp.where(n < max_exact, n, large)


def masked_softmax(s, mask):
    s = jnp.where(mask, s, NEG)
    m = jnp.max(s, axis=-1, keepdims=True)
    p = jnp.exp(s - m) * mask
    return p / jnp.maximum(jnp.sum(p, axis=-1, keepdims=True), 1e-30)


def compress_blocks(k, pe, w1, b1, w2):
    B, T, G, dh = k.shape
    nc = (T - CMP_LEN) // CMP_STRIDE + 1
    idx = jnp.arange(nc)[:, None] * CMP_STRIDE + jnp.arange(CMP_LEN)[None, :]
    blk = k[:, idx] + pe[None, None, :, None, :]
    blk = blk.transpose(0, 1, 3, 2, 4).reshape(B, nc, G, CMP_LEN * dh)
    return jax.nn.gelu(blk @ w1 + b1) @ w2


def nsa_mixer(q, kc, vc, ks, vs, kw, vw, gate_logits, rel_bias,
              pe_k, w1_k, b1_k, w2_k, pe_v, w1_v, b1_v, w2_v):
    B, T, _ = q.shape
    G, Hg, dh = N_KV, HEADS_PER_KV, HEAD_DIM
    q = q.reshape(B, T, G, Hg, dh) * (dh ** -0.5)
    kc, vc, ks, vs, kw, vw = [a.reshape(B, T, G, dh) for a in (kc, vc, ks, vs, kw, vw)]
    t = jnp.arange(T)
    table_g = rel_bias.reshape(N_BUCKETS, G, Hg)

    kcb = compress_blocks(kc, pe_k, w1_k, b1_k, w2_k)
    vcb = compress_blocks(vc, pe_v, w1_v, b1_v, w2_v)
    nc = kcb.shape[1]
    c_start = jnp.arange(nc) * CMP_STRIDE
    c_end = c_start + CMP_LEN - 1
    dist_c = t[:, None] - c_end[None, :]
    s_c = jnp.einsum('btghd,bcgd->bghtc', q, kcb).astype(jnp.float32)
    s_c = s_c + table_g[t5_bucket(dist_c)].transpose(2, 3, 0, 1).astype(jnp.float32)
    p_cmp = masked_softmax(s_c, dist_c >= 0)
    o_cmp = jnp.einsum('bghtc,bcgd->btghd', p_cmp.astype(vcb.dtype), vcb)

    ns = T // SEL_BLOCK
    n_sel = min(N_SELECT, ns)
    j_start = jnp.arange(ns) * SEL_BLOCK
    overlap = jnp.clip(jnp.minimum(c_start[:, None] + CMP_LEN, j_start[None, :] + SEL_BLOCK)
                       - jnp.maximum(c_start[:, None], j_start[None, :]), 0, None)
    overlap = overlap.astype(jnp.float32) / CMP_LEN
    imp = jnp.einsum('bghtc,cj->bgtj', p_cmp, overlap)
    cur = t // SEL_BLOCK
    jj = jnp.arange(ns)
    forced = (jj[None, :] == 0) | (jj[None, :] == cur[:, None]) | (jj[None, :] == cur[:, None] - 1)
    causal_blk = j_start[None, :] <= t[:, None]
    imp = jnp.where(forced, 1e6, jnp.where(causal_blk, imp, -1e9))
    _, sel_idx = lax.top_k(imp, n_sel)

    ks_b = ks.reshape(B, ns, SEL_BLOCK, G, dh).transpose(0, 3, 1, 2, 4)
    vs_b = vs.reshape(B, ns, SEL_BLOCK, G, dh).transpose(0, 3, 1, 2, 4)
    nq = T // SEL_Q_BLOCK
    q_ch = q.reshape(B, nq, SEL_Q_BLOCK, G, Hg, dh).transpose(1, 0, 2, 3, 4, 5)
    idx_ch = sel_idx.reshape(B, G, nq, SEL_Q_BLOCK, n_sel).transpose(2, 0, 1, 3, 4)
    t_ch = t.reshape(nq, SEL_Q_BLOCK)
    bi = jnp.arange(B)[:, None, None, None]
    gi = jnp.arange(G)[None, :, None, None]
    g_b = jnp.arange(G)[None, :, None, None, None]
    s_off = jnp.arange(SEL_BLOCK)

    def sel_block(args):
        qc, ic, tc = args
        kg = ks_b[bi, gi, ic]
        vg = vs_b[bi, gi, ic]
        s = jnp.einsum('bqghd,bgqnsd->bghqns', qc, kg).astype(jnp.float32)
        kpos = ic[..., None] * SEL_BLOCK + s_off
        dist = tc[None, None, :, None, None] - kpos
        bias = table_g[t5_bucket(dist), g_b].transpose(0, 1, 5, 2, 3, 4)
        s = (s + bias.astype(jnp.float32)).reshape(B, G, Hg, SEL_Q_BLOCK, n_sel * SEL_BLOCK)
        mask = (dist >= 0).reshape(B, G, 1, SEL_Q_BLOCK, n_sel * SEL_BLOCK)
        p = masked_softmax(s, mask).reshape(B, G, Hg, SEL_Q_BLOCK, n_sel, SEL_BLOCK)
        return jnp.einsum('bghqns,bgqnsd->bqghd', p.astype(vg.dtype), vg)

    o_sel = lax.map(sel_block, (q_ch, idx_ch, t_ch))
    o_sel = o_sel.transpose(1, 0, 2, 3, 4, 5).reshape(B, T, G, Hg, dh)

    nb = T // WIN_Q_BLOCK
    span = WIN_Q_BLOCK + WINDOW
    kw_pad = jnp.pad(kw, ((0, 0), (WINDOW, 0), (0, 0), (0, 0)))
    vw_pad = jnp.pad(vw, ((0, 0), (WINDOW, 0), (0, 0), (0, 0)))
    kidx = jnp.arange(nb)[:, None] * WIN_Q_BLOCK + jnp.arange(span)[None, :]
    kwb = kw_pad[:, kidx]
    vwb = vw_pad[:, kidx]
    qb = q.reshape(B, nb, WIN_Q_BLOCK, G, Hg, dh)
    s_w = jnp.einsum('bnqghd,bnkgd->bnghqk', qb, kwb).astype(jnp.float32)
    qpos = jnp.arange(nb)[:, None] * WIN_Q_BLOCK + jnp.arange(WIN_Q_BLOCK)[None, :]
    kpos = kidx - WINDOW
    dist_w = qpos[:, :, None] - kpos[:, None, :]
    mask_w = (dist_w >= 0) & (dist_w < WINDOW) & (kpos[:, None, :] >= 0)
    bias_w = table_g[t5_bucket(dist_w)].transpose(0, 3, 4, 1, 2)
    s_w = s_w + bias_w[None].astype(jnp.float32)
    p_w = masked_softmax(s_w, mask_w[:, None, None])
    o_win = jnp.einsum('bnghqk,bnkgd->bnqghd', p_w.astype(vwb.dtype), vwb).reshape(B, T, G, Hg, dh)

    g = jax.nn.sigmoid(gate_logits.astype(jnp.float32)).reshape(B, T, G, Hg, 3).astype(q.dtype)
    o = g[..., 0:1] * o_cmp + g[..., 1:2] * o_sel + g[..., 2:3] * o_win
    return o.reshape(B, T, D_ATTN)


def s5_mixer(u, lam_re, lam_im, log_step, b_re, b_im, c_re, c_im, d_skip, w_glu, b_glu):
    B, T, _ = u.shape
    f32 = jnp.float32
    uf = u.astype(f32).reshape(B, T, SSM_GROUPS, SSM_GROUP)
    step = jnp.exp(log_step.astype(f32))[:, None]
    lre, lim = lam_re.astype(f32), lam_im.astype(f32)
    mag = jnp.exp(lre * step)
    ab_re, ab_im = mag * jnp.cos(lim * step), mag * jnp.sin(lim * step)
    nr, ni = ab_re - 1.0, ab_im
    den = lre * lre + lim * lim
    f_re, f_im = (nr * lre + ni * lim) / den, (ni * lre - nr * lim) / den
    br, bim = b_re.astype(f32), b_im.astype(f32)
    bb_re = f_re[..., None] * br - f_im[..., None] * bim
    bb_im = f_re[..., None] * bim + f_im[..., None] * br
    bu_re = jnp.einsum('gph,btgh->btgp', bb_re, uf)
    bu_im = jnp.einsum('gph,btgh->btgp', bb_im, uf)
    a_re = jnp.broadcast_to(ab_re, (1, T, SSM_GROUPS, SSM_STATE))
    a_im = jnp.broadcast_to(ab_im, (1, T, SSM_GROUPS, SSM_STATE))

    def combine(e1, e2):
        a1r, a1i, b1r, b1i = e1
        a2r, a2i, b2r, b2i = e2
        return (a2r * a1r - a2i * a1i, a2r * a1i + a2i * a1r,
                a2r * b1r - a2i * b1i + b2r, a2r * b1i + a2i * b1r + b2i)

    _, _, xr, xi = lax.associative_scan(combine, (a_re, a_im, bu_re, bu_im), axis=1)
    y = (jnp.einsum('ghp,btgp->btgh', c_re.astype(f32), xr)
         - jnp.einsum('ghp,btgp->btgh', c_im.astype(f32), xi)
         + d_skip.astype(f32).reshape(SSM_GROUPS, SSM_GROUP) * uf)
    y = y.reshape(B, T, D_SSM).astype(u.dtype)
    h = jax.nn.gelu(y)
    return h * jax.nn.sigmoid(h @ w_glu + b_glu)


def setup_inputs(seed: int = 0) -> dict:
    key = jax.random.key(seed)
    ks = iter(jax.random.split(key, 40))
    f32 = jnp.float32

    def nrm(shape, scale):
        return jax.random.normal(next(ks), shape, f32) * scale

    def gain(shape):
        return 1.0 + nrm(shape, 0.02)

    L = DEPTH
    P = SSM_STATE
    lam_im0 = math.pi * jnp.arange(P, dtype=f32)
    return {
        "x": nrm((BATCH, SEQ, D_MODEL), 1.0),
        "ffn1_norm": gain((L, D_MODEL)),
        "ffn1_w1": nrm((L, D_MODEL, D_FF), D_MODEL ** -0.5),
        "ffn1_w3": nrm((L, D_MODEL, D_FF), D_MODEL ** -0.5),
        "ffn1_w2": nrm((L, D_FF, D_MODEL), D_FF ** -0.5),
        "mix_norm": gain((L, D_MODEL)),
        "w_in": nrm((L, D_MODEL, N_IN), D_MODEL ** -0.5),
        "cmp_pe_k": nrm((L, CMP_LEN, HEAD_DIM), 0.1),
        "cmp_w1_k": nrm((L, CMP_LEN * HEAD_DIM, CMP_HIDDEN), (CMP_LEN * HEAD_DIM) ** -0.5),
        "cmp_b1_k": nrm((L, CMP_HIDDEN), 0.01),
        "cmp_w2_k": nrm((L, CMP_HIDDEN, HEAD_DIM), CMP_HIDDEN ** -0.5),
        "cmp_pe_v": nrm((L, CMP_LEN, HEAD_DIM), 0.1),
        "cmp_w1_v": nrm((L, CMP_LEN * HEAD_DIM, CMP_HIDDEN), (CMP_LEN * HEAD_DIM) ** -0.5),
        "cmp_b1_v": nrm((L, CMP_HIDDEN), 0.01),
        "cmp_w2_v": nrm((L, CMP_HIDDEN, HEAD_DIM), CMP_HIDDEN ** -0.5),
        "rel_bias": nrm((N_BUCKETS, N_HEADS), 0.5),
        "ssm_lam_re": -0.5 + nrm((L, SSM_GROUPS, P), 0.01),
        "ssm_lam_im": lam_im0[None, None, :] + nrm((L, SSM_GROUPS, P), 0.01),
        "ssm_log_step": jax.random.uniform(next(ks), (L, SSM_GROUPS), f32,
                                           math.log(1e-3), math.log(1e-1)),
        "ssm_b_re": nrm((L, SSM_GROUPS, P, SSM_GROUP), (2.0 * SSM_GROUP) ** -0.5),
        "ssm_b_im": nrm((L, SSM_GROUPS, P, SSM_GROUP), (2.0 * SSM_GROUP) ** -0.5),
        "ssm_c_re": nrm((L, SSM_GROUPS, SSM_GROUP, P), (2.0 * P) ** -0.5),
        "ssm_c_im": nrm((L, SSM_GROUPS, SSM_GROUP, P), (2.0 * P) ** -0.5),
        "ssm_d": nrm((L, D_SSM), 1.0),
        "glu_w": nrm((L, D_SSM, D_SSM), D_SSM ** -0.5),
        "glu_b": nrm((L, D_SSM), 0.01),
        "w_out": nrm((L, D_MIX, D_MODEL), D_MIX ** -0.5),
        "ffn2_norm": gain((L, D_MODEL)),
        "ffn2_w1": nrm((L, D_MODEL, D_FF), D_MODEL ** -0.5),
        "ffn2_w3": nrm((L, D_MODEL, D_FF), D_MODEL ** -0.5),
        "ffn2_w2": nrm((L, D_FF, D_MODEL), D_FF ** -0.5),
        "final_norm": gain((D_MODEL,)),
    }


def reference(x, ffn1_norm, ffn1_w1, ffn1_w3, ffn1_w2, mix_norm, w_in,
              cmp_pe_k, cmp_w1_k, cmp_b1_k, cmp_w2_k, cmp_pe_v, cmp_w1_v, cmp_b1_v, cmp_w2_v,
              rel_bias, ssm_lam_re, ssm_lam_im, ssm_log_step, ssm_b_re, ssm_b_im,
              ssm_c_re, ssm_c_im, ssm_d, glu_w, glu_b, w_out,
              ffn2_norm, ffn2_w1, ffn2_w3, ffn2_w2, final_norm):
    splits = np.cumsum([D_ATTN, D_KV, D_KV, D_KV, D_KV, D_KV, D_KV, 3 * N_HEADS])
    h = x
    for l in range(DEPTH):
        h = h + 0.5 * swiglu(rmsnorm(h, ffn1_norm[l]), ffn1_w1[l], ffn1_w3[l], ffn1_w2[l])
        proj = rmsnorm(h, mix_norm[l]) @ w_in[l]
        q, kc, vc, ksl, vsl, kw, vw, gates, u_ssm = jnp.split(proj, splits, axis=-1)
        a = nsa_mixer(q, kc, vc, ksl, vsl, kw, vw, gates, rel_bias,
                      cmp_pe_k[l], cmp_w1_k[l], cmp_b1_k[l], cmp_w2_k[l],
                      cmp_pe_v[l], cmp_w1_v[l], cmp_b1_v[l], cmp_w2_v[l])
        s = s5_mixer(u_ssm, ssm_lam_re[l], ssm_lam_im[l], ssm_log_step[l], ssm_b_re[l], ssm_b_im[l],
                     ssm_c_re[l], ssm_c_im[l], ssm_d[l], glu_w[l], glu_b[l])
        h = h + jnp.concatenate([a, s], axis=-1) @ w_out[l]
        h = h + 0.5 * swiglu(rmsnorm(h, ffn2_norm[l]), ffn2_w1[l], ffn2_w3[l], ffn2_w2[l])
    return rmsnorm(h, final_norm)
```

```cpp
#include <hip/hip_runtime.h>
#include <hip/hip_cooperative_groups.h>
#include <cstdio>
namespace cg = cooperative_groups;

#define DI __device__ __forceinline__
#define LAS __attribute__((address_space(3)))
#define GAS __attribute__((address_space(1)))
typedef unsigned short bf16_t;
typedef short bf16x8 __attribute__((ext_vector_type(8)));
typedef short s16x4 __attribute__((ext_vector_type(4)));
typedef float f32x4 __attribute__((ext_vector_type(4)));
typedef float f32x16 __attribute__((ext_vector_type(16)));
typedef unsigned u32x4 __attribute__((ext_vector_type(4)));
typedef unsigned u32x2 __attribute__((ext_vector_type(2)));
typedef __bf16 bf16x2_t __attribute__((ext_vector_type(2)));
typedef float f32x2_t __attribute__((ext_vector_type(2)));

constexpr int MTOK = 16384, DM = 2048, DFF = 5632, TT = 2048;
constexpr int NPROJ = 3840;
constexpr int C_KC = 1024, C_VC = 1280, C_KS = 1536, C_VS = 1792, C_KW = 2048, C_VW = 2304, C_GATE = 2560, C_SSM = 2584;
constexpr float EPSN = 1e-6f;
constexpr float NEGF = -1e30f;

constexpr size_t WS_W13A = 0;
constexpr size_t WS_W2A = WS_W13A + 46137344;
constexpr size_t WS_W13B = WS_W2A + 23068672;
constexpr size_t WS_W2B = WS_W13B + 46137344;
constexpr size_t WS_WIN = WS_W2B + 23068672;
constexpr size_t WS_WOUT = WS_WIN + 15728640;
constexpr size_t WS_GLUW = WS_WOUT + 8388608;
constexpr size_t WS_CW1K = WS_GLUW + 2097152;
constexpr size_t WS_CW1V = WS_CW1K + 1048576;
constexpr size_t WS_CW2K = WS_CW1V + 1048576;
constexpr size_t WS_CW2V = WS_CW2K + 32768;
constexpr size_t WS_SMALL = WS_CW2V + 32768;
constexpr size_t WS_KCB = WS_SMALL + 1048576;
constexpr size_t WS_VCBT = WS_KCB + 524288;
constexpr size_t WS_S5END = WS_VCBT + 524288;
constexpr size_t WS_VTS = WS_S5END + 8388608;
constexpr size_t WS_VTW = WS_VTS + 8388608;
constexpr size_t WS_XN = WS_VTW + 8388608;
constexpr size_t WS_H = WS_XN + 67108864;
constexpr size_t WS_PROJ = WS_H;
constexpr size_t WS_AS = WS_H + 125829120;
constexpr size_t WS_HG = WS_XN;
constexpr size_t WS_OUTS = WS_H + 184549376 + 8388608;
constexpr size_t WS_END = WS_OUTS + 33554432;
constexpr int SM_CB1 = 0;
constexpr int SM_AB = 256;
constexpr int SM_BB = 256 + 16384;
constexpr int SM_CTR = 256 + 16384 + 131072;
constexpr int SM_CBP = SM_CTR + 64;
constexpr int SM_SS = SM_CBP + 32768;
constexpr int SM_BAR = 213504;

constexpr int LDS_BYTES = 151552;
constexpr int L_CUR = 149776;
constexpr int NPH = 13;

struct Params { const float* in[32]; float* out; unsigned char* ws; int ph_lo, ph_hi; };

DI unsigned pk2(float a, float b) { f32x2_t v = {a, b}; return __builtin_bit_cast(unsigned, __builtin_convertvector(v, bf16x2_t)); }
DI float bf2f(unsigned x) { return __uint_as_float(x << 16); }
DI float bflo(unsigned w) { return __uint_as_float(w << 16); }
DI float bfhi(unsigned w) { return __uint_as_float(w & 0xffff0000u); }
DI float sigmoidf_(float x) { return __builtin_amdgcn_rcpf(1.0f + __builtin_amdgcn_exp2f(-1.4426950408889634f * x)); }
DI float gelu_tanh(float v) { const float z = 0.7978845608028654f * (v + 0.044715f * v * v * v); const float th = 1.0f - 2.0f * __builtin_amdgcn_rcpf(__builtin_amdgcn_exp2f(2.8853900817779268f * z) + 1.0f); return 0.5f * v * (1.0f + th); }

namespace pg8 {
constexpr int BM = 256, BK = 64, HALF = 128, HTB = HALF * BK * 2, STAGE_BYTES = 8 * HTB, NXCD = 8, WGM = 8;
__host__ __device__ __forceinline__ int lds_byte(int r, int c) { const int st = (r >> 4) * 2 + (c >> 5), rr = r & 15, cc = c & 31, ob = rr * 64 + cc * 2; return st * 1024 + (ob ^ (((ob >> 9) & 1) << 5)); }
__host__ __device__ __forceinline__ void stage_rc(int b, int& R, int& C) { const int st = b / 1024, sb = b % 1024, swz = sb ^ (((sb >> 9) & 1) << 5); R = (st >> 1) * 16 + swz / 64; C = (st & 1) * 32 + (swz % 64) / 2; }
__host__ __device__ __forceinline__ int perm32(int rho) { const int n = rho >> 4, i = rho & 15; return 8 * (i >> 2) + 4 * n + (i & 3); }
struct Unit { int pm, pn; };
struct Gemm { const bf16_t* A; const bf16_t* Bt; int M, N, K; };
struct StaticOrder {
    int nM, nN, nwg, G, c;
    __host__ __device__ void init(int M, int N, int G_, int c_) { nM = M / BM; nN = N / BM; nwg = nM * nN; G = G_; c = c_; }
    __host__ __device__ bool next(int i, Unit& u) const {
        const long L = (long)i * G + c; if (L >= nwg) return false;
        int wgid = (int)L; { const int q = nwg / NXCD, r = nwg % NXCD, xcd = wgid % NXCD, off = wgid / NXCD; wgid = (xcd < r ? xcd * (q + 1) : r * (q + 1) + (xcd - r) * q) + off; }
        const int nig = WGM * nN, gid = wgid / nig, fm = gid * WGM, gsz = (nM - fm) < WGM ? (nM - fm) : WGM;
        u.pm = fm + ((wgid % nig) % gsz); u.pn = (wgid % nig) / gsz; return true;
    }
    __device__ __forceinline__ void a_ready(const Unit&) const {}
    __device__ __forceinline__ void done(const Unit&) const {}
};

template <class Epi, class Sched>
__device__ __forceinline__ void gemm_phase(LAS unsigned char* lds, const Gemm g, const Sched& S, const Epi& E) {
    const int tid = threadIdx.x, wid = __builtin_amdgcn_readfirstlane(tid >> 6), lane = tid & 63, wr = wid >> 2, wc = wid & 3, fr = lane & 15, fq = lane >> 4;
    const int K = g.K, nt = K / BK;
    unsigned voffA[2], voffB[2];
#pragma unroll
    for (int i = 0; i < 2; ++i) { int R, C; stage_rc(tid * 16 + i * 8192, R, C); const int Rb = Epi::PERM ? ((R & ~31) + perm32(R & 31)) : R;
        voffA[i] = (unsigned)(R * K + C) * 2u; voffB[i] = (unsigned)(Rb * K + C) * 2u; }
    const size_t kstep = (size_t)(BK * 2);
    const size_t hstep = (size_t)HALF * K * 2;
    const size_t tstep = 2 * hstep;
    const unsigned ldsw = (unsigned)wid * 1024u;
    const int aoff = lds_byte(wr * 64 + fr, fq * 8), boff = lds_byte(wc * 32 + fr, fq * 8);
#define PG8_SA(b, h) (((b) * 2 + (h)) * HTB)
#define PG8_SB(b, h) ((4 + (b) * 2 + (h)) * HTB)
#define PG8_STAGE(bufoff, gbase, voff) do { _Pragma("unroll") for (int _i = 0; _i < 2; ++_i) \
        __builtin_amdgcn_global_load_lds((const unsigned*)((const char*)(gbase) + (voff)[_i]), (LAS unsigned*)(lds + (bufoff) + ldsw + _i * 8192), 16, 0, 0); } while (0)
#define PG8_LDA(dst, b, h) do { _Pragma("unroll") for (int m = 0; m < 4; ++m) _Pragma("unroll") for (int k = 0; k < 2; ++k) dst[m][k] = *(const LAS bf16x8*)(lds + PG8_SA(b, h) + aoff + m * 2048 + k * 1024); } while (0)
#define PG8_LDB(dst, b, h) do { _Pragma("unroll") for (int n = 0; n < 2; ++n) _Pragma("unroll") for (int k = 0; k < 2; ++k) dst[n][k] = *(const LAS bf16x8*)(lds + PG8_SB(b, h) + boff + n * 2048 + k * 1024); } while (0)
#define PG8_MMA(ai, bj, At, Bt) do { __builtin_amdgcn_s_setprio(1); _Pragma("unroll") for (int m = 0; m < 4; ++m) _Pragma("unroll") for (int n = 0; n < 2; ++n) _Pragma("unroll") for (int k = 0; k < 2; ++k) \
        acc[ai][bj][m][n] = __builtin_amdgcn_mfma_f32_16x16x32_bf16(Bt[n][k], At[m][k], acc[ai][bj][m][n], 0, 0, 0); __builtin_amdgcn_s_setprio(0); } while (0)
#define PG8_WAIT_V(n) asm volatile("s_waitcnt vmcnt(" #n ")" ::: "memory")
#define PG8_WAIT_L(n) asm volatile("s_waitcnt lgkmcnt(" #n ")" ::: "memory")
#define PG8_BAR __builtin_amdgcn_s_barrier()
#define PG8_SCHED __builtin_amdgcn_sched_barrier(0)
    Unit cur, nxt; int ui = 0;
    if (!S.next(0, cur)) return;
    f32x4 acc[2][2][4][2];
#pragma unroll
    for (int a = 0; a < 2; ++a)
#pragma unroll
        for (int b = 0; b < 2; ++b)
#pragma unroll
            for (int m = 0; m < 4; ++m)
#pragma unroll
                for (int n = 0; n < 2; ++n) acc[a][b][m][n] = (f32x4){0.f, 0.f, 0.f, 0.f};
    bf16x8 At[4][2], B0[2][2], B1[2][2];
    const char* cA = (const char*)g.A + (size_t)cur.pm * tstep; const char* cB = (const char*)g.Bt + (size_t)cur.pn * tstep;
    S.a_ready(cur);
    PG8_STAGE(PG8_SB(0, 0), cB, voffB); PG8_STAGE(PG8_SA(0, 0), cA, voffA); PG8_STAGE(PG8_SB(0, 1), cB + hstep, voffB); PG8_STAGE(PG8_SA(0, 1), cA + hstep, voffA);
    if (wr == 1) PG8_BAR;
    PG8_WAIT_V(4); PG8_BAR;
    PG8_STAGE(PG8_SB(1, 0), cB + kstep, voffB); PG8_STAGE(PG8_SA(1, 0), cA + kstep, voffA); PG8_STAGE(PG8_SB(1, 1), cB + hstep + kstep, voffB);
    PG8_WAIT_V(6); PG8_BAR;
    for (;;) {
        const bool has_next = S.next(ui + 1, nxt);
        const char* nA = has_next ? (const char*)g.A + (size_t)nxt.pm * tstep : cA; const char* nB = has_next ? (const char*)g.Bt + (size_t)nxt.pn * tstep : cB;
        for (int t = 0; t < nt; t += 2) {
            const bool last = (t == nt - 2);
            const char* a1 = cA + (size_t)(t + 1) * kstep;
            const char* a2 = last ? nA : cA + (size_t)(t + 2) * kstep; const char* b2 = last ? nB : cB + (size_t)(t + 2) * kstep;
            const char* a3 = a2 + kstep; const char* b3 = b2 + kstep;
            if (last && has_next) S.a_ready(nxt);
            PG8_LDB(B0, 0, 0); PG8_SCHED; PG8_LDA(At, 0, 0); PG8_STAGE(PG8_SA(1, 1), a1 + hstep, voffA);
            PG8_WAIT_L(8); PG8_BAR; PG8_WAIT_L(0); PG8_MMA(0, 0, At, B0); PG8_BAR; PG8_SCHED;
            PG8_LDB(B1, 0, 1); PG8_STAGE(PG8_SB(0, 0), b2, voffB);
            PG8_BAR; PG8_WAIT_L(0); PG8_MMA(0, 1, At, B1); PG8_BAR;
            PG8_LDA(At, 0, 1); PG8_STAGE(PG8_SA(0, 0), a2, voffA);
            PG8_BAR; PG8_WAIT_L(0); PG8_MMA(1, 0, At, B0); PG8_BAR; PG8_SCHED;
            PG8_STAGE(PG8_SB(0, 1), b2 + hstep, voffB);
            PG8_WAIT_V(6); PG8_BAR; PG8_MMA(1, 1, At, B1); PG8_BAR;
            PG8_LDB(B0, 1, 0); PG8_SCHED; PG8_LDA(At, 1, 0); PG8_STAGE(PG8_SA(0, 1), a2 + hstep, voffA);
            PG8_WAIT_L(8); PG8_BAR; PG8_WAIT_L(0); PG8_MMA(0, 0, At, B0); PG8_BAR; PG8_SCHED;
            PG8_LDB(B1, 1, 1); PG8_STAGE(PG8_SB(1, 0), b3, voffB);
            PG8_BAR; PG8_WAIT_L(0); PG8_MMA(0, 1, At, B1); PG8_BAR;
            PG8_LDA(At, 1, 1); PG8_STAGE(PG8_SA(1, 0), a3, voffA);
            PG8_BAR; PG8_WAIT_L(0); PG8_MMA(1, 0, At, B0); PG8_BAR; PG8_SCHED;
            PG8_STAGE(PG8_SB(1, 1), b3 + hstep, voffB);
            PG8_WAIT_V(6); PG8_BAR; PG8_MMA(1, 1, At, B1); PG8_BAR;
        }
        E(acc, cur, wr, wc, fr, fq, ui, lds); S.done(cur);
        if (!has_next) break;
#pragma unroll
        for (int a = 0; a < 2; ++a)
#pragma unroll
            for (int b = 0; b < 2; ++b)
#pragma unroll
                for (int m = 0; m < 4; ++m)
#pragma unroll
                    for (int n = 0; n < 2; ++n) acc[a][b][m][n] = (f32x4){0.f, 0.f, 0.f, 0.f};
        cur = nxt; cA = nA; cB = nB; ++ui;
    }
    PG8_WAIT_V(0);
    if (wr == 0) PG8_BAR;
    PG8_BAR;
#undef PG8_SA
#undef PG8_SB
#undef PG8_STAGE
#undef PG8_LDA
#undef PG8_LDB
#undef PG8_MMA
#undef PG8_WAIT_V
#undef PG8_WAIT_L
#undef PG8_BAR
#undef PG8_SCHED
}
}

struct EpiSwiGLU {
    static constexpr bool PERM = true;
    bf16_t* H; const float* ss;
    DI void operator()(const f32x4 (&acc)[2][2][4][2], const pg8::Unit& u, int wr, int wc, int fr, int fq, int ui, LAS unsigned char* lds) const {
        const int row0 = u.pm * 256 + wr * 64 + fr, col0 = u.pn * 128 + wc * 32 + 8 * fq;
#pragma unroll
        for (int ai = 0; ai < 2; ++ai)
#pragma unroll
            for (int m = 0; m < 4; ++m) {
                const float rs = ss ? ((const LAS float*)(lds + 131072))[ui * 256 + wr * 64 + fr + ai * 128 + m * 16] : 1.0f;
                float v[8];
#pragma unroll
                for (int n = 0; n < 2; ++n)
#pragma unroll
                    for (int j = 0; j < 4; ++j) { const float gt = acc[ai][0][m][n][j] * rs, up = acc[ai][1][m][n][j] * rs; v[n * 4 + j] = gt * up * __builtin_amdgcn_rcpf(1.0f + __builtin_amdgcn_exp2f(-1.4426950408889634f * gt)); }
                u32x4 w; w.x = pk2(v[0], v[1]); w.y = pk2(v[2], v[3]); w.z = pk2(v[4], v[5]); w.w = pk2(v[6], v[7]);
                *(u32x4*)(H + (size_t)(row0 + ai * 128 + m * 16) * DFF + col0) = w;
            }
    }
};
template <int MODE> struct EpiResid {
    static constexpr bool PERM = true;
    const float* basef; const bf16_t* baseb; float* outf; bf16_t* hb; float* ss; float scale;
    DI void operator()(const f32x4 (&acc)[2][2][4][2], const pg8::Unit& u, int wr, int wc, int fr, int fq, int ui, LAS unsigned char* lds) const {
        const int row0 = u.pm * 256 + wr * 64 + fr, col0 = u.pn * 256 + wc * 32 + 8 * fq;
#pragma unroll
        for (int ai = 0; ai < 2; ++ai) {
            f32x4 bf0[4][2], bf1[4][2]; u32x4 bw[4][2];
#pragma unroll
            for (int m = 0; m < 4; ++m)
#pragma unroll
                for (int bj = 0; bj < 2; ++bj) { const size_t off = (size_t)(row0 + ai * 128 + m * 16) * DM + col0 + bj * 128;
                    if (MODE == 0) { bf0[m][bj] = *(const f32x4*)(basef + off); bf1[m][bj] = *(const f32x4*)(basef + off + 4); }
                    else bw[m][bj] = *(const u32x4*)(baseb + off); }
            __builtin_amdgcn_sched_barrier(0);
#pragma unroll
            for (int m = 0; m < 4; ++m) { const int row = row0 + ai * 128 + m * 16; const size_t off = (size_t)row * DM + col0; float rsum = 0.f;
#pragma unroll
                for (int bj = 0; bj < 2; ++bj) {
                    f32x4 b0, b1;
                    if (MODE == 0) { b0 = bf0[m][bj]; b1 = bf1[m][bj]; }
                    else { const u32x4 w = bw[m][bj]; b0 = (f32x4){bflo(w.x), bfhi(w.x), bflo(w.y), bfhi(w.y)}; b1 = (f32x4){bflo(w.z), bfhi(w.z), bflo(w.w), bfhi(w.w)}; }
                    const f32x4 v0 = b0 + acc[ai][bj][m][0] * scale, v1 = b1 + acc[ai][bj][m][1] * scale;
                    if (MODE == 2) { *(f32x4*)(outf + off + bj * 128) = v0; *(f32x4*)(outf + off + bj * 128 + 4) = v1; }
                    else { rsum += (v0[0] * v0[0] + v0[1] * v0[1]) + (v0[2] * v0[2] + v0[3] * v0[3]) + (v1[0] * v1[0] + v1[1] * v1[1]) + (v1[2] * v1[2] + v1[3] * v1[3]);
                        u32x4 w; w.x = pk2(v0[0], v0[1]); w.y = pk2(v0[2], v0[3]); w.z = pk2(v1[0], v1[1]); w.w = pk2(v1[2], v1[3]);
                        *(u32x4*)(hb + off + bj * 128) = w; } }
                if (MODE != 2) { rsum += __shfl_xor(rsum, 16); rsum += __shfl_xor(rsum, 32); if (fq == 0) atomicAdd(ss + row, rsum); } }
        }
    }
};
struct EpiProj {
    static constexpr bool PERM = true;
    bf16_t* O; const float* ss; bf16_t* vts; bf16_t* vtw;
    DI void operator()(const f32x4 (&acc)[2][2][4][2], const pg8::Unit& u, int wr, int wc, int fr, int fq, int ui, LAS unsigned char* lds) const {
        const int row0 = u.pm * 256 + wr * 64 + fr, col0 = u.pn * 256 + wc * 32 + 8 * fq;
        const bool tr = (u.pn == 7) || (u.pn == 9);
#pragma unroll
        for (int ai = 0; ai < 2; ++ai)
#pragma unroll
            for (int m = 0; m < 4; ++m) { const int row = row0 + ai * 128 + m * 16; bf16_t* rowp = O + (size_t)row * NPROJ + col0;
                const float rs = ((const LAS float*)(lds + 131072))[ui * 256 + wr * 64 + fr + ai * 128 + m * 16];
#pragma unroll
                for (int bj = 0; bj < 2; ++bj) { const f32x4 v0 = acc[ai][bj][m][0] * rs, v1 = acc[ai][bj][m][1] * rs;
                    u32x4 w; w.x = pk2(v0[0], v0[1]); w.y = pk2(v0[2], v0[3]); w.z = pk2(v1[0], v1[1]); w.w = pk2(v1[2], v1[3]);
                    if (!tr) *(u32x4*)(rowp + bj * 128) = w;
                    else { bf16_t* vt = (u.pn == 7 ? vts : vtw) + ((size_t)((row >> 11) * 2 + bj) * 128 + wc * 32 + 8 * fq) * TT + (row & 2047);
                        vt[0 * TT] = (bf16_t)(w.x & 0xffffu); vt[1 * TT] = (bf16_t)(w.x >> 16); vt[2 * TT] = (bf16_t)(w.y & 0xffffu); vt[3 * TT] = (bf16_t)(w.y >> 16);
                        vt[4 * TT] = (bf16_t)(w.z & 0xffffu); vt[5 * TT] = (bf16_t)(w.z >> 16); vt[6 * TT] = (bf16_t)(w.w & 0xffffu); vt[7 * TT] = (bf16_t)(w.w >> 16); } } }
    }
};
struct EpiGLU {
    static constexpr bool PERM = true;
    const bf16_t* HG; const float* bias; bf16_t* AS;
    DI void operator()(const f32x4 (&acc)[2][2][4][2], const pg8::Unit& u, int wr, int wc, int fr, int fq, int ui, LAS unsigned char* lds) const {
        const int row0 = u.pm * 256 + wr * 64 + fr, col0 = u.pn * 256 + wc * 32 + 8 * fq;
        f32x4 bs[2][2];
#pragma unroll
        for (int bj = 0; bj < 2; ++bj) { bs[bj][0] = *(const f32x4*)(bias + col0 + bj * 128); bs[bj][1] = *(const f32x4*)(bias + col0 + bj * 128 + 4); }
#pragma unroll
        for (int ai = 0; ai < 2; ++ai) {
            u32x4 hw[4][2];
#pragma unroll
            for (int m = 0; m < 4; ++m)
#pragma unroll
                for (int bj = 0; bj < 2; ++bj) hw[m][bj] = *(const u32x4*)(HG + (size_t)(row0 + ai * 128 + m * 16) * 1024 + col0 + bj * 128);
            __builtin_amdgcn_sched_barrier(0);
#pragma unroll
            for (int m = 0; m < 4; ++m) { const int row = row0 + ai * 128 + m * 16;
#pragma unroll
                for (int bj = 0; bj < 2; ++bj) { const int col = col0 + bj * 128; const u32x4 h = hw[m][bj];
                    const f32x4 v0 = acc[ai][bj][m][0] + bs[bj][0], v1 = acc[ai][bj][m][1] + bs[bj][1];
                    u32x4 w;
                    w.x = pk2(bflo(h.x) * sigmoidf_(v0[0]), bfhi(h.x) * sigmoidf_(v0[1]));
                    w.y = pk2(bflo(h.y) * sigmoidf_(v0[2]), bfhi(h.y) * sigmoidf_(v0[3]));
                    w.z = pk2(bflo(h.z) * sigmoidf_(v1[0]), bfhi(h.z) * sigmoidf_(v1[1]));
                    w.w = pk2(bflo(h.w) * sigmoidf_(v1[2]), bfhi(h.w) * sigmoidf_(v1[3]));
                    *(u32x4*)(AS + (size_t)row * DM + 1024 + col) = w; } }
        }
    }
};

DI void tconv(const float* __restrict__ src, int K, int N, int Npad, bf16_t* __restrict__ dst, int mode, float* tile, const float* __restrict__ gk = nullptr) {
    const int tid = threadIdx.x, ntk = K >> 6, ntn = Npad >> 7, ntile = ntk * ntn;
    f32x4 v[4];
    float gv[4];
#define TC_LOAD(tt) do { const int tk_ = (tt) % ntk, tn_ = (tt) / ntk; \
        _Pragma("unroll") for (int e = 0; e < 4; ++e) { const int i = tid + 512 * e, r = i >> 5, n = tn_ * 128 + (i & 31) * 4, nn = n < N ? n : N - 4; \
            v[e] = *(const f32x4*)(src + (size_t)(tk_ * 64 + r) * N + nn); gv[e] = gk ? gk[tk_ * 64 + r] : 1.0f; } } while (0)
    int t = blockIdx.x;
    if (t < ntile) TC_LOAD(t);
    for (; t < ntile; t += gridDim.x) {
#pragma unroll
        for (int e = 0; e < 4; ++e) { const int i = tid + 512 * e, r = i >> 5, c = (i & 31) * 4; const bool ok = (t / ntk) * 128 + c < N;
            const f32x4 x = ok ? v[e] * gv[e] : (f32x4){0.f, 0.f, 0.f, 0.f};
            tile[r * 129 + c] = x[0]; tile[r * 129 + c + 1] = x[1]; tile[r * 129 + c + 2] = x[2]; tile[r * 129 + c + 3] = x[3]; }
        __syncthreads();
        const int tk = t % ntk, tn = t / ntk;
        if (t + (int)gridDim.x < ntile) TC_LOAD(t + (int)gridDim.x);
        { const int nl = tid >> 2, kg = tid & 3, n = tn * 128 + nl;
          float x[16];
#pragma unroll
          for (int j = 0; j < 16; ++j) x[j] = tile[(kg * 16 + j) * 129 + nl];
          const int drow = mode == 0 ? n : (tn * 256 + nl + (mode == 2 ? 128 : 0));
          u32x4 w0, w1; w0.x = pk2(x[0], x[1]); w0.y = pk2(x[2], x[3]); w0.z = pk2(x[4], x[5]); w0.w = pk2(x[6], x[7]);
          w1.x = pk2(x[8], x[9]); w1.y = pk2(x[10], x[11]); w1.z = pk2(x[12], x[13]); w1.w = pk2(x[14], x[15]);
          u32x4* dp = (u32x4*)(dst + (size_t)drow * K + tk * 64 + kg * 16); dp[0] = w0; dp[1] = w1; }
        __syncthreads();
    }
#undef TC_LOAD
}

DI void norm_rows(const float* src, const float* __restrict__ g, bf16_t* dstb, float* dstf) {
    const int wid = threadIdx.x >> 6, lane = threadIdx.x & 63, stride = gridDim.x * 8;
    for (int row = blockIdx.x * 8 + wid; row < MTOK; row += 2 * stride) {
        const int row2 = row + stride; const bool has2 = row2 < MTOK;
        const f32x4* p = (const f32x4*)(src + (size_t)row * DM); const f32x4* p2 = (const f32x4*)(src + (size_t)(has2 ? row2 : row) * DM);
        f32x4 v[8], w[8]; float ss = 0.f, ss2 = 0.f;
#pragma unroll
        for (int i = 0; i < 8; ++i) { v[i] = p[lane + 64 * i]; w[i] = p2[lane + 64 * i]; }
#pragma unroll
        for (int i = 0; i < 8; ++i) { ss += v[i][0] * v[i][0] + v[i][1] * v[i][1] + v[i][2] * v[i][2] + v[i][3] * v[i][3]; ss2 += w[i][0] * w[i][0] + w[i][1] * w[i][1] + w[i][2] * w[i][2] + w[i][3] * w[i][3]; }
#pragma unroll
        for (int o = 32; o >= 1; o >>= 1) { ss += __shfl_xor(ss, o); ss2 += __shfl_xor(ss2, o); }
        const float rstd = 1.0f / sqrtf(ss * (1.0f / DM) + EPSN), rstd2 = 1.0f / sqrtf(ss2 * (1.0f / DM) + EPSN);
#pragma unroll
        for (int i = 0; i < 8; ++i) { const f32x4 gg = ((const f32x4*)g)[lane + 64 * i]; const f32x4 y = v[i] * rstd * gg, y2 = w[i] * rstd2 * gg;
            if (dstb) { u32x2 o; o.x = pk2(y[0], y[1]); o.y = pk2(y[2], y[3]); *(u32x2*)(dstb + (size_t)row * DM + (lane + 64 * i) * 4) = o;
                        if (has2) { u32x2 o2; o2.x = pk2(y2[0], y2[1]); o2.y = pk2(y2[2], y2[3]); *(u32x2*)(dstb + (size_t)row2 * DM + (lane + 64 * i) * 4) = o2; } }
            else { ((f32x4*)(dstf + (size_t)row * DM))[lane + 64 * i] = y; if (has2) ((f32x4*)(dstf + (size_t)row2 * DM))[lane + 64 * i] = y2; } }
    }
}

DI void phase_prep(const Params& P, unsigned char* smem) {
    unsigned char* ws = P.ws; float* tile = (float*)smem; const int tid = threadIdx.x;
    float* sm = (float*)(ws + WS_SMALL);
    if (blockIdx.x < 8) { const int idx = blockIdx.x * 512 + tid, grp = idx >> 6;
        const float step = expf(P.in[18][grp]), lre = P.in[16][idx], lim = P.in[17][idx];
        const float mag = expf(lre * step), ar = mag * cosf(lim * step), ai = mag * sinf(lim * step);
        const float nr = ar - 1.0f, ni = ai, den = lre * lre + lim * lim, fre = (nr * lre + ni * lim) / den, fim = (ni * lre - nr * lim) / den;
        f32x4 brv[4], biv[4];
#pragma unroll
        for (int k = 0; k < 4; ++k) { brv[k] = *(const f32x4*)(P.in[19] + idx * 16 + 4 * k); biv[k] = *(const f32x4*)(P.in[20] + idx * 16 + 4 * k); }
        bf16_t* tb = (bf16_t*)(sm + SM_BB); const int p = idx & 63;
        unsigned hre[16], lre_[16], him[16], lim_[16];
#pragma unroll
        for (int h = 0; h < 16; ++h) { const float br = brv[h >> 2][h & 3], bi = biv[h >> 2][h & 3];
            const float vre = fre * br - fim * bi, vim = fre * bi + fim * br;
            hre[h] = pk2(vre, 0.f) & 0xffffu; lre_[h] = pk2(vre - bf2f(hre[h]), 0.f) & 0xffffu;
            him[h] = pk2(vim, 0.f) & 0xffffu; lim_[h] = pk2(vim - bf2f(him[h]), 0.f) & 0xffffu; }
        { u32x4* d = (u32x4*)(tb + (grp * 128 + p) * 32);
          d[0] = (u32x4){hre[0] | (hre[1] << 16), hre[2] | (hre[3] << 16), hre[4] | (hre[5] << 16), hre[6] | (hre[7] << 16)};
          d[1] = (u32x4){hre[8] | (hre[9] << 16), hre[10] | (hre[11] << 16), hre[12] | (hre[13] << 16), hre[14] | (hre[15] << 16)};
          d[2] = (u32x4){lre_[0] | (lre_[1] << 16), lre_[2] | (lre_[3] << 16), lre_[4] | (lre_[5] << 16), lre_[6] | (lre_[7] << 16)};
          d[3] = (u32x4){lre_[8] | (lre_[9] << 16), lre_[10] | (lre_[11] << 16), lre_[12] | (lre_[13] << 16), lre_[14] | (lre_[15] << 16)};
          u32x4* e = (u32x4*)(tb + (grp * 128 + 64 + p) * 32);
          e[0] = (u32x4){him[0] | (him[1] << 16), him[2] | (him[3] << 16), him[4] | (him[5] << 16), him[6] | (him[7] << 16)};
          e[1] = (u32x4){him[8] | (him[9] << 16), him[10] | (him[11] << 16), him[12] | (him[13] << 16), him[14] | (him[15] << 16)};
          e[2] = (u32x4){lim_[0] | (lim_[1] << 16), lim_[2] | (lim_[3] << 16), lim_[4] | (lim_[5] << 16), lim_[6] | (lim_[7] << 16)};
          e[3] = (u32x4){lim_[8] | (lim_[9] << 16), lim_[10] | (lim_[11] << 16), lim_[12] | (lim_[13] << 16), lim_[14] | (lim_[15] << 16)}; }
        float pr = ar, pi = ai;
        for (int s = 0; s < 6; ++s) { const float nr2 = pr * pr - pi * pi, ni2 = 2.0f * pr * pi; pr = nr2; pi = ni2; }
        sm[SM_AB + idx * 4 + 0] = ar; sm[SM_AB + idx * 4 + 1] = ai; sm[SM_AB + idx * 4 + 2] = pr; sm[SM_AB + idx * 4 + 3] = pi; }
    { const int which = blockIdx.x >> 7, chunk = blockIdx.x & 127; const float* pe = P.in[which ? 11 : 7]; const float* w1 = P.in[which ? 12 : 8];
      if (blockIdx.x < 256) {
        const int n = tid & 127, sub = tid >> 7; float s = 0.f;
#pragma unroll
        for (int j = 0; j < 8; ++j) { const int k = chunk * 32 + sub * 8 + j; s += pe[k] * w1[(size_t)k * 128 + n]; }
        tile[tid] = s; __syncthreads();
        if (tid < 128) sm[SM_CBP + (which * 128 + chunk) * 128 + tid] = (tile[tid] + tile[tid + 128]) + (tile[tid + 256] + tile[tid + 384]);
        __syncthreads(); } }
    if (blockIdx.x == 10 && tid == 0) { ((int*)(sm + SM_CTR))[0] = 0; ((int*)(sm + SM_CTR))[1] = 0; }
    for (int i = blockIdx.x * 512 + tid; i < 32768; i += gridDim.x * 512) sm[SM_SS + i] = 0.f;
    { u32x4* z = (u32x4*)(ws + WS_KCB); const u32x4 zero = {0u, 0u, 0u, 0u};
      for (int i = blockIdx.x * 512 + tid; i < 65536; i += gridDim.x * 512) z[i] = zero; }
    norm_rows(P.in[0], P.in[1], (bf16_t*)(ws + WS_XN), nullptr);
    tconv(P.in[2], DM, DFF, DFF, (bf16_t*)(ws + WS_W13A), 1, tile);
    tconv(P.in[3], DM, DFF, DFF, (bf16_t*)(ws + WS_W13A), 2, tile);
    tconv(P.in[4], DFF, DM, DM, (bf16_t*)(ws + WS_W2A), 0, tile);
    tconv(P.in[6], DM, 3608, NPROJ, (bf16_t*)(ws + WS_WIN), 0, tile, P.in[5]);
    tconv(P.in[8], 4096, 128, 128, (bf16_t*)(ws + WS_CW1K), 0, tile);
    tconv(P.in[12], 4096, 128, 128, (bf16_t*)(ws + WS_CW1V), 0, tile);
    tconv(P.in[10], 128, 128, 128, (bf16_t*)(ws + WS_CW2K), 0, tile);
    tconv(P.in[14], 128, 128, 128, (bf16_t*)(ws + WS_CW2V), 0, tile);
    tconv(P.in[24], 1024, 1024, 1024, (bf16_t*)(ws + WS_GLUW), 0, tile);
    tconv(P.in[26], DM, DM, DM, (bf16_t*)(ws + WS_WOUT), 0, tile);
    tconv(P.in[28], DM, DFF, DFF, (bf16_t*)(ws + WS_W13B), 1, tile, P.in[27]);
    tconv(P.in[29], DM, DFF, DFF, (bf16_t*)(ws + WS_W13B), 2, tile, P.in[27]);
    tconv(P.in[30], DFF, DM, DM, (bf16_t*)(ws + WS_W2B), 0, tile);
}

DI void compress_item(const Params& P, int item, unsigned char* smem) {
    unsigned char* ws = P.ws; const int tid = threadIdx.x, wid = tid >> 6, lane = tid & 63, r = lane & 15, q = lane >> 4;
    const int which = item / 127, rt = item % 127;
    const bf16_t* proj = (const bf16_t*)(ws + WS_PROJ);
    const bf16_t* w1t = (const bf16_t*)(ws + (which ? WS_CW1V : WS_CW1K));
    const bf16_t* w2t = (const bf16_t*)(ws + (which ? WS_CW2V : WS_CW2K));
    const float* cb1 = (const float*)(ws + WS_SMALL) + SM_CB1 + which * 128;
    float* part = (float*)smem;
    bf16_t* hid = (bf16_t*)(smem + 65536);
    const int grow = rt * 16 + r, bg = grow / 127, c = grow % 127, b = bg >> 1, g = bg & 1;
    const bf16_t* arow = proj + (size_t)(b * TT + 16 * c) * NPROJ + (which ? C_VC : C_KC) + g * 128;
    f32x4 acc[8];
#pragma unroll
    for (int ct = 0; ct < 8; ++ct) acc[ct] = (f32x4){0.f, 0.f, 0.f, 0.f};
    bf16x8 fa[2], fb[2][8];
#define CP_LOAD(buf, s_) do { const int kabs_ = 512 * wid + 32 * (s_) + 8 * q; fa[buf] = *(const bf16x8*)(arow + (size_t)(kabs_ >> 7) * NPROJ + (kabs_ & 127)); \
        _Pragma("unroll") for (int ct = 0; ct < 8; ++ct) fb[buf][ct] = *(const bf16x8*)(w1t + (size_t)(ct * 16 + r) * 4096 + kabs_); } while (0)
    CP_LOAD(0, 0);
#pragma unroll
    for (int s = 0; s < 16; ++s) {
        if (s + 1 < 16) CP_LOAD((s + 1) & 1, s + 1);
        __builtin_amdgcn_sched_barrier(0);
#pragma unroll
        for (int ct = 0; ct < 8; ++ct) acc[ct] = __builtin_amdgcn_mfma_f32_16x16x32_bf16(fa[s & 1], fb[s & 1][ct], acc[ct], 0, 0, 0);
        __builtin_amdgcn_sched_barrier(0);
    }
#undef CP_LOAD
#pragma unroll
    for (int ct = 0; ct < 8; ++ct)
#pragma unroll
        for (int j = 0; j < 4; ++j) part[(wid * 16 + 4 * q + j) * 128 + ct * 16 + r] = acc[ct][j];
    __syncthreads();
    { const int row = tid >> 5, c4 = (tid & 31) * 4; f32x4 s = *(const f32x4*)(cb1 + c4);
#pragma unroll
      for (int w = 0; w < 8; ++w) s += *(const f32x4*)(part + (w * 16 + row) * 128 + c4);
      u32x2 o; o.x = pk2(gelu_tanh(s[0]), gelu_tanh(s[1])); o.y = pk2(gelu_tanh(s[2]), gelu_tanh(s[3]));
      *(u32x2*)(hid + row * 136 + c4) = o; }
    __syncthreads();
    { f32x4 a2 = {0.f, 0.f, 0.f, 0.f};
#pragma unroll
      for (int s = 0; s < 4; ++s) { const bf16x8 a = *(const bf16x8*)(hid + r * 136 + 32 * s + 8 * q);
          const bf16x8 bb = *(const bf16x8*)(w2t + (size_t)(16 * wid + r) * 128 + 32 * s + 8 * q);
          a2 = __builtin_amdgcn_mfma_f32_16x16x32_bf16(a, bb, a2, 0, 0, 0); }
      bf16_t* kcb = (bf16_t*)(ws + WS_KCB); bf16_t* vcbt = (bf16_t*)(ws + WS_VCBT);
#pragma unroll
      for (int j = 0; j < 4; ++j) { const int gr = rt * 16 + 4 * q + j, bg2 = gr / 127, c2 = gr % 127, col = 16 * wid + r;
          const bf16_t v = (bf16_t)(pk2(a2[j], 0.f) & 0xffffu);
          if (which == 0) kcb[(size_t)(bg2 * 128 + c2) * 128 + col] = v; else vcbt[(size_t)(bg2 * 128 + col) * 128 + c2] = v; } }
    __syncthreads();
}

DI void s5_bu16(const bf16x8 ub, const bf16x8 (&af)[8], float* buf, int r, int q) {
#pragma unroll
    for (int pt = 0; pt < 8; ++pt) { f32x4 d = {0.f, 0.f, 0.f, 0.f}; d = __builtin_amdgcn_mfma_f32_16x16x32_bf16(af[pt], ub, d, 0, 0, 0);
#pragma unroll
        for (int j = 0; j < 4; ++j) buf[(16 * pt + 4 * q + j) * 17 + r] = d[j]; }
}
DI void s5_pass1_item(const Params& P, int bitem, unsigned char* smem) {
    int tid_ = threadIdx.x; asm volatile("" : "+v"(tid_));
    unsigned char* ws = P.ws; const int tid = tid_, wid = tid >> 6, lane = tid & 63, r = lane & 15, q = lane >> 4;
    const int item = bitem * 8 + wid, ch = item & 31, grp = (item >> 5) & 63, b = item >> 11;
    const bf16_t* proj = (const bf16_t*)(ws + WS_PROJ); const float* sm = (const float*)(ws + WS_SMALL);
    float* buf = (float*)smem + wid * 2176;
    const bf16_t* tb = (const bf16_t*)(sm + SM_BB);
    bf16x8 af[8];
#pragma unroll
    for (int pt = 0; pt < 8; ++pt) af[pt] = *(const bf16x8*)(tb + (grp * 128 + 16 * pt + r) * 32 + 8 * q);
    const f32x4 ab = *(const f32x4*)(sm + SM_AB + (grp * 64 + lane) * 4);
    const bf16_t* ubase = proj + (size_t)(b * TT + ch * 64) * NPROJ + C_SSM + grp * 16;
    float xr = 0.f, xi = 0.f;
    bf16x8 ubs[4];
#pragma unroll
    for (int sub = 0; sub < 4; ++sub) ubs[sub] = *(const bf16x8*)(ubase + (size_t)(sub * 16 + r) * NPROJ + 8 * (q & 1));
#pragma unroll
    for (int sub = 0; sub < 4; ++sub) {
        s5_bu16(ubs[sub], af, buf, r, q);
        asm volatile("s_waitcnt lgkmcnt(0)" ::: "memory");
#pragma unroll
        for (int tt = 0; tt < 16; ++tt) { const float bur = buf[lane * 17 + tt], bui = buf[(64 + lane) * 17 + tt];
            const float nxr = ab[0] * xr - ab[1] * xi + bur, nxi = ab[0] * xi + ab[1] * xr + bui; xr = nxr; xi = nxi; }
        asm volatile("s_waitcnt lgkmcnt(0)" ::: "memory");
    }
    f32x2_t e = {xr, xi};
    *(f32x2_t*)(ws + WS_S5END + ((size_t)((b * 64 + grp) * 32 + ch) * 64 + lane) * 8) = e;
}

DI void vtrans_item(const Params& P, int item, unsigned char* smem) {
    unsigned char* ws = P.ws; const int tid = threadIdx.x;
    const int tokblk = item >> 3, cseg = item & 7, tok0 = tokblk * 64, b = tok0 >> 11, t0 = tok0 & 2047;
    const int col = (cseg < 4 ? C_VS + cseg * 64 : C_VW + (cseg - 4) * 64), g = (cseg & 3) >> 1, d0 = (cseg & 1) * 64;
    const bf16_t* proj = (const bf16_t*)(ws + WS_PROJ);
    bf16_t* dst = (bf16_t*)(ws + (cseg < 4 ? WS_VTS : WS_VTW)) + (size_t)((b * 2 + g) * 128 + d0) * TT + t0;
    bf16_t* tl = (bf16_t*)smem;
    { const int r = tid >> 3, sg = tid & 7; *(u32x4*)(tl + r * 72 + sg * 8) = *(const u32x4*)(proj + (size_t)(tok0 + r) * NPROJ + col + sg * 8); }
    __syncthreads();
    { const int d = tid >> 3, tsg = tid & 7; unsigned v[8];
#pragma unroll
      for (int j = 0; j < 8; ++j) v[j] = tl[(tsg * 8 + j) * 72 + d];
      u32x4 w; w.x = v[0] | (v[1] << 16); w.y = v[2] | (v[3] << 16); w.z = v[4] | (v[5] << 16); w.w = v[6] | (v[7] << 16);
      *(u32x4*)(dst + (size_t)d * TT + tsg * 8) = w; }
    __syncthreads();
}

DI void s5_pass3_item(const Params& P, int bitem, unsigned char* smem) {
    int tid_ = threadIdx.x; asm volatile("" : "+v"(tid_));
    unsigned char* ws = P.ws; const int tid = tid_, wid = tid >> 6, lane = tid & 63, r = lane & 15, q = lane >> 4;
    const int item = bitem * 8 + wid, ch = item & 31, grp = (item >> 5) & 63, b = item >> 11;
    const bf16_t* proj = (const bf16_t*)(ws + WS_PROJ); const float* sm = (const float*)(ws + WS_SMALL);
    float* xs = (float*)smem + wid * 2176;
    bf16_t* HG = (bf16_t*)(ws + WS_HG);
    const bf16_t* tb = (const bf16_t*)(sm + SM_BB);
    bf16x8 af[8];
#pragma unroll
    for (int pt = 0; pt < 8; ++pt) af[pt] = *(const bf16x8*)(tb + (grp * 128 + 16 * pt + r) * 32 + 8 * q);
    const f32x4 ab = *(const f32x4*)(sm + SM_AB + (grp * 64 + lane) * 4);
    float cB[32];
    { const float* cre = P.in[21] + (size_t)(grp * 16 + r) * 64; const float* cim = P.in[22] + (size_t)(grp * 16 + r) * 64;
#pragma unroll
      for (int i = 0; i < 32; ++i) { const int k = 4 * i + q; cB[i] = (i < 16) ? cre[k] : -cim[k - 64]; } }
    const float dsk = P.in[23][grp * 16 + r];
    const bf16_t* ubase = proj + (size_t)(b * TT + ch * 64) * NPROJ + C_SSM + grp * 16;
    bf16x8 ubs[4]; unsigned short uvs[4][4];
#pragma unroll
    for (int sub = 0; sub < 4; ++sub) { ubs[sub] = *(const bf16x8*)(ubase + (size_t)(sub * 16 + r) * NPROJ + 8 * (q & 1));
#pragma unroll
        for (int j = 0; j < 4; ++j) uvs[sub][j] = ubase[(size_t)(sub * 16 + 4 * q + j) * NPROJ + r]; }
    float xr = 0.f, xi = 0.f;
    { const f32x2_t* e = (const f32x2_t*)(ws + WS_S5END) + (size_t)((b * 64 + grp) * 32) * 64 + lane;
      for (int c0 = 0; c0 < ch; c0 += 16) { f32x2_t ev[16];
#pragma unroll
          for (int j = 0; j < 16; ++j) ev[j] = (c0 + j < ch) ? e[(c0 + j) * 64] : (f32x2_t){0.f, 0.f};
#pragma unroll
          for (int j = 0; j < 16; ++j) if (c0 + j < ch) { const float ncr = ab[2] * xr - ab[3] * xi + ev[j][0], nci = ab[2] * xi + ab[3] * xr + ev[j][1]; xr = ncr; xi = nci; } } }
#pragma unroll
    for (int sub = 0; sub < 4; ++sub) {
        s5_bu16(ubs[sub], af, xs, r, q);
        float uv[4];
#pragma unroll
        for (int j = 0; j < 4; ++j) uv[j] = bf2f(uvs[sub][j]);
        asm volatile("s_waitcnt lgkmcnt(0)" ::: "memory");
#pragma unroll
        for (int tt = 0; tt < 16; ++tt) { const float bur = xs[lane * 17 + tt], bui = xs[(64 + lane) * 17 + tt];
            const float nxr = ab[0] * xr - ab[1] * xi + bur, nxi = ab[0] * xi + ab[1] * xr + bui; xr = nxr; xi = nxi;
            xs[lane * 17 + tt] = xr; xs[(64 + lane) * 17 + tt] = xi; }
        asm volatile("s_waitcnt lgkmcnt(0)" ::: "memory");
        f32x4 ya[4];
#pragma unroll
        for (int j = 0; j < 4; ++j) ya[j] = (f32x4){0.f, 0.f, 0.f, 0.f};
#pragma unroll
        for (int i = 0; i < 32; ++i) { const float a = xs[(4 * i + q) * 17 + r]; ya[i & 3] = __builtin_amdgcn_mfma_f32_16x16x4f32(a, cB[i], ya[i & 3], 0, 0, 0); }
        const f32x4 y = (ya[0] + ya[1]) + (ya[2] + ya[3]);
#pragma unroll
        for (int j = 0; j < 4; ++j) { const int tl = sub * 16 + 4 * q + j; const float v = y[j] + dsk * uv[j];
            HG[(size_t)(b * TT + ch * 64 + tl) * 1024 + grp * 16 + r] = (bf16_t)(pk2(gelu_tanh(v), 0.f) & 0xffffu); }
        asm volatile("s_waitcnt lgkmcnt(0)" ::: "memory");
    }
}

DI float xor32_max(float x) { const auto r_ = __builtin_amdgcn_permlane32_swap(__float_as_uint(x), __float_as_uint(x), false, false); return fmaxf(__uint_as_float(r_[0]), __uint_as_float(r_[1])); }
DI float xor32_sum(float x) { const auto r_ = __builtin_amdgcn_permlane32_swap(__float_as_uint(x), __float_as_uint(x), false, false); return __uint_as_float(r_[0]) + __uint_as_float(r_[1]); }
#define MFMA32(a, b, c) __builtin_amdgcn_mfma_f32_32x32x16_bf16((a), (b), (c), 0, 0, 0)
DI bf16x8 ld2x4(const bf16_t* p0) { const s16x4 a = *(const s16x4*)p0, b = *(const s16x4*)(p0 + 8); return __builtin_shufflevector(a, b, 0, 1, 2, 3, 4, 5, 6, 7); }
DI bf16x8 packp(const f32x16& x, int s) { u32x4 p; p.x = pk2(x[8 * s], x[8 * s + 1]); p.y = pk2(x[8 * s + 2], x[8 * s + 3]); p.z = pk2(x[8 * s + 4], x[8 * s + 5]); p.w = pk2(x[8 * s + 6], x[8 * s + 7]); return __builtin_bit_cast(bf16x8, p); }
DI int crow(int i, int hh) { return (i & 3) + 8 * (i >> 2) + 4 * hh; }

constexpr int A_STG = 0;
constexpr int A_BUF = 34816, A_VOFF = 17408;
constexpr int A_IMPM = 69632, A_IMPS = A_IMPM + 33792, A_IMPV = A_IMPS + 33792, A_LUT = A_IMPV + 8192, A_SELM = A_LUT + 4096;
DI bf16x8 lds2x4(const unsigned char* p) { const s16x4 a = *(const s16x4*)p, b = *(const s16x4*)(p + 16); return __builtin_shufflevector(a, b, 0, 1, 2, 3, 4, 5, 6, 7); }

constexpr float QK_C1 = 0.08838834764831845f * 1.4426950408889634f;
template <int MODE, bool FAR>
DI void attn_tile(const unsigned char* kl  , const unsigned char* vl  ,
                  int k0, int tq, int r, int hh, bool bit, const bf16x8 (&qf)[8], const float* lutH, f32x16 (&o)[4], float& m, float& l) {
    f32x16 s;
#pragma unroll
    for (int i = 0; i < 16; ++i) s[i] = 0.f;
    const unsigned char* kp = kl + r * 272 + 16 * hh;
#pragma unroll
    for (int kk = 0; kk < 8; ++kk) { const bf16x8 a = *(const bf16x8*)(kp + 32 * kk); s = MFMA32(a, qf[kk], s); }
    float tmax = NEGF;
    if (FAR) {
        const float b31 = lutH[255];
#pragma unroll
        for (int i = 0; i < 16; ++i) { const float v = s[i] * QK_C1 + b31; s[i] = (MODE == 0 && !bit) ? NEGF : v; tmax = fmaxf(tmax, s[i]); }
    } else {
#pragma unroll
        for (int i = 0; i < 16; ++i) { const int dist = tq - (k0 + crow(i, hh));
            const bool valid = MODE == 0 ? (bit && dist >= 0) : (dist >= 0 && dist < 512);
            const int di = dist < 0 ? 0 : (dist > 255 ? 255 : dist);
            const float v = s[i] * QK_C1 + lutH[di];
            s[i] = valid ? v : NEGF; tmax = fmaxf(tmax, s[i]); }
    }
    tmax = xor32_max(tmax);
    const float mnew = fmaxf(m, tmax);
    if (__ballot(mnew != m) != 0ull) {
        const float alpha = __builtin_amdgcn_exp2f(m - mnew);
        l *= alpha; m = mnew;
#pragma unroll
        for (int dt = 0; dt < 4; ++dt)
#pragma unroll
            for (int i = 0; i < 16; ++i) o[dt][i] *= alpha;
    }
    float psum = 0.f;
    if (FAR) {
#pragma unroll
        for (int i = 0; i < 16; ++i) { const float p = __builtin_amdgcn_exp2f(s[i] - mnew); s[i] = p; psum += p; }
    } else {
#pragma unroll
        for (int i = 0; i < 16; ++i) { const float p = (s[i] > -1e29f) ? __builtin_amdgcn_exp2f(s[i] - mnew) : 0.f; s[i] = p; psum += p; }
    }
    psum = xor32_sum(psum);
    l += psum;
    const unsigned char* vp = vl + r * 136 + 8 * hh;
#pragma unroll
    for (int s2 = 0; s2 < 2; ++s2) { const bf16x8 pb = packp(s, s2);
#pragma unroll
        for (int dt = 0; dt < 4; ++dt) { const bf16x8 a = lds2x4(vp + dt * (32 * 136) + 32 * s2); o[dt] = MFMA32(a, pb, o[dt]); } }
}

template <int MODE>
DI void attn_tile64_far(const unsigned char* bp  , int r, int hh, bool bit, const bf16x8 (&qf)[8], const float* lutH, f32x16 (&o)[4], float& m, float& l) {
    f32x16 s0, s1;
#pragma unroll
    for (int i = 0; i < 16; ++i) { s0[i] = 0.f; s1[i] = 0.f; }
    const unsigned char* kp = bp + r * 272 + 16 * hh;
#pragma unroll
    for (int kk = 0; kk < 8; ++kk) { const bf16x8 a0 = *(const bf16x8*)(kp + 32 * kk), a1 = *(const bf16x8*)(kp + 32 * 272 + 32 * kk); s0 = MFMA32(a0, qf[kk], s0); s1 = MFMA32(a1, qf[kk], s1); }
    const float b31 = lutH[255];
    float tmax = NEGF;
#pragma unroll
    for (int i = 0; i < 16; ++i) { const float v0 = s0[i] * QK_C1 + b31, v1 = s1[i] * QK_C1 + b31;
        s0[i] = (MODE == 0 && !bit) ? NEGF : v0; s1[i] = (MODE == 0 && !bit) ? NEGF : v1; tmax = fmaxf(tmax, fmaxf(s0[i], s1[i])); }
    tmax = xor32_max(tmax);
    const float mnew = fmaxf(m, tmax);
    if (__ballot(mnew != m) != 0ull) {
        const float alpha = __builtin_amdgcn_exp2f(m - mnew);
        l *= alpha; m = mnew;
#pragma unroll
        for (int dt = 0; dt < 4; ++dt)
#pragma unroll
            for (int i = 0; i < 16; ++i) o[dt][i] *= alpha;
    }
    float psum = 0.f;
#pragma unroll
    for (int i = 0; i < 16; ++i) { const float p0 = __builtin_amdgcn_exp2f(s0[i] - mnew), p1 = __builtin_amdgcn_exp2f(s1[i] - mnew); s0[i] = p0; s1[i] = p1; psum += p0 + p1; }
    l += xor32_sum(psum);
    const unsigned char* vp = bp + A_VOFF + r * 136 + 8 * hh;
#pragma unroll
    for (int s2 = 0; s2 < 2; ++s2) { const bf16x8 pb0 = packp(s0, s2), pb1 = packp(s1, s2);
#pragma unroll
        for (int dt = 0; dt < 4; ++dt) { const bf16x8 a0 = lds2x4(vp + dt * (32 * 136) + 32 * s2), a1 = lds2x4(vp + dt * (32 * 136) + 64 + 32 * s2);
            o[dt] = MFMA32(a0, pb0, o[dt]); o[dt] = MFMA32(a1, pb1, o[dt]); } }
}

template <int MODE>
DI void attn_branch(unsigned char* smem, const bf16_t* kb  , const bf16_t* vt  , unsigned need, unsigned mymask,
                    int t0w, int tq, int r, int hh, const bf16x8 (&qf)[8], const float* lutH, f32x16 (&o)[4], float& m, float& l) {
    int tid = threadIdx.x; asm volatile("" : "+v"(tid));
    if (need == 0u) return;
    u32x4 kreg[2], vreg[2];
    const int krow0 = tid >> 4, kcc = tid & 15, vd0 = tid >> 3, vcc = tid & 7;
#define AB_LOAD(j) do { _Pragma("unroll") for (int e = 0; e < 2; ++e) { \
        kreg[e] = *(const u32x4*)(kb + (size_t)(64 * (j) + krow0 + 32 * e) * NPROJ + kcc * 8); \
        vreg[e] = *(const u32x4*)(vt + (size_t)(vd0 + 64 * e) * TT + 64 * (j) + vcc * 8); } } while (0)
#define AB_STORE(buf) do { unsigned char* bp_ = smem + A_STG + (buf) * A_BUF; _Pragma("unroll") for (int e = 0; e < 2; ++e) { \
        *(u32x4*)(bp_ + (krow0 + 32 * e) * 272 + kcc * 16) = kreg[e]; \
        unsigned char* vp_ = bp_ + A_VOFF + (vd0 + 64 * e) * 136 + vcc * 16; \
        *(u32x2*)vp_ = (u32x2){vreg[e].x, vreg[e].y}; *(u32x2*)(vp_ + 8) = (u32x2){vreg[e].z, vreg[e].w}; } } while (0)
    int j = __builtin_ctz(need); need &= need - 1u;
    AB_LOAD(j); AB_STORE(0);
    __syncthreads();
    int n = 0;
    for (;;) {
        const bool has_next = need != 0u;
        int jn = 0;
        if (has_next) { jn = __builtin_ctz(need); need &= need - 1u; AB_LOAD(jn); }
        const unsigned char* bp = smem + A_STG + (n & 1) * A_BUF;
        const bool bit = MODE == 0 ? ((mymask >> j) & 1u) : true;
        const bool any = MODE == 0 ? (__ballot(bit) != 0ull) : true;
        const bool far64 = any && (64 * j + 63 + 128 <= t0w) && (MODE == 0 || 64 * j >= t0w + 31 - 511);
        if (far64) attn_tile64_far<MODE>(bp, r, hh, bit, qf, lutH, o, m, l);
        else {
#pragma unroll 1
        for (int half = 0; half < 2; ++half) { const int k0 = 64 * j + 32 * half;
            bool act = any && (k0 <= t0w + 31);
            if (MODE == 1) act = act && (k0 + 31 + 511 >= t0w);
            const bool far = (k0 + 31 + 128 <= t0w) && (MODE == 0 || k0 >= t0w + 31 - 511);
            if (act) { if (far) attn_tile<MODE, true>(bp + half * (32 * 272), bp + A_VOFF + half * 64, k0, tq, r, hh, bit, qf, lutH, o, m, l);
                       else attn_tile<MODE, false>(bp + half * (32 * 272), bp + A_VOFF + half * 64, k0, tq, r, hh, bit, qf, lutH, o, m, l); } }
        }
        if (has_next) AB_STORE((n + 1) & 1);
        __syncthreads();
        if (!has_next) break;
        j = jn; ++n;
    }
#undef AB_LOAD
#undef AB_STORE
}

DI void attn_item(const Params& P, int item, unsigned char* smem) {
    int tid_ = threadIdx.x; asm volatile("" : "+v"(tid_));
    unsigned char* ws = P.ws; const int tid = tid_, wid = tid >> 6, lane = tid & 63, r = lane & 31, hh = lane >> 5;
    const int bg = item & 15, qt = 31 - (item >> 4), b = bg >> 1, g = bg & 1, t0 = qt * 64;
    const int hg = wid >> 1, t0w = t0 + 32 * (wid & 1), tq = t0w + r, head = g * 4 + hg, qloc = 32 * (wid & 1) + r;
    const bf16_t* proj = (const bf16_t*)(ws + WS_PROJ);
    float* outs = (float*)(ws + WS_OUTS) + ((size_t)blockIdx.x * 8 + wid) * 4096;
    float* impM = (float*)(smem + A_IMPM); float* impS = (float*)(smem + A_IMPS); float* impv = (float*)(smem + A_IMPV);
    float* lut = (float*)(smem + A_LUT); unsigned* selm = (unsigned*)(smem + A_SELM);
    for (int i = tid; i < 1024; i += 512) { const int h4 = i >> 8, n = i & 255; int bk;
        if (n < 16) bk = n; else { bk = 16 + (int)(logf((float)n / 16.0f) / 2.0794415416798357f * 16.0f); bk = bk > 31 ? 31 : bk; }
        lut[i] = P.in[15][bk * 8 + g * 4 + h4] * 1.4426950408889634f; }
    { const bf16_t* kcb = (const bf16_t*)(ws + WS_KCB) + (size_t)bg * 16384; const bf16_t* vcbt = (const bf16_t*)(ws + WS_VCBT) + (size_t)bg * 16384;
#pragma unroll
      for (int e = 0; e < 4; ++e) { const int id = tid + 512 * e, row = id >> 4, cc = id & 15;
          *(u32x4*)(smem + A_STG + row * 272 + cc * 16) = *(const u32x4*)(kcb + row * 128 + cc * 8);
          *(u32x4*)(smem + A_STG + A_BUF + row * 272 + cc * 16) = *(const u32x4*)(vcbt + row * 128 + cc * 8); } }
    bf16x8 qf[8];
    { const bf16_t* qrow = proj + (size_t)(b * TT + tq) * NPROJ + head * 128 + 8 * hh;
#pragma unroll
      for (int kk = 0; kk < 8; ++kk) qf[kk] = *(const bf16x8*)(qrow + 16 * kk); }
    __syncthreads();
    const float* lutH = lut + hg * 256;
    f32x16 oc[4];
    {
        const unsigned char* kl = smem + A_STG + r * 272 + 16 * hh;
        const unsigned char* vl = smem + A_STG + A_BUF + r * 272 + 8 * hh;
        float mx = NEGF, sum = 0.f;
#pragma unroll 1
        for (int kt = 0; kt < 4; ++kt) {
            f32x16 sc;
#pragma unroll
            for (int i = 0; i < 16; ++i) sc[i] = 0.f;
#pragma unroll
            for (int kk = 0; kk < 8; ++kk) { const bf16x8 a = *(const bf16x8*)(kl + kt * (32 * 272) + 32 * kk); sc = MFMA32(a, qf[kk], sc); }
            float tmax = NEGF;
#pragma unroll
            for (int i = 0; i < 16; ++i) { const int c = 32 * kt + crow(i, hh), dist = tq - (16 * c + 31);
                const int di = dist < 0 ? 0 : (dist > 255 ? 255 : dist);
                const float v = sc[i] * QK_C1 + lutH[di];
                sc[i] = (dist >= 0 && c < 127) ? v : NEGF; tmax = fmaxf(tmax, sc[i]); }
            tmax = xor32_max(tmax);
            const float mnew = fmaxf(mx, tmax); float ps = 0.f;
#pragma unroll
            for (int i = 0; i < 16; ++i) ps += (sc[i] > -1e29f) ? __builtin_amdgcn_exp2f(sc[i] - mnew) : 0.f;
            ps = xor32_sum(ps);
            sum = sum * __builtin_amdgcn_exp2f(mx - mnew) + ps; mx = mnew;
        }
        const float inv = 1.0f / fmaxf(sum, 1e-30f);
#pragma unroll
        for (int dt = 0; dt < 4; ++dt)
#pragma unroll
            for (int i = 0; i < 16; ++i) oc[dt][i] = 0.f;
#pragma unroll 1
        for (int kt = 0; kt < 4; ++kt) {
            f32x16 sc;
#pragma unroll
            for (int i = 0; i < 16; ++i) sc[i] = 0.f;
#pragma unroll
            for (int kk = 0; kk < 8; ++kk) { const bf16x8 a = *(const bf16x8*)(kl + kt * (32 * 272) + 32 * kk); sc = MFMA32(a, qf[kk], sc); }
#pragma unroll
            for (int i = 0; i < 16; ++i) { const int c = 32 * kt + crow(i, hh), dist = tq - (16 * c + 31);
                const int di = dist < 0 ? 0 : (dist > 255 ? 255 : dist);
                const float v = sc[i] * QK_C1 + lutH[di];
                sc[i] = (dist >= 0 && c < 127) ? __builtin_amdgcn_exp2f(v - mx) * inv : 0.f; }
#pragma unroll
            for (int gi = 0; gi < 4; ++gi) { const int jb = 8 * kt + 2 * gi + hh; const float p3 = 0.5f * sc[4 * gi + 3];
                impM[(hg * 64 + qloc) * 33 + jb] = sc[4 * gi] + sc[4 * gi + 1] + sc[4 * gi + 2] + p3;
                impS[(hg * 64 + qloc) * 33 + jb] = p3; }
#pragma unroll
            for (int s2 = 0; s2 < 2; ++s2) { const bf16x8 pb = packp(sc, s2);
#pragma unroll
                for (int dt = 0; dt < 4; ++dt) { const bf16x8 a = lds2x4(vl + dt * (32 * 272) + 64 * kt + 32 * s2); oc[dt] = MFMA32(a, pb, oc[dt]); } }
        }
    }
    __syncthreads();
#pragma unroll 1
    for (int e = 0; e < 4; ++e) { const int idx = tid + 512 * e, qq = idx >> 5, j = idx & 31, t = t0 + qq, cur = t >> 6;
        float v = 0.f;
#pragma unroll
        for (int h = 0; h < 4; ++h) { v += impM[(h * 64 + qq) * 33 + j]; if (j > 0) v += impS[(h * 64 + qq) * 33 + j - 1]; }
        const bool forced = (j == 0) || (j == cur) || (j == cur - 1);
        impv[idx] = forced ? 1e6f : (j <= cur ? v : -1e9f); }
    __syncthreads();
#pragma unroll 1
    for (int e = 0; e < 4; ++e) { const int idx = tid + 512 * e, qq = idx >> 5, j = idx & 31;
        const float my = impv[idx]; int rank = 0;
#pragma unroll 8
        for (int j2 = 0; j2 < 32; ++j2) { const float o2 = impv[qq * 32 + j2]; rank += (o2 > my || (o2 == my && j2 < j)) ? 1 : 0; }
        const unsigned long long bal = __ballot(rank < 16);
        if (lane == 0) selm[qq] = (unsigned)bal; if (lane == 32) selm[qq] = (unsigned)(bal >> 32); }
    __syncthreads();
    float gc, gs, gw;
    { const bf16_t* gp = proj + (size_t)(b * TT + tq) * NPROJ + C_GATE + head * 3;
      gc = sigmoidf_(bf2f(gp[0])); gs = sigmoidf_(bf2f(gp[1])); gw = sigmoidf_(bf2f(gp[2])); }
    { float* outs1_ = outs + lane; asm volatile("" : "+v"(outs1_)); GAS float* outs1 = (GAS float*)outs1_;
#pragma unroll
    for (int dt = 0; dt < 4; ++dt)
#pragma unroll
        for (int i = 0; i < 16; ++i) outs1[(dt * 16 + i) * 64] = gc * oc[dt][i]; }
    const unsigned mymask = selm[qloc];
    unsigned uni = selm[lane];
#pragma unroll
    for (int o_ = 32; o_ >= 1; o_ >>= 1) uni |= (unsigned)__shfl_xor((int)uni, o_);
    uni = __builtin_amdgcn_readfirstlane(uni);
    f32x16 o[4]; float m, l;
    {
#pragma unroll
        for (int dt = 0; dt < 4; ++dt)
#pragma unroll
            for (int i = 0; i < 16; ++i) o[dt][i] = 0.f;
        m = NEGF; l = 0.f;
        const bf16_t* kb = proj + (size_t)(b * TT) * NPROJ + C_KS + g * 128;
        const bf16_t* vt = (const bf16_t*)(ws + WS_VTS) + (size_t)bg * 128 * TT;
        const unsigned need = uni & (qt == 31 ? 0xffffffffu : ((1u << (qt + 1)) - 1u));
        attn_branch<0>(smem, kb, vt, need, mymask, t0w, tq, r, hh, qf, lutH, o, m, l);
        const float sc = gs / fmaxf(l, 1e-30f);
        float* outs2_ = outs + lane; asm volatile("" : "+v"(outs2_)); GAS float* outs2 = (GAS float*)outs2_;
        f32x16 pv[4];
#pragma unroll
        for (int dt = 0; dt < 4; ++dt)
#pragma unroll
            for (int i = 0; i < 16; ++i) pv[dt][i] = outs2[(dt * 16 + i) * 64];
        __builtin_amdgcn_sched_barrier(0);
#pragma unroll
        for (int dt = 0; dt < 4; ++dt)
#pragma unroll
            for (int i = 0; i < 16; ++i) outs2[(dt * 16 + i) * 64] = pv[dt][i] + sc * o[dt][i];
    }
    {
#pragma unroll
        for (int dt = 0; dt < 4; ++dt)
#pragma unroll
            for (int i = 0; i < 16; ++i) o[dt][i] = 0.f;
        m = NEGF; l = 0.f;
        const bf16_t* kb = proj + (size_t)(b * TT) * NPROJ + C_KW + g * 128;
        const bf16_t* vt = (const bf16_t*)(ws + WS_VTW) + (size_t)bg * 128 * TT;
        const int jlo = qt >= 8 ? qt - 8 : 0;
        const unsigned need = (qt == 31 ? 0xffffffffu : ((1u << (qt + 1)) - 1u)) & ~((1u << jlo) - 1u);
        attn_branch<1>(smem, kb, vt, need, 0u, t0w, tq, r, hh, qf, lutH, o, m, l);
        const float sc = gw / fmaxf(l, 1e-30f);
        float* outs3_ = outs + lane; asm volatile("" : "+v"(outs3_)); GAS float* outs3 = (GAS float*)outs3_;
        bf16_t* as = (bf16_t*)(ws + WS_AS) + (size_t)(b * TT + tq) * DM + head * 128;
        f32x16 pv[4];
#pragma unroll
        for (int dt = 0; dt < 4; ++dt)
#pragma unroll
            for (int i = 0; i < 16; ++i) pv[dt][i] = outs3[(dt * 16 + i) * 64];
        __builtin_amdgcn_sched_barrier(0);
#pragma unroll
        for (int dt = 0; dt < 4; ++dt)
#pragma unroll
            for (int gi = 0; gi < 4; ++gi) { float v[4];
#pragma unroll
                for (int j = 0; j < 4; ++j) { const int i = 4 * gi + j; v[j] = pv[dt][i] + sc * o[dt][i]; }
                u32x2 w; w.x = pk2(v[0], v[1]); w.y = pk2(v[2], v[3]);
                *(u32x2*)(as + 32 * dt + 8 * gi + 4 * hh) = w; }
    }
}

DI void fill_rstd(const pg8::StaticOrder& S, const float* ss, unsigned char* smem) {
    float* rl = (float*)(smem + 131072);
    for (int i = 0; i < 16; ++i) { pg8::Unit u; if (!S.next(i, u)) break;
        if (threadIdx.x < 256) rl[i * 256 + threadIdx.x] = 1.0f / sqrtf(ss[u.pm * 256 + threadIdx.x] * (1.0f / DM) + EPSN); }
    __syncthreads();
}

#define XB_TMO      128
#define XB_XCNT(j)  (256  + 64 * (j))
#define XB_XSUB(j)  (1280 + 64 * (j))
#define XB_XGEN(j)  (2304 + 64 * (j))
#define XB_TOP      3328
#define XB_TOPGEN   3392
#define XCD_BAR_WORDS 3456
#define XB_SPIN_CAP (1u << 18)
DI unsigned xb_ld(unsigned* p)              { return __hip_atomic_load(p, __ATOMIC_RELAXED, __HIP_MEMORY_SCOPE_AGENT); }
DI unsigned xb_add(unsigned* p, unsigned v) { return __hip_atomic_fetch_add(p, v, __ATOMIC_RELAXED, __HIP_MEMORY_SCOPE_AGENT); }
DI unsigned xb_xcc_id() { return (unsigned)__builtin_amdgcn_s_getreg((3 << 11) | 20) & 0xFu; }
#define XB_SPIN(cond, bar) do { unsigned _sp = 0; while (cond) { __builtin_amdgcn_s_sleep(1); \
    if ((++_sp & 255u) == 0u) { if (xb_ld(&(bar)[XB_TMO])) break; if (_sp > XB_SPIN_CAP) { atomicAdd(&(bar)[XB_TMO], 1u); break; } } } } while (0)
struct XcdBarrier { unsigned* bar; unsigned x; volatile LAS unsigned* st; };
DI XcdBarrier xcd_barrier_post(unsigned* bar, volatile LAS unsigned* st) {
    XcdBarrier b; b.bar = bar; b.x = xb_xcc_id(); b.st = st;
    if (threadIdx.x == 0) (void)xb_add(&bar[XB_XCNT(b.x)], 1u);
    return b;
}
DI void xcd_barrier_complete(unsigned* bar, unsigned x, unsigned& nloc, unsigned& nx) {
    const unsigned G = gridDim.x * gridDim.y * gridDim.z;
    unsigned sum, cnt, mine, sp = 0u;
    for (;;) {
        sum = 0u; cnt = 0u; mine = 0u;
#pragma unroll
        for (unsigned j = 0; j < 16; ++j) { const unsigned c = xb_ld(&bar[XB_XCNT(j)]); sum += c; cnt += (c > 0u) ? 1u : 0u; mine = (j == x) ? c : mine; }
        if (sum == G) break;
        __builtin_amdgcn_s_sleep(1);
        if ((++sp & 255u) == 0u) { if (xb_ld(&bar[XB_TMO])) break; if (sp > XB_SPIN_CAP) { atomicAdd(&bar[XB_TMO], 1u); break; } }
    }
    nloc = mine > 0u ? mine : 1u; nx = cnt > 0u ? cnt : 1u;
}
DI void xcd_barrier(const XcdBarrier& b) {
    asm volatile("s_waitcnt vmcnt(0)" ::: "memory");
    __syncthreads();
    if (threadIdx.x == 0) {
        unsigned* bar = b.bar;
        __builtin_amdgcn_s_waitcnt(0);
        unsigned nloc = b.st[0], nx = b.st[1];
        if (nloc == 0u) { xcd_barrier_complete(bar, b.x, nloc, nx); b.st[0] = nloc; b.st[1] = nx; }
        const unsigned old = xb_add(&bar[XB_XSUB(b.x)], 1u);
        const unsigned gen = old / nloc;
        if (old + 1u == (gen + 1u) * nloc) {
            __builtin_amdgcn_fence(__ATOMIC_RELEASE, "agent");
            asm volatile("s_waitcnt vmcnt(0)" ::: "memory");
            const unsigned og = xb_add(&bar[XB_TOP], 1u);
            const unsigned tg = og / nx;
            if (og + 1u == (tg + 1u) * nx) xb_add(&bar[XB_TOPGEN], 1u);
            else XB_SPIN(xb_ld(&bar[XB_TOPGEN]) == tg, bar);
            __builtin_amdgcn_fence(__ATOMIC_ACQUIRE, "agent");
            xb_add(&bar[XB_XGEN(b.x)], 1u);
            asm volatile("s_waitcnt vmcnt(0)" ::: "memory");
        } else {
            XB_SPIN(xb_ld(&bar[XB_XGEN(b.x)]) == gen, bar);
            __builtin_amdgcn_fence(__ATOMIC_ACQUIRE, "agent");
            asm volatile("s_waitcnt vmcnt(0)" ::: "memory");
        }
    }
    __syncthreads();
}

__global__ void __launch_bounds__(512, 2) hymba_fwd(Params P) {
    extern __shared__ __attribute__((aligned(16))) unsigned char shm[];
    cg::grid_group grid = cg::this_grid();
    unsigned char* ws = P.ws;
    LAS unsigned char* lds = (LAS unsigned char*)shm;
    const int tid = threadIdx.x, G = gridDim.x;
    float* hres = P.out;
    const int lo = P.ph_lo, hi = P.ph_hi;
    volatile LAS unsigned* xbst = (volatile LAS unsigned*)(lds + L_CUR + 16);
    if (tid == 0) { xbst[0] = 0u; xbst[1] = 0u; }
    __syncthreads();
    const XcdBarrier xbar = xcd_barrier_post((unsigned*)((float*)(ws + WS_SMALL) + SM_BAR), xbst);
#define IN(k) (lo <= (k) && (k) < hi)
#define SYNC(k) do { if (IN(k) && IN((k) + 1)) { if ((k) == 0) grid.sync(); else xcd_barrier(xbar); } } while (0)
#ifndef DUP_PH
#define DUP_PH -1
#endif
#define REP(k) for (int rep_ = 0; rep_ < ((k) == DUP_PH ? 2 : 1); ++rep_, (((k) == DUP_PH && rep_ == 1) ? grid.sync() : (void)0))
    if (IN(0)) REP(0) phase_prep(P, shm);
    SYNC(0);
    if (IN(1)) REP(1) { pg8::Gemm g{(const bf16_t*)(ws + WS_XN), (const bf16_t*)(ws + WS_W13A), MTOK, 2 * DFF, DM};
        pg8::StaticOrder S; S.init(MTOK, 2 * DFF, G, (int)blockIdx.x); EpiSwiGLU E{(bf16_t*)(ws + WS_H), nullptr};
        pg8::gemm_phase<EpiSwiGLU, pg8::StaticOrder>(lds, g, S, E); }
    SYNC(1);
    if (IN(2)) REP(2) { pg8::Gemm g{(const bf16_t*)(ws + WS_H), (const bf16_t*)(ws + WS_W2A), MTOK, DM, DFF};
        pg8::StaticOrder S; S.init(MTOK, DM, G, (int)blockIdx.x); EpiResid<0> E{P.in[0], nullptr, nullptr, (bf16_t*)hres, (float*)(ws + WS_SMALL) + SM_SS, 0.5f};
        pg8::gemm_phase<EpiResid<0>, pg8::StaticOrder>(lds, g, S, E); }
    if (IN(2) && hi > 3) xcd_barrier(xbar);
    if (IN(4)) REP(4) {
        if (blockIdx.x == 0 && tid < 256) { float* sm = (float*)(ws + WS_SMALL); const int which = tid >> 7, n = tid & 127; float s = P.in[which ? 13 : 9][n];
            for (int c = 0; c < 128; ++c) s += sm[SM_CBP + (which * 128 + c) * 128 + n];
            sm[SM_CB1 + which * 128 + n] = s; }
        pg8::Gemm g{(const bf16_t*)hres, (const bf16_t*)(ws + WS_WIN), MTOK, NPROJ, DM};
        pg8::StaticOrder S; S.init(MTOK, NPROJ, G, (int)blockIdx.x); EpiProj E{(bf16_t*)(ws + WS_PROJ), (const float*)(ws + WS_SMALL) + SM_SS, (bf16_t*)(ws + WS_VTS), (bf16_t*)(ws + WS_VTW)}; fill_rstd(S, E.ss, shm);
        pg8::gemm_phase<EpiProj, pg8::StaticOrder>(lds, g, S, E); }
    SYNC(4);
    if (IN(5)) REP(5) {
        for (int it = blockIdx.x; it < 254 + 2048; it += G) {
            if (it < 254) compress_item(P, it, shm);
            else { s5_pass1_item(P, it - 254, shm); __syncthreads(); }
        } }
    SYNC(5);
    if (IN(6)) REP(6) {
        int* ctr = (int*)((float*)(ws + WS_SMALL) + SM_CTR) + rep_;
        volatile int* curw = (volatile int*)(shm + L_CUR);
        for (;;) {
            __syncthreads();
            if (tid == 0) *curw = atomicAdd(ctr, 1);
            __syncthreads();
            const int it = *curw;
            if (it >= 512 + 2048) break;
            if (it < 512) attn_item(P, it, shm); else s5_pass3_item(P, it - 512, shm);
        } }
    SYNC(6);
    if (IN(7)) REP(7) { pg8::Gemm g{(const bf16_t*)(ws + WS_HG), (const bf16_t*)(ws + WS_GLUW), MTOK, 1024, 1024};
        pg8::StaticOrder S; S.init(MTOK, 1024, G, (int)blockIdx.x); EpiGLU E{(const bf16_t*)(ws + WS_HG), P.in[25], (bf16_t*)(ws + WS_AS)};
        pg8::gemm_phase<EpiGLU, pg8::StaticOrder>(lds, g, S, E); }
    SYNC(7);
    if (IN(8)) REP(8) { pg8::Gemm g{(const bf16_t*)(ws + WS_AS), (const bf16_t*)(ws + WS_WOUT), MTOK, DM, DM};
        pg8::StaticOrder S; S.init(MTOK, DM, G, (int)blockIdx.x); EpiResid<1> E{nullptr, (const bf16_t*)hres, nullptr, (bf16_t*)(ws + WS_XN), (float*)(ws + WS_SMALL) + SM_SS + 16384, 1.0f};
        pg8::gemm_phase<EpiResid<1>, pg8::StaticOrder>(lds, g, S, E); }
    if (IN(8) && hi > 9) xcd_barrier(xbar);
    if (IN(10)) REP(10) { pg8::Gemm g{(const bf16_t*)(ws + WS_XN), (const bf16_t*)(ws + WS_W13B), MTOK, 2 * DFF, DM};
        pg8::StaticOrder S; S.init(MTOK, 2 * DFF, G, (int)blockIdx.x); EpiSwiGLU E{(bf16_t*)(ws + WS_H), (const float*)(ws + WS_SMALL) + SM_SS + 16384}; fill_rstd(S, E.ss, shm);
        pg8::gemm_phase<EpiSwiGLU, pg8::StaticOrder>(lds, g, S, E); }
    SYNC(10);
    if (IN(11)) REP(11) { pg8::Gemm g{(const bf16_t*)(ws + WS_H), (const bf16_t*)(ws + WS_W2B), MTOK, DM, DFF};
        pg8::StaticOrder S; S.init(MTOK, DM, G, (int)blockIdx.x); EpiResid<2> E{nullptr, (const bf16_t*)(ws + WS_XN), hres, nullptr, nullptr, 0.5f};
        pg8::gemm_phase<EpiResid<2>, pg8::StaticOrder>(lds, g, S, E); }
    SYNC(11);
    if (IN(12)) REP(12) norm_rows(hres, P.in[31], nullptr, hres);
}

#ifndef N_LAUNCH_MODE
#define N_LAUNCH_MODE 0
#endif

extern "C" void kernel_launch(void* const* d_in, const int* in_sizes, int n_in, void* d_out, int out_size, void* d_ws, size_t ws_size, hipStream_t stream) {
    static int grid = 0;
    if (grid == 0) {
        int dev = 0, cus = 0, per_cu = 0;
        hipGetDevice(&dev);
        hipDeviceGetAttribute(&cus, hipDeviceAttributeMultiprocessorCount, dev);
        hipFuncSetAttribute((const void*)hymba_fwd, hipFuncAttributeMaxDynamicSharedMemorySize, LDS_BYTES);
        hipOccupancyMaxActiveBlocksPerMultiprocessor(&per_cu, (const void*)hymba_fwd, 512, LDS_BYTES);
        if (per_cu < 1) { fprintf(stderr, "occupancy query says %d blocks/CU\n", per_cu); per_cu = 1; }
        (void)hipGetLastError();
        grid = cus * 1;
        if (n_in != 32 || ws_size < WS_END) fprintf(stderr, "kernel_launch: unexpected n_in %d / ws %zu\n", n_in, ws_size);
    }
    Params p{};
    for (int i = 0; i < 32; ++i) p.in[i] = (const float*)d_in[i];
    p.out = (float*)d_out; p.ws = (unsigned char*)d_ws;
    (void)hipMemsetAsync((unsigned char*)d_ws + WS_SMALL + (size_t)SM_BAR * 4, 0, XCD_BAR_WORDS * 4, stream);
#if N_LAUNCH_MODE == 0
    p.ph_lo = 0; p.ph_hi = NPH;
    { void* args[] = {&p};
      hipError_t e = hipLaunchCooperativeKernel((const void*)hymba_fwd, dim3(grid), dim3(512), args, LDS_BYTES, stream);
      if (e != hipSuccess) fprintf(stderr, "cooperative launch failed: %s (grid %d)\n", hipGetErrorString(e), grid); }
#else
    for (int ph = 0; ph < NPH; ++ph) { p.ph_lo = ph; p.ph_hi = ph + 1;
        void* args[] = {&p};
        hipError_t e = hipLaunchCooperativeKernel((const void*)hymba_fwd, dim3(grid), dim3(512), args, LDS_BYTES, stream);
        if (e != hipSuccess) fprintf(stderr, "launch %d failed: %s (grid %d)\n", ph, hipGetErrorString(e), grid); }
#endif
}
```

```cpp
#include <hip/hip_runtime.h>
#include <hip/hip_cooperative_groups.h>
#include <cstdio>
namespace cg = cooperative_groups;

#define DI __device__ __forceinline__
#define LAS __attribute__((address_space(3)))
#define GAS __attribute__((address_space(1)))
typedef unsigned short bf16_t;
typedef short bf16x8 __attribute__((ext_vector_type(8)));
typedef short s16x4 __attribute__((ext_vector_type(4)));
typedef float f32x4 __attribute__((ext_vector_type(4)));
typedef float f32x16 __attribute__((ext_vector_type(16)));
typedef unsigned u32x4 __attribute__((ext_vector_type(4)));
typedef unsigned u32x2 __attribute__((ext_vector_type(2)));
typedef __bf16 bf16x2_t __attribute__((ext_vector_type(2)));
typedef float f32x2_t __attribute__((ext_vector_type(2)));

constexpr int MTOK = 16384, DM = 2048, DFF = 5632, TT = 2048;
constexpr int NPROJ = 3840;
constexpr int C_KC = 1024, C_VC = 1280, C_KS = 1536, C_VS = 1792, C_KW = 2048, C_VW = 2304, C_GATE = 2560, C_SSM = 2584;
constexpr float EPSN = 1e-6f;
constexpr float NEGF = -1e30f;

constexpr size_t WS_W13A = 0;
constexpr size_t WS_W2A = WS_W13A + 46137344;
constexpr size_t WS_W13B = WS_W2A + 23068672;
constexpr size_t WS_W2B = WS_W13B + 46137344;
constexpr size_t WS_WIN = WS_W2B + 23068672;
constexpr size_t WS_WOUT = WS_WIN + 15728640;
constexpr size_t WS_GLUW = WS_WOUT + 8388608;
constexpr size_t WS_CW1K = WS_GLUW + 2097152;
constexpr size_t WS_CW1V = WS_CW1K + 1048576;
constexpr size_t WS_CW2K = WS_CW1V + 1048576;
constexpr size_t WS_CW2V = WS_CW2K + 32768;
constexpr size_t WS_SMALL = WS_CW2V + 32768;
constexpr size_t WS_KCB = WS_SMALL + 1048576;
constexpr size_t WS_VCBT = WS_KCB + 524288;
constexpr size_t WS_S5END = WS_VCBT + 524288;
constexpr size_t WS_VTS = WS_S5END + 8388608;
constexpr size_t WS_VTW = WS_VTS + 8388608;
constexpr size_t WS_XN = WS_VTW + 8388608;
constexpr size_t WS_H = WS_XN + 67108864;
constexpr size_t WS_PROJ = WS_H;
constexpr size_t WS_AS = WS_H + 125829120;
constexpr size_t WS_HG = WS_XN;
constexpr size_t WS_OUTS = WS_H + 184549376 + 8388608;
constexpr size_t WS_END = WS_OUTS + 33554432;
constexpr int SM_CB1 = 0;
constexpr int SM_AB = 256;
constexpr int SM_BB = 256 + 16384;
constexpr int SM_CTR = 256 + 16384 + 131072;
constexpr int SM_CBP = SM_CTR + 64;
constexpr int SM_SS = SM_CBP + 32768;
constexpr int SM_BAR = 213504;

constexpr int LDS_BYTES = 151552;
constexpr int L_CUR = 149776;
constexpr int NPH = 13;

struct Params { const float* in[32]; float* out; unsigned char* ws; int ph_lo, ph_hi; };

DI unsigned pk2(float a, float b) { f32x2_t v = {a, b}; return __builtin_bit_cast(unsigned, __builtin_convertvector(v, bf16x2_t)); }
DI float bf2f(unsigned x) { return __uint_as_float(x << 16); }
DI float bflo(unsigned w) { return __uint_as_float(w << 16); }
DI float bfhi(unsigned w) { return __uint_as_float(w & 0xffff0000u); }
DI float sigmoidf_(float x) { return __builtin_amdgcn_rcpf(1.0f + __builtin_amdgcn_exp2f(-1.4426950408889634f * x)); }
DI float gelu_tanh(float v) { const float z = 0.7978845608028654f * (v + 0.044715f * v * v * v); const float th = 1.0f - 2.0f * __builtin_amdgcn_rcpf(__builtin_amdgcn_exp2f(2.8853900817779268f * z) + 1.0f); return 0.5f * v * (1.0f + th); }

namespace pg8 {
constexpr int BM = 256, BK = 64, HALF = 128, HTB = HALF * BK * 2, STAGE_BYTES = 8 * HTB, NXCD = 8, WGM = 8;
__host__ __device__ __forceinline__ int lds_byte(int r, int c) { const int st = (r >> 4) * 2 + (c >> 5), rr = r & 15, cc = c & 31, ob = rr * 64 + cc * 2; return st * 1024 + (ob ^ (((ob >> 9) & 1) << 5)); }
__host__ __device__ __forceinline__ void stage_rc(int b, int& R, int& C) { const int st = b / 1024, sb = b % 1024, swz = sb ^ (((sb >> 9) & 1) << 5); R = (st >> 1) * 16 + swz / 64; C = (st & 1) * 32 + (swz % 64) / 2; }
__host__ __device__ __forceinline__ int perm32(int rho) { const int n = rho >> 4, i = rho & 15; return 8 * (i >> 2) + 4 * n + (i & 3); }
struct Unit { int pm, pn; };
struct Gemm { const bf16_t* A; const bf16_t* Bt; int M, N, K; };
struct StaticOrder {
    int nM, nN, nwg, G, c;
    __host__ __device__ void init(int M, int N, int G_, int c_) { nM = M / BM; nN = N / BM; nwg = nM * nN; G = G_; c = c_; }
    __host__ __device__ bool next(int i, Unit& u) const {
        const long L = (long)i * G + c; if (L >= nwg) return false;
        int wgid = (int)L; { const int q = nwg / NXCD, r = nwg % NXCD, xcd = wgid % NXCD, off = wgid / NXCD; wgid = (xcd < r ? xcd * (q + 1) : r * (q + 1) + (xcd - r) * q) + off; }
        const int nig = WGM * nN, gid = wgid / nig, fm = gid * WGM, gsz = (nM - fm) < WGM ? (nM - fm) : WGM;
        u.pm = fm + ((wgid % nig) % gsz); u.pn = (wgid % nig) / gsz; return true;
    }
    __device__ __forceinline__ void a_ready(const Unit&) const {}
    __device__ __forceinline__ void done(const Unit&) const {}
};

template <class Epi, class Sched>
__device__ __forceinline__ void gemm_phase(LAS unsigned char* lds, const Gemm g, const Sched& S, const Epi& E) {
    const int tid = threadIdx.x, wid = __builtin_amdgcn_readfirstlane(tid >> 6), lane = tid & 63, wr = wid >> 2, wc = wid & 3, fr = lane & 15, fq = lane >> 4;
    const int K = g.K, nt = K / BK;
    unsigned voffA[2], voffB[2];
#pragma unroll
    for (int i = 0; i < 2; ++i) { int R, C; stage_rc(tid * 16 + i * 8192, R, C); const int Rb = Epi::PERM ? ((R & ~31) + perm32(R & 31)) : R;
        voffA[i] = (unsigned)(R * K + C) * 2u; voffB[i] = (unsigned)(Rb * K + C) * 2u; }
    const size_t kstep = (size_t)(BK * 2);
    const size_t hstep = (size_t)HALF * K * 2;
    const size_t tstep = 2 * hstep;
    const unsigned ldsw = (unsigned)wid * 1024u;
    const int aoff = lds_byte(wr * 64 + fr, fq * 8), boff = lds_byte(wc * 32 + fr, fq * 8);
#define PG8_SA(b, h) (((b) * 2 + (h)) * HTB)
#define PG8_SB(b, h) ((4 + (b) * 2 + (h)) * HTB)
#define PG8_STAGE(bufoff, gbase, voff) do { _Pragma("unroll") for (int _i = 0; _i < 2; ++_i) \
        __builtin_amdgcn_global_load_lds((const unsigned*)((const char*)(gbase) + (voff)[_i]), (LAS unsigned*)(lds + (bufoff) + ldsw + _i * 8192), 16, 0, 0); } while (0)
#define PG8_LDA(dst, b, h) do { _Pragma("unroll") for (int m = 0; m < 4; ++m) _Pragma("unroll") for (int k = 0; k < 2; ++k) dst[m][k] = *(const LAS bf16x8*)(lds + PG8_SA(b, h) + aoff + m * 2048 + k * 1024); } while (0)
#define PG8_LDB(dst, b, h) do { _Pragma("unroll") for (int n = 0; n < 2; ++n) _Pragma("unroll") for (int k = 0; k < 2; ++k) dst[n][k] = *(const LAS bf16x8*)(lds + PG8_SB(b, h) + boff + n * 2048 + k * 1024); } while (0)
#define PG8_MMA(ai, bj, At, Bt) do { __builtin_amdgcn_s_setprio(1); _Pragma("unroll") for (int m = 0; m < 4; ++m) _Pragma("unroll") for (int n = 0; n < 2; ++n) _Pragma("unroll") for (int k = 0; k < 2; ++k) \
        acc[ai][bj][m][n] = __builtin_amdgcn_mfma_f32_16x16x32_bf16(Bt[n][k], At[m][k], acc[ai][bj][m][n], 0, 0, 0); __builtin_amdgcn_s_setprio(0); } while (0)
#define PG8_WAIT_V(n) asm volatile("s_waitcnt vmcnt(" #n ")" ::: "memory")
#define PG8_WAIT_L(n) asm volatile("s_waitcnt lgkmcnt(" #n ")" ::: "memory")
#define PG8_BAR __builtin_amdgcn_s_barrier()
#define PG8_SCHED __builtin_amdgcn_sched_barrier(0)
    Unit cur, nxt; int ui = 0;
    if (!S.next(0, cur)) return;
    f32x4 acc[2][2][4][2];
#pragma unroll
    for (int a = 0; a < 2; ++a)
#pragma unroll
        for (int b = 0; b < 2; ++b)
#pragma unroll
            for (int m = 0; m < 4; ++m)
#pragma unroll
                for (int n = 0; n < 2; ++n) acc[a][b][m][n] = (f32x4){0.f, 0.f, 0.f, 0.f};
    bf16x8 At[4][2], B0[2][2], B1[2][2];
    const char* cA = (const char*)g.A + (size_t)cur.pm * tstep; const char* cB = (const char*)g.Bt + (size_t)cur.pn * tstep;
    S.a_ready(cur);
    PG8_STAGE(PG8_SB(0, 0), cB, voffB); PG8_STAGE(PG8_SA(0, 0), cA, voffA); PG8_STAGE(PG8_SB(0, 1), cB + hstep, voffB); PG8_STAGE(PG8_SA(0, 1), cA + hstep, voffA);
    if (wr == 1) PG8_BAR;
    PG8_WAIT_V(4); PG8_BAR;
    PG8_STAGE(PG8_SB(1, 0), cB + kstep, voffB); PG8_STAGE(PG8_SA(1, 0), cA + kstep, voffA); PG8_STAGE(PG8_SB(1, 1), cB + hstep + kstep, voffB);
    PG8_WAIT_V(6); PG8_BAR;
    for (;;) {
        const bool has_next = S.next(ui + 1, nxt);
        const char* nA = has_next ? (const char*)g.A + (size_t)nxt.pm * tstep : cA; const char* nB = has_next ? (const char*)g.Bt + (size_t)nxt.pn * tstep : cB;
        for (int t = 0; t < nt; t += 2) {
            const bool last = (t == nt - 2);
            const char* a1 = cA + (size_t)(t + 1) * kstep;
            const char* a2 = last ? nA : cA + (size_t)(t + 2) * kstep; const char* b2 = last ? nB : cB + (size_t)(t + 2) * kstep;
            const char* a3 = a2 + kstep; const char* b3 = b2 + kstep;
            if (last && has_next) S.a_ready(nxt);
            PG8_LDB(B0, 0, 0); PG8_SCHED; PG8_LDA(At, 0, 0); PG8_STAGE(PG8_SA(1, 1), a1 + hstep, voffA);
            PG8_WAIT_L(8); PG8_BAR; PG8_WAIT_L(0); PG8_MMA(0, 0, At, B0); PG8_BAR; PG8_SCHED;
            PG8_LDB(B1, 0, 1); PG8_STAGE(PG8_SB(0, 0), b2, voffB);
            PG8_BAR; PG8_WAIT_L(0); PG8_MMA(0, 1, At, B1); PG8_BAR;
            PG8_LDA(At, 0, 1); PG8_STAGE(PG8_SA(0, 0), a2, voffA);
            PG8_BAR; PG8_WAIT_L(0); PG8_MMA(1, 0, At, B0); PG8_BAR; PG8_SCHED;
            PG8_STAGE(PG8_SB(0, 1), b2 + hstep, voffB);
            PG8_WAIT_V(6); PG8_BAR; PG8_MMA(1, 1, At, B1); PG8_BAR;
            PG8_LDB(B0, 1, 0); PG8_SCHED; PG8_LDA(At, 1, 0); PG8_STAGE(PG8_SA(0, 1), a2 + hstep, voffA);
            PG8_WAIT_L(8); PG8_BAR; PG8_WAIT_L(0); PG8_MMA(0, 0, At, B0); PG8_BAR; PG8_SCHED;
            PG8_LDB(B1, 1, 1); PG8_STAGE(PG8_SB(1, 0), b3, voffB);
            PG8_BAR; PG8_WAIT_L(0); PG8_MMA(0, 1, At, B1); PG8_BAR;
            PG8_LDA(At, 1, 1); PG8_STAGE(PG8_SA(1, 0), a3, voffA);
            PG8_BAR; PG8_WAIT_L(0); PG8_MMA(1, 0, At, B0); PG8_BAR; PG8_SCHED;
            PG8_STAGE(PG8_SB(1, 1), b3 + hstep, voffB);
            PG8_WAIT_V(6); PG8_BAR; PG8_MMA(1, 1, At, B1); PG8_BAR;
        }
        E(acc, cur, wr, wc, fr, fq, ui, lds); S.done(cur);
        if (!has_next) break;
#pragma unroll
        for (int a = 0; a < 2; ++a)
#pragma unroll
            for (int b = 0; b < 2; ++b)
#pragma unroll
                for (int m = 0; m < 4; ++m)
#pragma unroll
                    for (int n = 0; n < 2; ++n) acc[a][b][m][n] = (f32x4){0.f, 0.f, 0.f, 0.f};
        cur = nxt; cA = nA; cB = nB; ++ui;
    }
    PG8_WAIT_V(0);
    if (wr == 0) PG8_BAR;
    PG8_BAR;
#undef PG8_SA
#undef PG8_SB
#undef PG8_STAGE
#undef PG8_LDA
#undef PG8_LDB
#undef PG8_MMA
#undef PG8_WAIT_V
#undef PG8_WAIT_L
#undef PG8_BAR
#undef PG8_SCHED
}
}

struct EpiSwiGLU {
    static constexpr bool PERM = true;
    bf16_t* H; const float* ss;
    DI void operator()(const f32x4 (&acc)[2][2][4][2], const pg8::Unit& u, int wr, int wc, int fr, int fq, int ui, LAS unsigned char* lds) const {
        const int row0 = u.pm * 256 + wr * 64 + fr, col0 = u.pn * 128 + wc * 32 + 8 * fq;
#pragma unroll
        for (int ai = 0; ai < 2; ++ai)
#pragma unroll
            for (int m = 0; m < 4; ++m) {
                const float rs = ss ? ((const LAS float*)(lds + 131072))[ui * 256 + wr * 64 + fr + ai * 128 + m * 16] : 1.0f;
                float v[8];
#pragma unroll
                for (int n = 0; n < 2; ++n)
#pragma unroll
                    for (int j = 0; j < 4; ++j) { const float gt = acc[ai][0][m][n][j] * rs, up = acc[ai][1][m][n][j] * rs; v[n * 4 + j] = gt * up * __builtin_amdgcn_rcpf(1.0f + __builtin_amdgcn_exp2f(-1.4426950408889634f * gt)); }
                u32x4 w; w.x = pk2(v[0], v[1]); w.y = pk2(v[2], v[3]); w.z = pk2(v[4], v[5]); w.w = pk2(v[6], v[7]);
                *(u32x4*)(H + (size_t)(row0 + ai * 128 + m * 16) * DFF + col0) = w;
            }
    }
};
template <int MODE> struct EpiResid {
    static constexpr bool PERM = true;
    const float* basef; const bf16_t* baseb; float* outf; bf16_t* hb; float* ss; float scale;
    DI void operator()(const f32x4 (&acc)[2][2][4][2], const pg8::Unit& u, int wr, int wc, int fr, int fq, int ui, LAS unsigned char* lds) const {
        const int row0 = u.pm * 256 + wr * 64 + fr, col0 = u.pn * 256 + wc * 32 + 8 * fq;
#pragma unroll
        for (int ai = 0; ai < 2; ++ai) {
            f32x4 bf0[4][2], bf1[4][2]; u32x4 bw[4][2];
#pragma unroll
            for (int m = 0; m < 4; ++m)
#pragma unroll
                for (int bj = 0; bj < 2; ++bj) { const size_t off = (size_t)(row0 + ai * 128 + m * 16) * DM + col0 + bj * 128;
                    if (MODE == 0) { bf0[m][bj] = *(const f32x4*)(basef + off); bf1[m][bj] = *(const f32x4*)(basef + off + 4); }
                    else bw[m][bj] = *(const u32x4*)(baseb + off); }
            __builtin_amdgcn_sched_barrier(0);
#pragma unroll
            for (int m = 0; m < 4; ++m) { const int row = row0 + ai * 128 + m * 16; const size_t off = (size_t)row * DM + col0; float rsum = 0.f;
#pragma unroll
                for (int bj = 0; bj < 2; ++bj) {
                    f32x4 b0, b1;
                    if (MODE == 0) { b0 = bf0[m][bj]; b1 = bf1[m][bj]; }
                    else { const u32x4 w = bw[m][bj]; b0 = (f32x4){bflo(w.x), bfhi(w.x), bflo(w.y), bfhi(w.y)}; b1 = (f32x4){bflo(w.z), bfhi(w.z), bflo(w.w), bfhi(w.w)}; }
                    const f32x4 v0 = b0 + acc[ai][bj][m][0] * scale, v1 = b1 + acc[ai][bj][m][1] * scale;
                    if (MODE == 2) { *(f32x4*)(outf + off + bj * 128) = v0; *(f32x4*)(outf + off + bj * 128 + 4) = v1; }
                    else { rsum += (v0[0] * v0[0] + v0[1] * v0[1]) + (v0[2] * v0[2] + v0[3] * v0[3]) + (v1[0] * v1[0] + v1[1] * v1[1]) + (v1[2] * v1[2] + v1[3] * v1[3]);
                        u32x4 w; w.x = pk2(v0[0], v0[1]); w.y = pk2(v0[2], v0[3]); w.z = pk2(v1[0], v1[1]); w.w = pk2(v1[2], v1[3]);
                        *(u32x4*)(hb + off + bj * 128) = w; } }
                if (MODE != 2) { rsum += __shfl_xor(rsum, 16); rsum += __shfl_xor(rsum, 32); if (fq == 0) atomicAdd(ss + row, rsum); } }
        }
    }
};
struct EpiProj {
    static constexpr bool PERM = true;
    bf16_t* O; const float* ss; bf16_t* vts; bf16_t* vtw;
    DI void operator()(const f32x4 (&acc)[2][2][4][2], const pg8::Unit& u, int wr, int wc, int fr, int fq, int ui, LAS unsigned char* lds) const {
        const int row0 = u.pm * 256 + wr * 64 + fr, col0 = u.pn * 256 + wc * 32 + 8 * fq;
        const bool tr = (u.pn == 7) || (u.pn == 9);
#pragma unroll
        for (int ai = 0; ai < 2; ++ai)
#pragma unroll
            for (int m = 0; m < 4; ++m) { const int row = row0 + ai * 128 + m * 16; bf16_t* rowp = O + (size_t)row * NPROJ + col0;
                const float rs = ((const LAS float*)(lds + 131072))[ui * 256 + wr * 64 + fr + ai * 128 + m * 16];
#pragma unroll
                for (int bj = 0; bj < 2; ++bj) { const f32x4 v0 = acc[ai][bj][m][0] * rs, v1 = acc[ai][bj][m][1] * rs;
                    u32x4 w; w.x = pk2(v0[0], v0[1]); w.y = pk2(v0[2], v0[3]); w.z = pk2(v1[0], v1[1]); w.w = pk2(v1[2], v1[3]);
                    if (!tr) *(u32x4*)(rowp + bj * 128) = w;
                    else { bf16_t* vt = (u.pn == 7 ? vts : vtw) + ((size_t)((row >> 11) * 2 + bj) * 128 + wc * 32 + 8 * fq) * TT + (row & 2047);
                        vt[0 * TT] = (bf16_t)(w.x & 0xffffu); vt[1 * TT] = (bf16_t)(w.x >> 16); vt[2 * TT] = (bf16_t)(w.y & 0xffffu); vt[3 * TT] = (bf16_t)(w.y >> 16);
                        vt[4 * TT] = (bf16_t)(w.z & 0xffffu); vt[5 * TT] = (bf16_t)(w.z >> 16); vt[6 * TT] = (bf16_t)(w.w & 0xffffu); vt[7 * TT] = (bf16_t)(w.w >> 16); } } }
    }
};
struct EpiGLU {
    static constexpr bool PERM = true;
    const bf16_t* HG; const float* bias; bf16_t* AS;
    DI void operator()(const f32x4 (&acc)[2][2][4][2], const pg8::Unit& u, int wr, int wc, int fr, int fq, int ui, LAS unsigned char* lds) const {
        const int row0 = u.pm * 256 + wr * 64 + fr, col0 = u.pn * 256 + wc * 32 + 8 * fq;
        f32x4 bs[2][2];
#pragma unroll
        for (int bj = 0; bj < 2; ++bj) { bs[bj][0] = *(const f32x4*)(bias + col0 + bj * 128); bs[bj][1] = *(const f32x4*)(bias + col0 + bj * 128 + 4); }
#pragma unroll
        for (int ai = 0; ai < 2; ++ai) {
            u32x4 hw[4][2];
#pragma unroll
            for (int m = 0; m < 4; ++m)
#pragma unroll
                for (int bj = 0; bj < 2; ++bj) hw[m][bj] = *(const u32x4*)(HG + (size_t)(row0 + ai * 128 + m * 16) * 1024 + col0 + bj * 128);
            __builtin_amdgcn_sched_barrier(0);
#pragma unroll
            for (int m = 0; m < 4; ++m) { const int row = row0 + ai * 128 + m * 16;
#pragma unroll
                for (int bj = 0; bj < 2; ++bj) { const int col = col0 + bj * 128; const u32x4 h = hw[m][bj];
                    const f32x4 v0 = acc[ai][bj][m][0] + bs[bj][0], v1 = acc[ai][bj][m][1] + bs[bj][1];
                    u32x4 w;
                    w.x = pk2(bflo(h.x) * sigmoidf_(v0[0]), bfhi(h.x) * sigmoidf_(v0[1]));
                    w.y = pk2(bflo(h.y) * sigmoidf_(v0[2]), bfhi(h.y) * sigmoidf_(v0[3]));
                    w.z = pk2(bflo(h.z) * sigmoidf_(v1[0]), bfhi(h.z) * sigmoidf_(v1[1]));
                    w.w = pk2(bflo(h.w) * sigmoidf_(v1[2]), bfhi(h.w) * sigmoidf_(v1[3]));
                    *(u32x4*)(AS + (size_t)row * DM + 1024 + col) = w; } }
        }
    }
};

DI void tconv(const float* __restrict__ src, int K, int N, int Npad, bf16_t* __restrict__ dst, int mode, float* tile, const float* __restrict__ gk = nullptr) {
    const int tid = threadIdx.x, ntk = K >> 6, ntn = Npad >> 7, ntile = ntk * ntn;
    f32x4 v[4];
    float gv[4];
#define TC_LOAD(tt) do { const int tk_ = (tt) % ntk, tn_ = (tt) / ntk; \
        _Pragma("unroll") for (int e = 0; e < 4; ++e) { const int i = tid + 512 * e, r = i >> 5, n = tn_ * 128 + (i & 31) * 4, nn = n < N ? n : N - 4; \
            v[e] = *(const f32x4*)(src + (size_t)(tk_ * 64 + r) * N + nn); gv[e] = gk ? gk[tk_ * 64 + r] : 1.0f; } } while (0)
    int t = blockIdx.x;
    if (t < ntile) TC_LOAD(t);
    for (; t < ntile; t += gridDim.x) {
#pragma unroll
        for (int e = 0; e < 4; ++e) { const int i = tid + 512 * e, r = i >> 5, c = (i & 31) * 4; const bool ok = (t / ntk) * 128 + c < N;
            const f32x4 x = ok ? v[e] * gv[e] : (f32x4){0.f, 0.f, 0.f, 0.f};
            tile[r * 129 + c] = x[0]; tile[r * 129 + c + 1] = x[1]; tile[r * 129 + c + 2] = x[2]; tile[r * 129 + c + 3] = x[3]; }
        __syncthreads();
        const int tk = t % ntk, tn = t / ntk;
        if (t + (int)gridDim.x < ntile) TC_LOAD(t + (int)gridDim.x);
        { const int nl = tid >> 2, kg = tid & 3, n = tn * 128 + nl;
          float x[16];
#pragma unroll
          for (int j = 0; j < 16; ++j) x[j] = tile[(kg * 16 + j) * 129 + nl];
          const int drow = mode == 0 ? n : (tn * 256 + nl + (mode == 2 ? 128 : 0));
          u32x4 w0, w1; w0.x = pk2(x[0], x[1]); w0.y = pk2(x[2], x[3]); w0.z = pk2(x[4], x[5]); w0.w = pk2(x[6], x[7]);
          w1.x = pk2(x[8], x[9]); w1.y = pk2(x[10], x[11]); w1.z = pk2(x[12], x[13]); w1.w = pk2(x[14], x[15]);
          u32x4* dp = (u32x4*)(dst + (size_t)drow * K + tk * 64 + kg * 16); dp[0] = w0; dp[1] = w1; }
        __syncthreads();
    }
#undef TC_LOAD
}

DI void norm_rows(const float* src, const float* __restrict__ g, bf16_t* dstb, float* dstf) {
    const int wid = threadIdx.x >> 6, lane = threadIdx.x & 63, stride = gridDim.x * 8;
    for (int row = blockIdx.x * 8 + wid; row < MTOK; row += 2 * stride) {
        const int row2 = row + stride; const bool has2 = row2 < MTOK;
        const f32x4* p = (const f32x4*)(src + (size_t)row * DM); const f32x4* p2 = (const f32x4*)(src + (size_t)(has2 ? row2 : row) * DM);
        f32x4 v[8], w[8]; float ss = 0.f, ss2 = 0.f;
#pragma unroll
        for (int i = 0; i < 8; ++i) { v[i] = p[lane + 64 * i]; w[i] = p2[lane + 64 * i]; }
#pragma unroll
        for (int i = 0; i < 8; ++i) { ss += v[i][0] * v[i][0] + v[i][1] * v[i][1] + v[i][2] * v[i][2] + v[i][3] * v[i][3]; ss2 += w[i][0] * w[i][0] + w[i][1] * w[i][1] + w[i][2] * w[i][2] + w[i][3] * w[i][3]; }
#pragma unroll
        for (int o = 32; o >= 1; o >>= 1) { ss += __shfl_xor(ss, o); ss2 += __shfl_xor(ss2, o); }
        const float rstd = 1.0f / sqrtf(ss * (1.0f / DM) + EPSN), rstd2 = 1.0f / sqrtf(ss2 * (1.0f / DM) + EPSN);
#pragma unroll
        for (int i = 0; i < 8; ++i) { const f32x4 gg = ((const f32x4*)g)[lane + 64 * i]; const f32x4 y = v[i] * rstd * gg, y2 = w[i] * rstd2 * gg;
            if (dstb) { u32x2 o; o.x = pk2(y[0], y[1]); o.y = pk2(y[2], y[3]); *(u32x2*)(dstb + (size_t)row * DM + (lane + 64 * i) * 4) = o;
                        if (has2) { u32x2 o2; o2.x = pk2(y2[0], y2[1]); o2.y = pk2(y2[2], y2[3]); *(u32x2*)(dstb + (size_t)row2 * DM + (lane + 64 * i) * 4) = o2; } }
            else { ((f32x4*)(dstf + (size_t)row * DM))[lane + 64 * i] = y; if (has2) ((f32x4*)(dstf + (size_t)row2 * DM))[lane + 64 * i] = y2; } }
    }
}

DI void phase_prep(const Params& P, unsigned char* smem) {
    unsigned char* ws = P.ws; float* tile = (float*)smem; const int tid = threadIdx.x;
    float* sm = (float*)(ws + WS_SMALL);
    if (blockIdx.x < 8) { const int idx = blockIdx.x * 512 + tid, grp = idx >> 6;
        const float step = expf(P.in[18][grp]), lre = P.in[16][idx], lim = P.in[17][idx];
        const float mag = expf(lre * step), ar = mag * cosf(lim * step), ai = mag * sinf(lim * step);
        const float nr = ar - 1.0f, ni = ai, den = lre * lre + lim * lim, fre = (nr * lre + ni * lim) / den, fim = (ni * lre - nr * lim) / den;
        f32x4 brv[4], biv[4];
#pragma unroll
        for (int k = 0; k < 4; ++k) { brv[k] = *(const f32x4*)(P.in[19] + idx * 16 + 4 * k); biv[k] = *(const f32x4*)(P.in[20] + idx * 16 + 4 * k); }
        bf16_t* tb = (bf16_t*)(sm + SM_BB); const int p = idx & 63;
        unsigned hre[16], lre_[16], him[16], lim_[16];
#pragma unroll
        for (int h = 0; h < 16; ++h) { const float br = brv[h >> 2][h & 3], bi = biv[h >> 2][h & 3];
            const float vre = fre * br - fim * bi, vim = fre * bi + fim * br;
            hre[h] = pk2(vre, 0.f) & 0xffffu; lre_[h] = pk2(vre - bf2f(hre[h]), 0.f) & 0xffffu;
            him[h] = pk2(vim, 0.f) & 0xffffu; lim_[h] = pk2(vim - bf2f(him[h]), 0.f) & 0xffffu; }
        { u32x4* d = (u32x4*)(tb + (grp * 128 + p) * 32);
          d[0] = (u32x4){hre[0] | (hre[1] << 16), hre[2] | (hre[3] << 16), hre[4] | (hre[5] << 16), hre[6] | (hre[7] << 16)};
          d[1] = (u32x4){hre[8] | (hre[9] << 16), hre[10] | (hre[11] << 16), hre[12] | (hre[13] << 16), hre[14] | (hre[15] << 16)};
          d[2] = (u32x4){lre_[0] | (lre_[1] << 16), lre_[2] | (lre_[3] << 16), lre_[4] | (lre_[5] << 16), lre_[6] | (lre_[7] << 16)};
          d[3] = (u32x4){lre_[8] | (lre_[9] << 16), lre_[10] | (lre_[11] << 16), lre_[12] | (lre_[13] << 16), lre_[14] | (lre_[15] << 16)};
          u32x4* e = (u32x4*)(tb + (grp * 128 + 64 + p) * 32);
          e[0] = (u32x4){him[0] | (him[1] << 16), him[2] | (him[3] << 16), him[4] | (him[5] << 16), him[6] | (him[7] << 16)};
          e[1] = (u32x4){him[8] | (him[9] << 16), him[10] | (him[11] << 16), him[12] | (him[13] << 16), him[14] | (him[15] << 16)};
          e[2] = (u32x4){lim_[0] | (lim_[1] << 16), lim_[2] | (lim_[3] << 16), lim_[4] | (lim_[5] << 16), lim_[6] | (lim_[7] << 16)};
          e[3] = (u32x4){lim_[8] | (lim_[9] << 16), lim_[10] | (lim_[11] << 16), lim_[12] | (lim_[13] << 16), lim_[14] | (lim_[15] << 16)}; }
        float pr = ar, pi = ai;
        for (int s = 0; s < 6; ++s) { const float nr2 = pr * pr - pi * pi, ni2 = 2.0f * pr * pi; pr = nr2; pi = ni2; }
        sm[SM_AB + idx * 4 + 0] = ar; sm[SM_AB + idx * 4 + 1] = ai; sm[SM_AB + idx * 4 + 2] = pr; sm[SM_AB + idx * 4 + 3] = pi; }
    { const int which = blockIdx.x >> 7, chunk = blockIdx.x & 127; const float* pe = P.in[which ? 11 : 7]; const float* w1 = P.in[which ? 12 : 8];
      if (blockIdx.x < 256) {
        const int n = tid & 127, sub = tid >> 7; float s = 0.f;
#pragma unroll
        for (int j = 0; j < 8; ++j) { const int k = chunk * 32 + sub * 8 + j; s += pe[k] * w1[(size_t)k * 128 + n]; }
        tile[tid] = s; __syncthreads();
        if (tid < 128) sm[SM_CBP + (which * 128 + chunk) * 128 + tid] = (tile[tid] + tile[tid + 128]) + (tile[tid + 256] + tile[tid + 384]);
        __syncthreads(); } }
    if (blockIdx.x == 10 && tid == 0) { ((int*)(sm + SM_CTR))[0] = 0; ((int*)(sm + SM_CTR))[1] = 0; }
    for (int i = blockIdx.x * 512 + tid; i < 32768; i += gridDim.x * 512) sm[SM_SS + i] = 0.f;
    { u32x4* z = (u32x4*)(ws + WS_KCB); const u32x4 zero = {0u, 0u, 0u, 0u};
      for (int i = blockIdx.x * 512 + tid; i < 65536; i += gridDim.x * 512) z[i] = zero; }
    norm_rows(P.in[0], P.in[1], (bf16_t*)(ws + WS_XN), nullptr);
    tconv(P.in[2], DM, DFF, DFF, (bf16_t*)(ws + WS_W13A), 1, tile);
    tconv(P.in[3], DM, DFF, DFF, (bf16_t*)(ws + WS_W13A), 2, tile);
    tconv(P.in[4], DFF, DM, DM, (bf16_t*)(ws + WS_W2A), 0, tile);
    tconv(P.in[6], DM, 3608, NPROJ, (bf16_t*)(ws + WS_WIN), 0, tile, P.in[5]);
    tconv(P.in[8], 4096, 128, 128, (bf16_t*)(ws + WS_CW1K), 0, tile);
    tconv(P.in[12], 4096, 128, 128, (bf16_t*)(ws + WS_CW1V), 0, tile);
    tconv(P.in[10], 128, 128, 128, (bf16_t*)(ws + WS_CW2K), 0, tile);
    tconv(P.in[14], 128, 128, 128, (bf16_t*)(ws + WS_CW2V), 0, tile);
    tconv(P.in[24], 1024, 1024, 1024, (bf16_t*)(ws + WS_GLUW), 0, tile);
    tconv(P.in[26], DM, DM, DM, (bf16_t*)(ws + WS_WOUT), 0, tile);
    tconv(P.in[28], DM, DFF, DFF, (bf16_t*)(ws + WS_W13B), 1, tile, P.in[27]);
    tconv(P.in[29], DM, DFF, DFF, (bf16_t*)(ws + WS_W13B), 2, tile, P.in[27]);
    tconv(P.in[30], DFF, DM, DM, (bf16_t*)(ws + WS_W2B), 0, tile);
}

DI void compress_item(const Params& P, int item, unsigned char* smem) {
    unsigned char* ws = P.ws; const int tid = threadIdx.x, wid = tid >> 6, lane = tid & 63, r = lane & 15, q = lane >> 4;
    const int which = item / 127, rt = item % 127;
    const bf16_t* proj = (const bf16_t*)(ws + WS_PROJ);
    const bf16_t* w1t = (const bf16_t*)(ws + (which ? WS_CW1V : WS_CW1K));
    const bf16_t* w2t = (const bf16_t*)(ws + (which ? WS_CW2V : WS_CW2K));
    const float* cb1 = (const float*)(ws + WS_SMALL) + SM_CB1 + which * 128;
    float* part = (float*)smem;
    bf16_t* hid = (bf16_t*)(smem + 65536);
    const int grow = rt * 16 + r, bg = grow / 127, c = grow % 127, b = bg >> 1, g = bg & 1;
    const bf16_t* arow = proj + (size_t)(b * TT + 16 * c) * NPROJ + (which ? C_VC : C_KC) + g * 128;
    f32x4 acc[8];
#pragma unroll
    for (int ct = 0; ct < 8; ++ct) acc[ct] = (f32x4){0.f, 0.f, 0.f, 0.f};
    bf16x8 fa[2], fb[2][8];
#define CP_LOAD(buf, s_) do { const int kabs_ = 512 * wid + 32 * (s_) + 8 * q; fa[buf] = *(const bf16x8*)(arow + (size_t)(kabs_ >> 7) * NPROJ + (kabs_ & 127)); \
        _Pragma("unroll") for (int ct = 0; ct < 8; ++ct) fb[buf][ct] = *(const bf16x8*)(w1t + (size_t)(ct * 16 + r) * 4096 + kabs_); } while (0)
    CP_LOAD(0, 0);
#pragma unroll
    for (int s = 0; s < 16; ++s) {
        if (s + 1 < 16) CP_LOAD((s + 1) & 1, s + 1);
        __builtin_amdgcn_sched_barrier(0);
#pragma unroll
        for (int ct = 0; ct < 8; ++ct) acc[ct] = __builtin_amdgcn_mfma_f32_16x16x32_bf16(fa[s & 1], fb[s & 1][ct], acc[ct], 0, 0, 0);
        __builtin_amdgcn_sched_barrier(0);
    }
#undef CP_LOAD
#pragma unroll
    for (int ct = 0; ct < 8; ++ct)
#pragma unroll
        for (int j = 0; j < 4; ++j) part[(wid * 16 + 4 * q + j) * 128 + ct * 16 + r] = acc[ct][j];
    __syncthreads();
    { const int row = tid >> 5, c4 = (tid & 31) * 4; f32x4 s = *(const f32x4*)(cb1 + c4);
#pragma unroll
      for (int w = 0; w < 8; ++w) s += *(const f32x4*)(part + (w * 16 + row) * 128 + c4);
      u32x2 o; o.x = pk2(gelu_tanh(s[0]), gelu_tanh(s[1])); o.y = pk2(gelu_tanh(s[2]), gelu_tanh(s[3]));
      *(u32x2*)(hid + row * 136 + c4) = o; }
    __syncthreads();
    { f32x4 a2 = {0.f, 0.f, 0.f, 0.f};
#pragma unroll
      for (int s = 0; s < 4; ++s) { const bf16x8 a = *(const bf16x8*)(hid + r * 136 + 32 * s + 8 * q);
          const bf16x8 bb = *(const bf16x8*)(w2t + (size_t)(16 * wid + r) * 128 + 32 * s + 8 * q);
          a2 = __builtin_amdgcn_mfma_f32_16x16x32_bf16(a, bb, a2, 0, 0, 0); }
      bf16_t* kcb = (bf16_t*)(ws + WS_KCB); bf16_t* vcbt = (bf16_t*)(ws + WS_VCBT);
#pragma unroll
      for (int j = 0; j < 4; ++j) { const int gr = rt * 16 + 4 * q + j, bg2 = gr / 127, c2 = gr % 127, col = 16 * wid + r;
          const bf16_t v = (bf16_t)(pk2(a2[j], 0.f) & 0xffffu);
          if (which == 0) kcb[(size_t)(bg2 * 128 + c2) * 128 + col] = v; else vcbt[(size_t)(bg2 * 128 + col) * 128 + c2] = v; } }
    __syncthreads();
}

DI void s5_bu16(const bf16x8 ub, const bf16x8 (&af)[8], float* buf, int r, int q) {
#pragma unroll
    for (int pt = 0; pt < 8; ++pt) { f32x4 d = {0.f, 0.f, 0.f, 0.f}; d = __builtin_amdgcn_mfma_f32_16x16x32_bf16(af[pt], ub, d, 0, 0, 0);
#pragma unroll
        for (int j = 0; j < 4; ++j) buf[(16 * pt + 4 * q + j) * 17 + r] = d[j]; }
}
DI void s5_pass1_item(const Params& P, int bitem, unsigned char* smem) {
    int tid_ = threadIdx.x; asm volatile("" : "+v"(tid_));
    unsigned char* ws = P.ws; const int tid = tid_, wid = tid >> 6, lane = tid & 63, r = lane & 15, q = lane >> 4;
    const int item = bitem * 8 + wid, ch = item & 31, grp = (item >> 5) & 63, b = item >> 11;
    const bf16_t* proj = (const bf16_t*)(ws + WS_PROJ); const float* sm = (const float*)(ws + WS_SMALL);
    float* buf = (float*)smem + wid * 2176;
    const bf16_t* tb = (const bf16_t*)(sm + SM_BB);
    bf16x8 af[8];
#pragma unroll
    for (int pt = 0; pt < 8; ++pt) af[pt] = *(const bf16x8*)(tb + (grp * 128 + 16 * pt + r) * 32 + 8 * q);
    const f32x4 ab = *(const f32x4*)(sm + SM_AB + (grp * 64 + lane) * 4);
    const bf16_t* ubase = proj + (size_t)(b * TT + ch * 64) * NPROJ + C_SSM + grp * 16;
    float xr = 0.f, xi = 0.f;
    bf16x8 ubs[4];
#pragma unroll
    for (int sub = 0; sub < 4; ++sub) ubs[sub] = *(const bf16x8*)(ubase + (size_t)(sub * 16 + r) * NPROJ + 8 * (q & 1));
#pragma unroll
    for (int sub = 0; sub < 4; ++sub) {
        s5_bu16(ubs[sub], af, buf, r, q);
        asm volatile("s_waitcnt lgkmcnt(0)" ::: "memory");
#pragma unroll
        for (int tt = 0; tt < 16; ++tt) { const float bur = buf[lane * 17 + tt], bui = buf[(64 + lane) * 17 + tt];
            const float nxr = ab[0] * xr - ab[1] * xi + bur, nxi = ab[0] * xi + ab[1] * xr + bui; xr = nxr; xi = nxi; }
        asm volatile("s_waitcnt lgkmcnt(0)" ::: "memory");
    }
    f32x2_t e = {xr, xi};
    *(f32x2_t*)(ws + WS_S5END + ((size_t)((b * 64 + grp) * 32 + ch) * 64 + lane) * 8) = e;
}

DI void vtrans_item(const Params& P, int item, unsigned char* smem) {
    unsigned char* ws = P.ws; const int tid = threadIdx.x;
    const int tokblk = item >> 3, cseg = item & 7, tok0 = tokblk * 64, b = tok0 >> 11, t0 = tok0 & 2047;
    const int col = (cseg < 4 ? C_VS + cseg * 64 : C_VW + (cseg - 4) * 64), g = (cseg & 3) >> 1, d0 = (cseg & 1) * 64;
    const bf16_t* proj = (const bf16_t*)(ws + WS_PROJ);
    bf16_t* dst = (bf16_t*)(ws + (cseg < 4 ? WS_VTS : WS_VTW)) + (size_t)((b * 2 + g) * 128 + d0) * TT + t0;
    bf16_t* tl = (bf16_t*)smem;
    { const int r = tid >> 3, sg = tid & 7; *(u32x4*)(tl + r * 72 + sg * 8) = *(const u32x4*)(proj + (size_t)(tok0 + r) * NPROJ + col + sg * 8); }
    __syncthreads();
    { const int d = tid >> 3, tsg = tid & 7; unsigned v[8];
#pragma unroll
      for (int j = 0; j < 8; ++j) v[j] = tl[(tsg * 8 + j) * 72 + d];
      u32x4 w; w.x = v[0] | (v[1] << 16); w.y = v[2] | (v[3] << 16); w.z = v[4] | (v[5] << 16); w.w = v[6] | (v[7] << 16);
      *(u32x4*)(dst + (size_t)d * TT + tsg * 8) = w; }
    __syncthreads();
}

DI void s5_pass3_item(const Params& P, int bitem, unsigned char* smem) {
    int tid_ = threadIdx.x; asm volatile("" : "+v"(tid_));
    unsigned char* ws = P.ws; const int tid = tid_, wid = tid >> 6, lane = tid & 63, r = lane & 15, q = lane >> 4;
    const int item = bitem * 8 + wid, ch = item & 31, grp = (item >> 5) & 63, b = item >> 11;
    const bf16_t* proj = (const bf16_t*)(ws + WS_PROJ); const float* sm = (const float*)(ws + WS_SMALL);
    float* xs = (float*)smem + wid * 2176;
    bf16_t* HG = (bf16_t*)(ws + WS_HG);
    const bf16_t* tb = (const bf16_t*)(sm + SM_BB);
    bf16x8 af[8];
#pragma unroll
    for (int pt = 0; pt < 8; ++pt) af[pt] = *(const bf16x8*)(tb + (grp * 128 + 16 * pt + r) * 32 + 8 * q);
    const f32x4 ab = *(const f32x4*)(sm + SM_AB + (grp * 64 + lane) * 4);
    float cB[32];
    { const float* cre = P.in[21] + (size_t)(grp * 16 + r) * 64; const float* cim = P.in[22] + (size_t)(grp * 16 + r) * 64;
#pragma unroll
      for (int i = 0; i < 32; ++i) { const int k = 4 * i + q; cB[i] = (i < 16) ? cre[k] : -cim[k - 64]; } }
    const float dsk = P.in[23][grp * 16 + r];
    const bf16_t* ubase = proj + (size_t)(b * TT + ch * 64) * NPROJ + C_SSM + grp * 16;
    bf16x8 ubs[4]; unsigned short uvs[4][4];
#pragma unroll
    for (int sub = 0; sub < 4; ++sub) { ubs[sub] = *(const bf16x8*)(ubase + (size_t)(sub * 16 + r) * NPROJ + 8 * (q & 1));
#pragma unroll
        for (int j = 0; j < 4; ++j) uvs[sub][j] = ubase[(size_t)(sub * 16 + 4 * q + j) * NPROJ + r]; }
    float xr = 0.f, xi = 0.f;
    {
      const f32x2_t* e = (const f32x2_t*)(ws + WS_S5END) + (size_t)((b * 64 + grp) * 32) * 64 + lane;
      f32x2_t ev[31];
#pragma unroll
      for (int j = 0; j < 31; ++j) ev[j] = e[(j < ch ? j : 0) * 64];
#pragma unroll
      for (int j = 0; j < 31; ++j) { const float ex = j < ch ? ev[j][0] : 0.f, ey = j < ch ? ev[j][1] : 0.f;
          const float ncr = ab[2] * xr - ab[3] * xi + ex, nci = ab[2] * xi + ab[3] * xr + ey; xr = j < ch ? ncr : xr; xi = j < ch ? nci : xi; } }
#pragma unroll
    for (int sub = 0; sub < 4; ++sub) {
        s5_bu16(ubs[sub], af, xs, r, q);
        float uv[4];
#pragma unroll
        for (int j = 0; j < 4; ++j) uv[j] = bf2f(uvs[sub][j]);
        asm volatile("s_waitcnt lgkmcnt(0)" ::: "memory");
#pragma unroll
        for (int tt = 0; tt < 16; ++tt) { const float bur = xs[lane * 17 + tt], bui = xs[(64 + lane) * 17 + tt];
            const float nxr = ab[0] * xr - ab[1] * xi + bur, nxi = ab[0] * xi + ab[1] * xr + bui; xr = nxr; xi = nxi;
            xs[lane * 17 + tt] = xr; xs[(64 + lane) * 17 + tt] = xi; }
        asm volatile("s_waitcnt lgkmcnt(0)" ::: "memory");
        f32x4 ya[4];
#pragma unroll
        for (int j = 0; j < 4; ++j) ya[j] = (f32x4){0.f, 0.f, 0.f, 0.f};
#pragma unroll
        for (int i = 0; i < 32; ++i) { const float a = xs[(4 * i + q) * 17 + r]; ya[i & 3] = __builtin_amdgcn_mfma_f32_16x16x4f32(a, cB[i], ya[i & 3], 0, 0, 0); }
        const f32x4 y = (ya[0] + ya[1]) + (ya[2] + ya[3]);
#pragma unroll
        for (int j = 0; j < 4; ++j) { const int tl = sub * 16 + 4 * q + j; const float v = y[j] + dsk * uv[j];
            HG[(size_t)(b * TT + ch * 64 + tl) * 1024 + grp * 16 + r] = (bf16_t)(pk2(gelu_tanh(v), 0.f) & 0xffffu); }
        asm volatile("s_waitcnt lgkmcnt(0)" ::: "memory");
    }
}

DI float xor32_max(float x) { const auto r_ = __builtin_amdgcn_permlane32_swap(__float_as_uint(x), __float_as_uint(x), false, false); return fmaxf(__uint_as_float(r_[0]), __uint_as_float(r_[1])); }
DI float xor32_sum(float x) { const auto r_ = __builtin_amdgcn_permlane32_swap(__float_as_uint(x), __float_as_uint(x), false, false); return __uint_as_float(r_[0]) + __uint_as_float(r_[1]); }
#define MFMA32(a, b, c) __builtin_amdgcn_mfma_f32_32x32x16_bf16((a), (b), (c), 0, 0, 0)
DI bf16x8 ld2x4(const bf16_t* p0) { const s16x4 a = *(const s16x4*)p0, b = *(const s16x4*)(p0 + 8); return __builtin_shufflevector(a, b, 0, 1, 2, 3, 4, 5, 6, 7); }
DI bf16x8 packp(const f32x16& x, int s) { u32x4 p; p.x = pk2(x[8 * s], x[8 * s + 1]); p.y = pk2(x[8 * s + 2], x[8 * s + 3]); p.z = pk2(x[8 * s + 4], x[8 * s + 5]); p.w = pk2(x[8 * s + 6], x[8 * s + 7]); return __builtin_bit_cast(bf16x8, p); }
DI int crow(int i, int hh) { return (i & 3) + 8 * (i >> 2) + 4 * hh; }

constexpr int A_STG = 0;
constexpr int A_BUF = 34816, A_VOFF = 17408;
constexpr int A_IMPM = 69632, A_IMPS = A_IMPM + 33792, A_IMPV = A_IMPS + 33792, A_LUT = A_IMPV + 8192, A_SELM = A_LUT + 4096;
DI bf16x8 lds2x4(const unsigned char* p) { const s16x4 a = *(const s16x4*)p, b = *(const s16x4*)(p + 16); return __builtin_shufflevector(a, b, 0, 1, 2, 3, 4, 5, 6, 7); }

constexpr float QK_C1 = 0.08838834764831845f * 1.4426950408889634f;
template <int MODE, bool FAR>
DI void attn_tile(const unsigned char* kl  , const unsigned char* vl  ,
                  int k0, int tq, int r, int hh, bool bit, const bf16x8 (&qf)[8], const float* lutH, f32x16 (&o)[4], float& m, float& l) {
    f32x16 s;
#pragma unroll
    for (int i = 0; i < 16; ++i) s[i] = 0.f;
    const unsigned char* kp = kl + r * 272 + 16 * hh;
#pragma unroll
    for (int kk = 0; kk < 8; ++kk) { const bf16x8 a = *(const bf16x8*)(kp + 32 * kk); s = MFMA32(a, qf[kk], s); }
    float tmax = NEGF;
    if (FAR) {
        const float b31 = lutH[255];
#pragma unroll
        for (int i = 0; i < 16; ++i) { const float v = s[i] * QK_C1 + b31; s[i] = (MODE == 0 && !bit) ? NEGF : v; tmax = fmaxf(tmax, s[i]); }
    } else {
#pragma unroll
        for (int i = 0; i < 16; ++i) { const int dist = tq - (k0 + crow(i, hh));
            const bool valid = MODE == 0 ? (bit && dist >= 0) : (dist >= 0 && dist < 512);
            const int di = dist < 0 ? 0 : (dist > 255 ? 255 : dist);
            const float v = s[i] * QK_C1 + lutH[di];
            s[i] = valid ? v : NEGF; tmax = fmaxf(tmax, s[i]); }
    }
    tmax = xor32_max(tmax);
    const float mnew = fmaxf(m, tmax);
    if (__ballot(mnew != m) != 0ull) {
        const float alpha = __builtin_amdgcn_exp2f(m - mnew);
        l *= alpha; m = mnew;
#pragma unroll
        for (int dt = 0; dt < 4; ++dt)
#pragma unroll
            for (int i = 0; i < 16; ++i) o[dt][i] *= alpha;
    }
    float psum = 0.f;
    if (FAR) {
#pragma unroll
        for (int i = 0; i < 16; ++i) { const float p = __builtin_amdgcn_exp2f(s[i] - mnew); s[i] = p; psum += p; }
    } else {
#pragma unroll
        for (int i = 0; i < 16; ++i) { const float p = (s[i] > -1e29f) ? __builtin_amdgcn_exp2f(s[i] - mnew) : 0.f; s[i] = p; psum += p; }
    }
    psum = xor32_sum(psum);
    l += psum;
    const unsigned char* vp = vl + r * 136 + 8 * hh;
#pragma unroll
    for (int s2 = 0; s2 < 2; ++s2) { const bf16x8 pb = packp(s, s2);
#pragma unroll
        for (int dt = 0; dt < 4; ++dt) { const bf16x8 a = lds2x4(vp + dt * (32 * 136) + 32 * s2); o[dt] = MFMA32(a, pb, o[dt]); } }
}

template <int MODE>
DI void attn_tile64_far(const unsigned char* bp  , int r, int hh, bool bit, const bf16x8 (&qf)[8], const float* lutH, f32x16 (&o)[4], float& m, float& l) {
    f32x16 s0, s1;
#pragma unroll
    for (int i = 0; i < 16; ++i) { s0[i] = 0.f; s1[i] = 0.f; }
    const unsigned char* kp = bp + r * 272 + 16 * hh;
#pragma unroll
    for (int kk = 0; kk < 8; ++kk) { const bf16x8 a0 = *(const bf16x8*)(kp + 32 * kk), a1 = *(const bf16x8*)(kp + 32 * 272 + 32 * kk); s0 = MFMA32(a0, qf[kk], s0); s1 = MFMA32(a1, qf[kk], s1); }
    const float b31 = lutH[255];
    float tmax = NEGF;
#pragma unroll
    for (int i = 0; i < 16; ++i) { const float v0 = s0[i] * QK_C1 + b31, v1 = s1[i] * QK_C1 + b31;
        s0[i] = (MODE == 0 && !bit) ? NEGF : v0; s1[i] = (MODE == 0 && !bit) ? NEGF : v1; tmax = fmaxf(tmax, fmaxf(s0[i], s1[i])); }
    tmax = xor32_max(tmax);
    const float mnew = fmaxf(m, tmax);
    if (__ballot(mnew != m) != 0ull) {
        const float alpha = __builtin_amdgcn_exp2f(m - mnew);
        l *= alpha; m = mnew;
#pragma unroll
        for (int dt = 0; dt < 4; ++dt)
#pragma unroll
            for (int i = 0; i < 16; ++i) o[dt][i] *= alpha;
    }
    float psum = 0.f;
#pragma unroll
    for (int i = 0; i < 16; ++i) { const float p0 = __builtin_amdgcn_exp2f(s0[i] - mnew), p1 = __builtin_amdgcn_exp2f(s1[i] - mnew); s0[i] = p0; s1[i] = p1; psum += p0 + p1; }
    l += xor32_sum(psum);
    const unsigned char* vp = bp + A_VOFF + r * 136 + 8 * hh;
#pragma unroll
    for (int s2 = 0; s2 < 2; ++s2) { const bf16x8 pb0 = packp(s0, s2), pb1 = packp(s1, s2);
#pragma unroll
        for (int dt = 0; dt < 4; ++dt) { const bf16x8 a0 = lds2x4(vp + dt * (32 * 136) + 32 * s2), a1 = lds2x4(vp + dt * (32 * 136) + 64 + 32 * s2);
            o[dt] = MFMA32(a0, pb0, o[dt]); o[dt] = MFMA32(a1, pb1, o[dt]); } }
}

template <int MODE>
DI void attn_branch(unsigned char* smem, const bf16_t* kb  , const bf16_t* vt  , unsigned need, unsigned mymask,
                    int t0w, int tq, int r, int hh, const bf16x8 (&qf)[8], const float* lutH, f32x16 (&o)[4], float& m, float& l) {
    int tid = threadIdx.x; asm volatile("" : "+v"(tid));
    if (need == 0u) return;
    u32x4 kreg[2], vreg[2];
    const int krow0 = tid >> 4, kcc = tid & 15, vd0 = tid >> 3, vcc = tid & 7;
#define AB_LOAD(j) do { _Pragma("unroll") for (int e = 0; e < 2; ++e) { \
        kreg[e] = *(const u32x4*)(kb + (size_t)(64 * (j) + krow0 + 32 * e) * NPROJ + kcc * 8); \
        vreg[e] = *(const u32x4*)(vt + (size_t)(vd0 + 64 * e) * TT + 64 * (j) + vcc * 8); } } while (0)
#define AB_STORE(buf) do { unsigned char* bp_ = smem + A_STG + (buf) * A_BUF; _Pragma("unroll") for (int e = 0; e < 2; ++e) { \
        *(u32x4*)(bp_ + (krow0 + 32 * e) * 272 + kcc * 16) = kreg[e]; \
        unsigned char* vp_ = bp_ + A_VOFF + (vd0 + 64 * e) * 136 + vcc * 16; \
        *(u32x2*)vp_ = (u32x2){vreg[e].x, vreg[e].y}; *(u32x2*)(vp_ + 8) = (u32x2){vreg[e].z, vreg[e].w}; } } while (0)
    int j = __builtin_ctz(need); need &= need - 1u;
    AB_LOAD(j); AB_STORE(0);
    __syncthreads();
    int n = 0;
    for (;;) {
        const bool has_next = need != 0u;
        int jn = 0;
        if (has_next) { jn = __builtin_ctz(need); need &= need - 1u; AB_LOAD(jn); }
        const unsigned char* bp = smem + A_STG + (n & 1) * A_BUF;
        const bool bit = MODE == 0 ? ((mymask >> j) & 1u) : true;
        const bool any = MODE == 0 ? (__ballot(bit) != 0ull) : true;
        const bool far64 = any && (64 * j + 63 + 128 <= t0w) && (MODE == 0 || 64 * j >= t0w + 31 - 511);
        if (far64) attn_tile64_far<MODE>(bp, r, hh, bit, qf, lutH, o, m, l);
        else {
#pragma unroll 1
        for (int half = 0; half < 2; ++half) { const int k0 = 64 * j + 32 * half;
            bool act = any && (k0 <= t0w + 31);
            if (MODE == 1) act = act && (k0 + 31 + 511 >= t0w);
            const bool far = (k0 + 31 + 128 <= t0w) && (MODE == 0 || k0 >= t0w + 31 - 511);
            if (act) { if (far) attn_tile<MODE, true>(bp + half * (32 * 272), bp + A_VOFF + half * 64, k0, tq, r, hh, bit, qf, lutH, o, m, l);
                       else attn_tile<MODE, false>(bp + half * (32 * 272), bp + A_VOFF + half * 64, k0, tq, r, hh, bit, qf, lutH, o, m, l); } }
        }
        if (has_next) AB_STORE((n + 1) & 1);
        __syncthreads();
        if (!has_next) break;
        j = jn; ++n;
    }
#undef AB_LOAD
#undef AB_STORE
}

DI void attn_item(const Params& P, int item, unsigned char* smem) {
    int tid_ = threadIdx.x; asm volatile("" : "+v"(tid_));
    unsigned char* ws = P.ws; const int tid = tid_, wid = tid >> 6, lane = tid & 63, r = lane & 31, hh = lane >> 5;
    const int bg = item & 15, qt = 31 - (item >> 4), b = bg >> 1, g = bg & 1, t0 = qt * 64;
    const int hg = wid >> 1, t0w = t0 + 32 * (wid & 1), tq = t0w + r, head = g * 4 + hg, qloc = 32 * (wid & 1) + r;
    const bf16_t* proj = (const bf16_t*)(ws + WS_PROJ);
    float* outs = (float*)(ws + WS_OUTS) + ((size_t)blockIdx.x * 8 + wid) * 4096;
    float* impM = (float*)(smem + A_IMPM); float* impS = (float*)(smem + A_IMPS); float* impv = (float*)(smem + A_IMPV);
    float* lut = (float*)(smem + A_LUT); unsigned* selm = (unsigned*)(smem + A_SELM);
    for (int i = tid; i < 1024; i += 512) { const int h4 = i >> 8, n = i & 255; int bk;
        if (n < 16) bk = n; else { bk = 16 + (int)(logf((float)n / 16.0f) / 2.0794415416798357f * 16.0f); bk = bk > 31 ? 31 : bk; }
        lut[i] = P.in[15][bk * 8 + g * 4 + h4] * 1.4426950408889634f; }
    { const bf16_t* kcb = (const bf16_t*)(ws + WS_KCB) + (size_t)bg * 16384; const bf16_t* vcbt = (const bf16_t*)(ws + WS_VCBT) + (size_t)bg * 16384;
#pragma unroll
      for (int e = 0; e < 4; ++e) { const int id = tid + 512 * e, row = id >> 4, cc = id & 15;
          *(u32x4*)(smem + A_STG + row * 272 + cc * 16) = *(const u32x4*)(kcb + row * 128 + cc * 8);
          *(u32x4*)(smem + A_STG + A_BUF + row * 272 + cc * 16) = *(const u32x4*)(vcbt + row * 128 + cc * 8); } }
    bf16x8 qf[8];
    { const bf16_t* qrow = proj + (size_t)(b * TT + tq) * NPROJ + head * 128 + 8 * hh;
#pragma unroll
      for (int kk = 0; kk < 8; ++kk) qf[kk] = *(const bf16x8*)(qrow + 16 * kk); }
    __syncthreads();
    const float* lutH = lut + hg * 256;
    f32x16 oc[4];
    {
        const unsigned char* kl = smem + A_STG + r * 272 + 16 * hh;
        const unsigned char* vl = smem + A_STG + A_BUF + r * 272 + 8 * hh;
        float mx = NEGF, sum = 0.f;
#pragma unroll 1
        for (int kt = 0; kt < 4; ++kt) {
            f32x16 sc;
#pragma unroll
            for (int i = 0; i < 16; ++i) sc[i] = 0.f;
#pragma unroll
            for (int kk = 0; kk < 8; ++kk) { const bf16x8 a = *(const bf16x8*)(kl + kt * (32 * 272) + 32 * kk); sc = MFMA32(a, qf[kk], sc); }
            float tmax = NEGF;
#pragma unroll
            for (int i = 0; i < 16; ++i) { const int c = 32 * kt + crow(i, hh), dist = tq - (16 * c + 31);
                const int di = dist < 0 ? 0 : (dist > 255 ? 255 : dist);
                const float v = sc[i] * QK_C1 + lutH[di];
                sc[i] = (dist >= 0 && c < 127) ? v : NEGF; tmax = fmaxf(tmax, sc[i]); }
            tmax = xor32_max(tmax);
            const float mnew = fmaxf(mx, tmax); float ps = 0.f;
#pragma unroll
            for (int i = 0; i < 16; ++i) ps += (sc[i] > -1e29f) ? __builtin_amdgcn_exp2f(sc[i] - mnew) : 0.f;
            ps = xor32_sum(ps);
            sum = sum * __builtin_amdgcn_exp2f(mx - mnew) + ps; mx = mnew;
        }
        const float inv = 1.0f / fmaxf(sum, 1e-30f);
#pragma unroll
        for (int dt = 0; dt < 4; ++dt)
#pragma unroll
            for (int i = 0; i < 16; ++i) oc[dt][i] = 0.f;
#pragma unroll 1
        for (int kt = 0; kt < 4; ++kt) {
            f32x16 sc;
#pragma unroll
            for (int i = 0; i < 16; ++i) sc[i] = 0.f;
#pragma unroll
            for (int kk = 0; kk < 8; ++kk) { const bf16x8 a = *(const bf16x8*)(kl + kt * (32 * 272) + 32 * kk); sc = MFMA32(a, qf[kk], sc); }
#pragma unroll
            for (int i = 0; i < 16; ++i) { const int c = 32 * kt + crow(i, hh), dist = tq - (16 * c + 31);
                const int di = dist < 0 ? 0 : (dist > 255 ? 255 : dist);
                const float v = sc[i] * QK_C1 + lutH[di];
                sc[i] = (dist >= 0 && c < 127) ? __builtin_amdgcn_exp2f(v - mx) * inv : 0.f; }
#pragma unroll
            for (int gi = 0; gi < 4; ++gi) { const int jb = 8 * kt + 2 * gi + hh; const float p3 = 0.5f * sc[4 * gi + 3];
                impM[(hg * 64 + qloc) * 33 + jb] = sc[4 * gi] + sc[4 * gi + 1] + sc[4 * gi + 2] + p3;
                impS[(hg * 64 + qloc) * 33 + jb] = p3; }
#pragma unroll
            for (int s2 = 0; s2 < 2; ++s2) { const bf16x8 pb = packp(sc, s2);
#pragma unroll
                for (int dt = 0; dt < 4; ++dt) { const bf16x8 a = lds2x4(vl + dt * (32 * 272) + 64 * kt + 32 * s2); oc[dt] = MFMA32(a, pb, oc[dt]); } }
        }
    }
    __syncthreads();
#pragma unroll 1
    for (int e = 0; e < 4; ++e) { const int idx = tid + 512 * e, qq = idx >> 5, j = idx & 31, t = t0 + qq, cur = t >> 6;
        float v = 0.f;
#pragma unroll
        for (int h = 0; h < 4; ++h) { v += impM[(h * 64 + qq) * 33 + j]; if (j > 0) v += impS[(h * 64 + qq) * 33 + j - 1]; }
        const bool forced = (j == 0) || (j == cur) || (j == cur - 1);
        impv[idx] = forced ? 1e6f : (j <= cur ? v : -1e9f); }
    __syncthreads();
#pragma unroll 1
    for (int e = 0; e < 4; ++e) { const int idx = tid + 512 * e, qq = idx >> 5, j = idx & 31;
        const float my = impv[idx]; int rank = 0;
#pragma unroll 8
        for (int j2 = 0; j2 < 32; ++j2) { const float o2 = impv[qq * 32 + j2]; rank += (o2 > my || (o2 == my && j2 < j)) ? 1 : 0; }
        const unsigned long long bal = __ballot(rank < 16);
        if (lane == 0) selm[qq] = (unsigned)bal; if (lane == 32) selm[qq] = (unsigned)(bal >> 32); }
    __syncthreads();
    float gc, gs, gw;
    { const bf16_t* gp = proj + (size_t)(b * TT + tq) * NPROJ + C_GATE + head * 3;
      gc = sigmoidf_(bf2f(gp[0])); gs = sigmoidf_(bf2f(gp[1])); gw = sigmoidf_(bf2f(gp[2])); }
    { float* outs1_ = outs + lane; asm volatile("" : "+v"(outs1_)); GAS float* outs1 = (GAS float*)outs1_;
#pragma unroll
    for (int dt = 0; dt < 4; ++dt)
#pragma unroll
        for (int i = 0; i < 16; ++i) outs1[(dt * 16 + i) * 64] = gc * oc[dt][i]; }
    const unsigned mymask = selm[qloc];
    unsigned uni = selm[lane];
#pragma unroll
    for (int o_ = 32; o_ >= 1; o_ >>= 1) uni |= (unsigned)__shfl_xor((int)uni, o_);
    uni = __builtin_amdgcn_readfirstlane(uni);
    f32x16 o[4]; float m, l;
    {
#pragma unroll
        for (int dt = 0; dt < 4; ++dt)
#pragma unroll
            for (int i = 0; i < 16; ++i) o[dt][i] = 0.f;
        m = NEGF; l = 0.f;
        const bf16_t* kb = proj + (size_t)(b * TT) * NPROJ + C_KS + g * 128;
        const bf16_t* vt = (const bf16_t*)(ws + WS_VTS) + (size_t)bg * 128 * TT;
        const unsigned need = uni & (qt == 31 ? 0xffffffffu : ((1u << (qt + 1)) - 1u));
        attn_branch<0>(smem, kb, vt, need, mymask, t0w, tq, r, hh, qf, lutH, o, m, l);
        const float sc = gs / fmaxf(l, 1e-30f);
        float* outs2_ = outs + lane; asm volatile("" : "+v"(outs2_)); GAS float* outs2 = (GAS float*)outs2_;
        f32x16 pv[4];
#pragma unroll
        for (int dt = 0; dt < 4; ++dt)
#pragma unroll
            for (int i = 0; i < 16; ++i) pv[dt][i] = outs2[(dt * 16 + i) * 64];
        __builtin_amdgcn_sched_barrier(0);
#pragma unroll
        for (int dt = 0; dt < 4; ++dt)
#pragma unroll
            for (int i = 0; i < 16; ++i) outs2[(dt * 16 + i) * 64] = pv[dt][i] + sc * o[dt][i];
    }
    {
#pragma unroll
        for (int dt = 0; dt < 4; ++dt)
#pragma unroll
            for (int i = 0; i < 16; ++i) o[dt][i] = 0.f;
        m = NEGF; l = 0.f;
        const bf16_t* kb = proj + (size_t)(b * TT) * NPROJ + C_KW + g * 128;
        const bf16_t* vt = (const bf16_t*)(ws + WS_VTW) + (size_t)bg * 128 * TT;
        const int jlo = qt >= 8 ? qt - 8 : 0;
        const unsigned need = (qt == 31 ? 0xffffffffu : ((1u << (qt + 1)) - 1u)) & ~((1u << jlo) - 1u);
        attn_branch<1>(smem, kb, vt, need, 0u, t0w, tq, r, hh, qf, lutH, o, m, l);
        const float sc = gw / fmaxf(l, 1e-30f);
        float* outs3_ = outs + lane; asm volatile("" : "+v"(outs3_)); GAS float* outs3 = (GAS float*)outs3_;
        bf16_t* as = (bf16_t*)(ws + WS_AS) + (size_t)(b * TT + tq) * DM + head * 128;
        f32x16 pv[4];
#pragma unroll
        for (int dt = 0; dt < 4; ++dt)
#pragma unroll
            for (int i = 0; i < 16; ++i) pv[dt][i] = outs3[(dt * 16 + i) * 64];
        __builtin_amdgcn_sched_barrier(0);
#pragma unroll
        for (int dt = 0; dt < 4; ++dt)
#pragma unroll
            for (int gi = 0; gi < 4; ++gi) { float v[4];
#pragma unroll
                for (int j = 0; j < 4; ++j) { const int i = 4 * gi + j; v[j] = pv[dt][i] + sc * o[dt][i]; }
                u32x2 w; w.x = pk2(v[0], v[1]); w.y = pk2(v[2], v[3]);
                *(u32x2*)(as + 32 * dt + 8 * gi + 4 * hh) = w; }
    }
}

DI void fill_rstd(const pg8::StaticOrder& S, const float* ss, unsigned char* smem) {
    float* rl = (float*)(smem + 131072);
    for (int i = 0; i < 16; ++i) { pg8::Unit u; if (!S.next(i, u)) break;
        if (threadIdx.x < 256) rl[i * 256 + threadIdx.x] = 1.0f / sqrtf(ss[u.pm * 256 + threadIdx.x] * (1.0f / DM) + EPSN); }
    __syncthreads();
}

#define XB_TMO      128
#define XB_XCNT(j)  (256  + 64 * (j))
#define XB_XSUB(j)  (1280 + 64 * (j))
#define XB_XGEN(j)  (2304 + 64 * (j))
#define XB_TOP      3328
#define XB_TOPGEN   3392
#define XCD_BAR_WORDS 3456
#define XB_SPIN_CAP (1u << 18)
DI unsigned xb_ld(unsigned* p)              { return __hip_atomic_load(p, __ATOMIC_RELAXED, __HIP_MEMORY_SCOPE_AGENT); }
DI unsigned xb_add(unsigned* p, unsigned v) { return __hip_atomic_fetch_add(p, v, __ATOMIC_RELAXED, __HIP_MEMORY_SCOPE_AGENT); }
DI unsigned xb_xcc_id() { return (unsigned)__builtin_amdgcn_s_getreg((3 << 11) | 20) & 0xFu; }
#define XB_SPIN(cond, bar) do { unsigned _sp = 0; while (cond) { __builtin_amdgcn_s_sleep(1); \
    if ((++_sp & 255u) == 0u) { if (xb_ld(&(bar)[XB_TMO])) break; if (_sp > XB_SPIN_CAP) { atomicAdd(&(bar)[XB_TMO], 1u); break; } } } } while (0)
struct XcdBarrier { unsigned* bar; unsigned x; volatile LAS unsigned* st; };
DI XcdBarrier xcd_barrier_post(unsigned* bar, volatile LAS unsigned* st) {
    XcdBarrier b; b.bar = bar; b.x = xb_xcc_id(); b.st = st;
    if (threadIdx.x == 0) (void)xb_add(&bar[XB_XCNT(b.x)], 1u);
    return b;
}
DI void xcd_barrier_complete(unsigned* bar, unsigned x, unsigned& nloc, unsigned& nx) {
    const unsigned G = gridDim.x * gridDim.y * gridDim.z;
    unsigned sum, cnt, mine, sp = 0u;
    for (;;) {
        sum = 0u; cnt = 0u; mine = 0u;
#pragma unroll
        for (unsigned j = 0; j < 16; ++j) { const unsigned c = xb_ld(&bar[XB_XCNT(j)]); sum += c; cnt += (c > 0u) ? 1u : 0u; mine = (j == x) ? c : mine; }
        if (sum == G) break;
        __builtin_amdgcn_s_sleep(1);
        if ((++sp & 255u) == 0u) { if (xb_ld(&bar[XB_TMO])) break; if (sp > XB_SPIN_CAP) { atomicAdd(&bar[XB_TMO], 1u); break; } }
    }
    nloc = mine > 0u ? mine : 1u; nx = cnt > 0u ? cnt : 1u;
}
DI void xcd_barrier(const XcdBarrier& b) {
    asm volatile("s_waitcnt vmcnt(0)" ::: "memory");
    __syncthreads();
    if (threadIdx.x == 0) {
        unsigned* bar = b.bar;
        __builtin_amdgcn_s_waitcnt(0);
        unsigned nloc = b.st[0], nx = b.st[1];
        if (nloc == 0u) { xcd_barrier_complete(bar, b.x, nloc, nx); b.st[0] = nloc; b.st[1] = nx; }
        const unsigned old = xb_add(&bar[XB_XSUB(b.x)], 1u);
        const unsigned gen = old / nloc;
        if (old + 1u == (gen + 1u) * nloc) {
            __builtin_amdgcn_fence(__ATOMIC_RELEASE, "agent");
            asm volatile("s_waitcnt vmcnt(0)" ::: "memory");
            const unsigned og = xb_add(&bar[XB_TOP], 1u);
            const unsigned tg = og / nx;
            if (og + 1u == (tg + 1u) * nx) xb_add(&bar[XB_TOPGEN], 1u);
            else XB_SPIN(xb_ld(&bar[XB_TOPGEN]) == tg, bar);
            __builtin_amdgcn_fence(__ATOMIC_ACQUIRE, "agent");
            xb_add(&bar[XB_XGEN(b.x)], 1u);
            asm volatile("s_waitcnt vmcnt(0)" ::: "memory");
        } else {
            XB_SPIN(xb_ld(&bar[XB_XGEN(b.x)]) == gen, bar);
            __builtin_amdgcn_fence(__ATOMIC_ACQUIRE, "agent");
            asm volatile("s_waitcnt vmcnt(0)" ::: "memory");
        }
    }
    __syncthreads();
}

__global__ void __launch_bounds__(512, 2) hymba_fwd(Params P) {
    extern __shared__ __attribute__((aligned(16))) unsigned char shm[];
    cg::grid_group grid = cg::this_grid();
    unsigned char* ws = P.ws;
    LAS unsigned char* lds = (LAS unsigned char*)shm;
    const int tid = threadIdx.x, G = gridDim.x;
    float* hres = P.out;
    const int lo = P.ph_lo, hi = P.ph_hi;
    volatile LAS unsigned* xbst = (volatile LAS unsigned*)(lds + L_CUR + 16);
    if (tid == 0) { xbst[0] = 0u; xbst[1] = 0u; }
    __syncthreads();
    const XcdBarrier xbar = xcd_barrier_post((unsigned*)((float*)(ws + WS_SMALL) + SM_BAR), xbst);
#define IN(k) (lo <= (k) && (k) < hi)
#define SYNC(k) do { if (IN(k) && IN((k) + 1)) { if ((k) == 0) grid.sync(); else xcd_barrier(xbar); } } while (0)
#ifndef DUP_PH
#define DUP_PH -1
#endif
#define REP(k) for (int rep_ = 0; rep_ < ((k) == DUP_PH ? 2 : 1); ++rep_, (((k) == DUP_PH && rep_ == 1) ? grid.sync() : (void)0))
    if (IN(0)) REP(0) phase_prep(P, shm);
    SYNC(0);
    if (IN(1)) REP(1) { pg8::Gemm g{(const bf16_t*)(ws + WS_XN), (const bf16_t*)(ws + WS_W13A), MTOK, 2 * DFF, DM};
        pg8::StaticOrder S; S.init(MTOK, 2 * DFF, G, (int)blockIdx.x); EpiSwiGLU E{(bf16_t*)(ws + WS_H), nullptr};
        pg8::gemm_phase<EpiSwiGLU, pg8::StaticOrder>(lds, g, S, E); }
    SYNC(1);
    if (IN(2)) REP(2) { pg8::Gemm g{(const bf16_t*)(ws + WS_H), (const bf16_t*)(ws + WS_W2A), MTOK, DM, DFF};
        pg8::StaticOrder S; S.init(MTOK, DM, G, (int)blockIdx.x); EpiResid<0> E{P.in[0], nullptr, nullptr, (bf16_t*)hres, (float*)(ws + WS_SMALL) + SM_SS, 0.5f};
        pg8::gemm_phase<EpiResid<0>, pg8::StaticOrder>(lds, g, S, E); }
    if (IN(2) && hi > 3) xcd_barrier(xbar);
    if (IN(4)) REP(4) {
        if (blockIdx.x == 0 && tid < 256) { float* sm = (float*)(ws + WS_SMALL); const int which = tid >> 7, n = tid & 127; float s = P.in[which ? 13 : 9][n];
            for (int c = 0; c < 128; ++c) s += sm[SM_CBP + (which * 128 + c) * 128 + n];
            sm[SM_CB1 + which * 128 + n] = s; }
        pg8::Gemm g{(const bf16_t*)hres, (const bf16_t*)(ws + WS_WIN), MTOK, NPROJ, DM};
        pg8::StaticOrder S; S.init(MTOK, NPROJ, G, (int)blockIdx.x); EpiProj E{(bf16_t*)(ws + WS_PROJ), (const float*)(ws + WS_SMALL) + SM_SS, (bf16_t*)(ws + WS_VTS), (bf16_t*)(ws + WS_VTW)}; fill_rstd(S, E.ss, shm);
        pg8::gemm_phase<EpiProj, pg8::StaticOrder>(lds, g, S, E); }
    SYNC(4);
    if (IN(5)) REP(5) {
        for (int it = blockIdx.x; it < 254 + 2048; it += G) {
            if (it < 254) compress_item(P, it, shm);
            else { s5_pass1_item(P, it - 254, shm); __syncthreads(); }
        } }
    SYNC(5);
    if (IN(6)) REP(6) {
        int* ctr = (int*)((float*)(ws + WS_SMALL) + SM_CTR) + rep_;
        volatile int* curw = (volatile int*)(shm + L_CUR);
        for (;;) {
            __syncthreads();
            if (tid == 0) *curw = atomicAdd(ctr, 1);
            __syncthreads();
            const int it = *curw;
            if (it >= 512 + 2048) break;
            if (it < 512) attn_item(P, it, shm); else s5_pass3_item(P, it - 512, shm);
        } }
    SYNC(6);
    if (IN(7)) REP(7) { pg8::Gemm g{(const bf16_t*)(ws + WS_HG), (const bf16_t*)(ws + WS_GLUW), MTOK, 1024, 1024};
        pg8::StaticOrder S; S.init(MTOK, 1024, G, (int)blockIdx.x); EpiGLU E{(const bf16_t*)(ws + WS_HG), P.in[25], (bf16_t*)(ws + WS_AS)};
        pg8::gemm_phase<EpiGLU, pg8::StaticOrder>(lds, g, S, E); }
    SYNC(7);
    if (IN(8)) REP(8) { pg8::Gemm g{(const bf16_t*)(ws + WS_AS), (const bf16_t*)(ws + WS_WOUT), MTOK, DM, DM};
        pg8::StaticOrder S; S.init(MTOK, DM, G, (int)blockIdx.x); EpiResid<1> E{nullptr, (const bf16_t*)hres, nullptr, (bf16_t*)(ws + WS_XN), (float*)(ws + WS_SMALL) + SM_SS + 16384, 1.0f};
        pg8::gemm_phase<EpiResid<1>, pg8::StaticOrder>(lds, g, S, E); }
    if (IN(8) && hi > 9) xcd_barrier(xbar);
    if (IN(10)) REP(10) { pg8::Gemm g{(const bf16_t*)(ws + WS_XN), (const bf16_t*)(ws + WS_W13B), MTOK, 2 * DFF, DM};
        pg8::StaticOrder S; S.init(MTOK, 2 * DFF, G, (int)blockIdx.x); EpiSwiGLU E{(bf16_t*)(ws + WS_H), (const float*)(ws + WS_SMALL) + SM_SS + 16384}; fill_rstd(S, E.ss, shm);
        pg8::gemm_phase<EpiSwiGLU, pg8::StaticOrder>(lds, g, S, E); }
    SYNC(10);
    if (IN(11)) REP(11) { pg8::Gemm g{(const bf16_t*)(ws + WS_H), (const bf16_t*)(ws + WS_W2B), MTOK, DM, DFF};
        pg8::StaticOrder S; S.init(MTOK, DM, G, (int)blockIdx.x); EpiResid<2> E{nullptr, (const bf16_t*)(ws + WS_XN), hres, nullptr, nullptr, 0.5f};
        pg8::gemm_phase<EpiResid<2>, pg8::StaticOrder>(lds, g, S, E); }
    SYNC(11);
    if (IN(12)) REP(12) norm_rows(hres, P.in[31], nullptr, hres);
}

#ifndef N_LAUNCH_MODE
#define N_LAUNCH_MODE 0
#endif

extern "C" void kernel_launch(void* const* d_in, const int* in_sizes, int n_in, void* d_out, int out_size, void* d_ws, size_t ws_size, hipStream_t stream) {
    static int grid = 0;
    if (grid == 0) {
        int dev = 0, cus = 0, per_cu = 0;
        hipGetDevice(&dev);
        hipDeviceGetAttribute(&cus, hipDeviceAttributeMultiprocessorCount, dev);
        hipFuncSetAttribute((const void*)hymba_fwd, hipFuncAttributeMaxDynamicSharedMemorySize, LDS_BYTES);
        hipOccupancyMaxActiveBlocksPerMultiprocessor(&per_cu, (const void*)hymba_fwd, 512, LDS_BYTES);
        if (per_cu < 1) { fprintf(stderr, "occupancy query says %d blocks/CU\n", per_cu); per_cu = 1; }
        (void)hipGetLastError();
        grid = cus * 1;
        if (n_in != 32 || ws_size < WS_END) fprintf(stderr, "kernel_launch: unexpected n_in %d / ws %zu\n", n_in, ws_size);
    }
    Params p{};
    for (int i = 0; i < 32; ++i) p.in[i] = (const float*)d_in[i];
    p.out = (float*)d_out; p.ws = (unsigned char*)d_ws;
    (void)hipMemsetAsync((unsigned char*)d_ws + WS_SMALL + (size_t)SM_BAR * 4, 0, XCD_BAR_WORDS * 4, stream);
#if N_LAUNCH_MODE == 0
    p.ph_lo = 0; p.ph_hi = NPH;
    { void* args[] = {&p};
      hipError_t e = hipLaunchCooperativeKernel((const void*)hymba_fwd, dim3(grid), dim3(512), args, LDS_BYTES, stream);
      if (e != hipSuccess) fprintf(stderr, "cooperative launch failed: %s (grid %d)\n", hipGetErrorString(e), grid); }
#else
    for (int ph = 0; ph < NPH; ++ph) { p.ph_lo = ph; p.ph_hi = ph + 1;
        void* args[] = {&p};
        hipError_t e = hipLaunchCooperativeKernel((const void*)hymba_fwd, dim3(grid), dim3(512), args, LDS_BYTES, stream);
        if (e != hipSuccess) fprintf(stderr, "launch %d failed: %s (grid %d)\n", ph, hipGetErrorString(e), grid); }
#endif
}
```

```cpp
#include <hip/hip_runtime.h>
#include <hip/hip_cooperative_groups.h>
#include <cstdio>
namespace cg = cooperative_groups;

#define DI __device__ __forceinline__
#define LAS __attribute__((address_space(3)))
#define GAS __attribute__((address_space(1)))
typedef unsigned short bf16_t;
typedef short bf16x8 __attribute__((ext_vector_type(8)));
typedef short s16x4 __attribute__((ext_vector_type(4)));
typedef float f32x4 __attribute__((ext_vector_type(4)));
typedef float f32x16 __attribute__((ext_vector_type(16)));
typedef unsigned u32x4 __attribute__((ext_vector_type(4)));
typedef unsigned u32x2 __attribute__((ext_vector_type(2)));
typedef __bf16 bf16x2_t __attribute__((ext_vector_type(2)));
typedef float f32x2_t __attribute__((ext_vector_type(2)));

constexpr int MTOK = 16384, DM = 2048, DFF = 5632, TT = 2048;
constexpr int NPROJ = 3840;
constexpr int C_KC = 1024, C_VC = 1280, C_KS = 1536, C_VS = 1792, C_KW = 2048, C_VW = 2304, C_GATE = 2560, C_SSM = 2584;
constexpr float EPSN = 1e-6f;
constexpr float NEGF = -1e30f;

constexpr size_t WS_W13A = 0;
constexpr size_t WS_W2A = WS_W13A + 46137344;
constexpr size_t WS_W13B = WS_W2A + 23068672;
constexpr size_t WS_W2B = WS_W13B + 46137344;
constexpr size_t WS_WIN = WS_W2B + 23068672;
constexpr size_t WS_WOUT = WS_WIN + 15728640;
constexpr size_t WS_GLUW = WS_WOUT + 8388608;
constexpr size_t WS_CW1K = WS_GLUW + 2097152;
constexpr size_t WS_CW1V = WS_CW1K + 1048576;
constexpr size_t WS_CW2K = WS_CW1V + 1048576;
constexpr size_t WS_CW2V = WS_CW2K + 32768;
constexpr size_t WS_SMALL = WS_CW2V + 32768;
constexpr size_t WS_KCB = WS_SMALL + 1048576;
constexpr size_t WS_VCBT = WS_KCB + 524288;
constexpr size_t WS_S5END = WS_VCBT + 524288;
constexpr size_t WS_VTS = WS_S5END + 8388608;
constexpr size_t WS_VTW = WS_VTS + 8388608;
constexpr size_t WS_XN = WS_VTW + 8388608;
constexpr size_t WS_H = WS_XN + 67108864;
constexpr size_t WS_PROJ = WS_H;
constexpr size_t WS_AS = WS_H + 125829120;
constexpr size_t WS_HG = WS_XN;
constexpr size_t WS_OUTS = WS_H + 184549376 + 8388608;
constexpr size_t WS_END = WS_OUTS + 33554432;
constexpr int SM_CB1 = 0;
constexpr int SM_AB = 256;
constexpr int SM_BB = 256 + 16384;
constexpr int SM_CTR = 256 + 16384 + 131072;
constexpr int SM_CBP = SM_CTR + 64;
constexpr int SM_SS = SM_CBP + 32768;
constexpr int SM_BAR = 213504;

constexpr int LDS_BYTES = 151552;
constexpr int L_CUR = 149776;
constexpr int NPH = 13;

struct Params { const float* in[32]; float* out; unsigned char* ws; int ph_lo, ph_hi; };

DI unsigned pk2(float a, float b) { f32x2_t v = {a, b}; return __builtin_bit_cast(unsigned, __builtin_convertvector(v, bf16x2_t)); }
DI float bf2f(unsigned x) { return __uint_as_float(x << 16); }
DI float bflo(unsigned w) { return __uint_as_float(w << 16); }
DI float bfhi(unsigned w) { return __uint_as_float(w & 0xffff0000u); }
DI float sigmoidf_(float x) { return __builtin_amdgcn_rcpf(1.0f + __builtin_amdgcn_exp2f(-1.4426950408889634f * x)); }
DI float gelu_tanh(float v) { const float z = 0.7978845608028654f * (v + 0.044715f * v * v * v); const float th = 1.0f - 2.0f * __builtin_amdgcn_rcpf(__builtin_amdgcn_exp2f(2.8853900817779268f * z) + 1.0f); return 0.5f * v * (1.0f + th); }

namespace pg8 {
constexpr int BM = 256, BK = 64, HALF = 128, HTB = HALF * BK * 2, STAGE_BYTES = 8 * HTB, NXCD = 8, WGM = 8;
__host__ __device__ __forceinline__ int lds_byte(int r, int c) { const int st = (r >> 4) * 2 + (c >> 5), rr = r & 15, cc = c & 31, ob = rr * 64 + cc * 2; return st * 1024 + (ob ^ (((ob >> 9) & 1) << 5)); }
__host__ __device__ __forceinline__ void stage_rc(int b, int& R, int& C) { const int st = b / 1024, sb = b % 1024, swz = sb ^ (((sb >> 9) & 1) << 5); R = (st >> 1) * 16 + swz / 64; C = (st & 1) * 32 + (swz % 64) / 2; }
__host__ __device__ __forceinline__ int perm32(int rho) { const int n = rho >> 4, i = rho & 15; return 8 * (i >> 2) + 4 * n + (i & 3); }
struct Unit { int pm, pn; };
struct Gemm { const bf16_t* A; const bf16_t* Bt; int M, N, K; };
struct StaticOrder {
    int nM, nN, nwg, G, c;
    __host__ __device__ void init(int M, int N, int G_, int c_) { nM = M / BM; nN = N / BM; nwg = nM * nN; G = G_; c = c_; }
    __host__ __device__ bool next(int i, Unit& u) const {
        const long L = (long)i * G + c; if (L >= nwg) return false;
        int wgid = (int)L; { const int q = nwg / NXCD, r = nwg % NXCD, xcd = wgid % NXCD, off = wgid / NXCD; wgid = (xcd < r ? xcd * (q + 1) : r * (q + 1) + (xcd - r) * q) + off; }
        const int nig = WGM * nN, gid = wgid / nig, fm = gid * WGM, gsz = (nM - fm) < WGM ? (nM - fm) : WGM;
        u.pm = fm + ((wgid % nig) % gsz); u.pn = (wgid % nig) / gsz; return true;
    }
    __device__ __forceinline__ void a_ready(const Unit&) const {}
    __device__ __forceinline__ void done(const Unit&) const {}
};

template <class Epi, class Sched>
__device__ __forceinline__ void gemm_phase(LAS unsigned char* lds, const Gemm g, const Sched& S, const Epi& E) {
    const int tid = threadIdx.x, wid = __builtin_amdgcn_readfirstlane(tid >> 6), lane = tid & 63, wr = wid >> 2, wc = wid & 3, fr = lane & 15, fq = lane >> 4;
    const int K = g.K, nt = K / BK;
    unsigned voffA[2], voffB[2];
#pragma unroll
    for (int i = 0; i < 2; ++i) { int R, C; stage_rc(tid * 16 + i * 8192, R, C); const int Rb = Epi::PERM ? ((R & ~31) + perm32(R & 31)) : R;
        voffA[i] = (unsigned)(R * K + C) * 2u; voffB[i] = (unsigned)(Rb * K + C) * 2u; }
    const size_t kstep = (size_t)(BK * 2);
    const size_t hstep = (size_t)HALF * K * 2;
    const size_t tstep = 2 * hstep;
    const unsigned ldsw = (unsigned)wid * 1024u;
    const int aoff = lds_byte(wr * 64 + fr, fq * 8), boff = lds_byte(wc * 32 + fr, fq * 8);
#define PG8_SA(b, h) (((b) * 2 + (h)) * HTB)
#define PG8_SB(b, h) ((4 + (b) * 2 + (h)) * HTB)
#define PG8_STAGE(bufoff, gbase, voff) do { _Pragma("unroll") for (int _i = 0; _i < 2; ++_i) \
        __builtin_amdgcn_global_load_lds((const unsigned*)((const char*)(gbase) + (voff)[_i]), (LAS unsigned*)(lds + (bufoff) + ldsw + _i * 8192), 16, 0, 0); } while (0)
#define PG8_LDA(dst, b, h) do { _Pragma("unroll") for (int m = 0; m < 4; ++m) _Pragma("unroll") for (int k = 0; k < 2; ++k) dst[m][k] = *(const LAS bf16x8*)(lds + PG8_SA(b, h) + aoff + m * 2048 + k * 1024); } while (0)
#define PG8_LDB(dst, b, h) do { _Pragma("unroll") for (int n = 0; n < 2; ++n) _Pragma("unroll") for (int k = 0; k < 2; ++k) dst[n][k] = *(const LAS bf16x8*)(lds + PG8_SB(b, h) + boff + n * 2048 + k * 1024); } while (0)
#define PG8_MMA(ai, bj, At, Bt) do { __builtin_amdgcn_s_setprio(1); _Pragma("unroll") for (int m = 0; m < 4; ++m) _Pragma("unroll") for (int n = 0; n < 2; ++n) _Pragma("unroll") for (int k = 0; k < 2; ++k) \
        acc[ai][bj][m][n] = __builtin_amdgcn_mfma_f32_16x16x32_bf16(Bt[n][k], At[m][k], acc[ai][bj][m][n], 0, 0, 0); __builtin_amdgcn_s_setprio(0); } while (0)
#define PG8_WAIT_V(n) asm volatile("s_waitcnt vmcnt(" #n ")" ::: "memory")
#define PG8_WAIT_L(n) asm volatile("s_waitcnt lgkmcnt(" #n ")" ::: "memory")
#define PG8_BAR __builtin_amdgcn_s_barrier()
#define PG8_SCHED __builtin_amdgcn_sched_barrier(0)
    Unit cur, nxt; int ui = 0;
    if (!S.next(0, cur)) return;
    f32x4 acc[2][2][4][2];
#pragma unroll
    for (int a = 0; a < 2; ++a)
#pragma unroll
        for (int b = 0; b < 2; ++b)
#pragma unroll
            for (int m = 0; m < 4; ++m)
#pragma unroll
                for (int n = 0; n < 2; ++n) acc[a][b][m][n] = (f32x4){0.f, 0.f, 0.f, 0.f};
    bf16x8 At[4][2], B0[2][2], B1[2][2];
    const char* cA = (const char*)g.A + (size_t)cur.pm * tstep; const char* cB = (const char*)g.Bt + (size_t)cur.pn * tstep;
    S.a_ready(cur);
    PG8_STAGE(PG8_SB(0, 0), cB, voffB); PG8_STAGE(PG8_SA(0, 0), cA, voffA); PG8_STAGE(PG8_SB(0, 1), cB + hstep, voffB); PG8_STAGE(PG8_SA(0, 1), cA + hstep, voffA);
    if (wr == 1) PG8_BAR;
    PG8_WAIT_V(4); PG8_BAR;
    PG8_STAGE(PG8_SB(1, 0), cB + kstep, voffB); PG8_STAGE(PG8_SA(1, 0), cA + kstep, voffA); PG8_STAGE(PG8_SB(1, 1), cB + hstep + kstep, voffB);
    PG8_WAIT_V(6); PG8_BAR;
    for (;;) {
        const bool has_next = S.next(ui + 1, nxt);
        const char* nA = has_next ? (const char*)g.A + (size_t)nxt.pm * tstep : cA; const char* nB = has_next ? (const char*)g.Bt + (size_t)nxt.pn * tstep : cB;
        for (int t = 0; t < nt; t += 2) {
            const bool last = (t == nt - 2);
            const char* a1 = cA + (size_t)(t + 1) * kstep;
            const char* a2 = last ? nA : cA + (size_t)(t + 2) * kstep; const char* b2 = last ? nB : cB + (size_t)(t + 2) * kstep;
            const char* a3 = a2 + kstep; const char* b3 = b2 + kstep;
            if (last && has_next) S.a_ready(nxt);
            PG8_LDB(B0, 0, 0); PG8_SCHED; PG8_LDA(At, 0, 0); PG8_STAGE(PG8_SA(1, 1), a1 + hstep, voffA);
            PG8_WAIT_L(8); PG8_BAR; PG8_WAIT_L(0); PG8_MMA(0, 0, At, B0); PG8_BAR; PG8_SCHED;
            PG8_LDB(B1, 0, 1); PG8_STAGE(PG8_SB(0, 0), b2, voffB);
            PG8_BAR; PG8_WAIT_L(0); PG8_MMA(0, 1, At, B1); PG8_BAR;
            PG8_LDA(At, 0, 1); PG8_STAGE(PG8_SA(0, 0), a2, voffA);
            PG8_BAR; PG8_WAIT_L(0); PG8_MMA(1, 0, At, B0); PG8_BAR; PG8_SCHED;
            PG8_STAGE(PG8_SB(0, 1), b2 + hstep, voffB);
            PG8_WAIT_V(6); PG8_BAR; PG8_MMA(1, 1, At, B1); PG8_BAR;
            PG8_LDB(B0, 1, 0); PG8_SCHED; PG8_LDA(At, 1, 0); PG8_STAGE(PG8_SA(0, 1), a2 + hstep, voffA);
            PG8_WAIT_L(8); PG8_BAR; PG8_WAIT_L(0); PG8_MMA(0, 0, At, B0); PG8_BAR; PG8_SCHED;
            PG8_LDB(B1, 1, 1); PG8_STAGE(PG8_SB(1, 0), b3, voffB);
            PG8_BAR; PG8_WAIT_L(0); PG8_MMA(0, 1, At, B1); PG8_BAR;
            PG8_LDA(At, 1, 1); PG8_STAGE(PG8_SA(1, 0), a3, voffA);
            PG8_BAR; PG8_WAIT_L(0); PG8_MMA(1, 0, At, B0); PG8_BAR; PG8_SCHED;
            PG8_STAGE(PG8_SB(1, 1), b3 + hstep, voffB);
            PG8_WAIT_V(6); PG8_BAR; PG8_MMA(1, 1, At, B1); PG8_BAR;
        }
        E(acc, cur, wr, wc, fr, fq, ui, lds); S.done(cur);
        if (!has_next) break;
#pragma unroll
        for (int a = 0; a < 2; ++a)
#pragma unroll
            for (int b = 0; b < 2; ++b)
#pragma unroll
                for (int m = 0; m < 4; ++m)
#pragma unroll
                    for (int n = 0; n < 2; ++n) acc[a][b][m][n] = (f32x4){0.f, 0.f, 0.f, 0.f};
        cur = nxt; cA = nA; cB = nB; ++ui;
    }
    PG8_WAIT_V(0);
    if (wr == 0) PG8_BAR;
    PG8_BAR;
#undef PG8_SA
#undef PG8_SB
#undef PG8_STAGE
#undef PG8_LDA
#undef PG8_LDB
#undef PG8_MMA
#undef PG8_WAIT_V
#undef PG8_WAIT_L
#undef PG8_BAR
#undef PG8_SCHED
}
}

struct EpiSwiGLU {
    static constexpr bool PERM = true;
    bf16_t* H; const float* ss;
    DI void operator()(const f32x4 (&acc)[2][2][4][2], const pg8::Unit& u, int wr, int wc, int fr, int fq, int ui, LAS unsigned char* lds) const {
        const int row0 = u.pm * 256 + wr * 64 + fr, col0 = u.pn * 128 + wc * 32 + 8 * fq;
#pragma unroll
        for (int ai = 0; ai < 2; ++ai)
#pragma unroll
            for (int m = 0; m < 4; ++m) {
                const float rs = ss ? ((const LAS float*)(lds + 131072))[ui * 256 + wr * 64 + fr + ai * 128 + m * 16] : 1.0f;
                float v[8];
#pragma unroll
                for (int n = 0; n < 2; ++n)
#pragma unroll
                    for (int j = 0; j < 4; ++j) { const float gt = acc[ai][0][m][n][j] * rs, up = acc[ai][1][m][n][j] * rs; v[n * 4 + j] = gt * up * __builtin_amdgcn_rcpf(1.0f + __builtin_amdgcn_exp2f(-1.4426950408889634f * gt)); }
                u32x4 w; w.x = pk2(v[0], v[1]); w.y = pk2(v[2], v[3]); w.z = pk2(v[4], v[5]); w.w = pk2(v[6], v[7]);
                *(u32x4*)(H + (size_t)(row0 + ai * 128 + m * 16) * DFF + col0) = w;
            }
    }
};
template <int MODE> struct EpiResid {
    static constexpr bool PERM = true;
    const float* basef; const bf16_t* baseb; float* outf; bf16_t* hb; float* ss; float scale;
    DI void operator()(const f32x4 (&acc)[2][2][4][2], const pg8::Unit& u, int wr, int wc, int fr, int fq, int ui, LAS unsigned char* lds) const {
        const int row0 = u.pm * 256 + wr * 64 + fr, col0 = u.pn * 256 + wc * 32 + 8 * fq;
#pragma unroll
        for (int ai = 0; ai < 2; ++ai) {
            f32x4 bf0[4][2], bf1[4][2]; u32x4 bw[4][2];
#pragma unroll
            for (int m = 0; m < 4; ++m)
#pragma unroll
                for (int bj = 0; bj < 2; ++bj) { const size_t off = (size_t)(row0 + ai * 128 + m * 16) * DM + col0 + bj * 128;
                    if (MODE == 0) { bf0[m][bj] = *(const f32x4*)(basef + off); bf1[m][bj] = *(const f32x4*)(basef + off + 4); }
                    else bw[m][bj] = *(const u32x4*)(baseb + off); }
            __builtin_amdgcn_sched_barrier(0);
#pragma unroll
            for (int m = 0; m < 4; ++m) { const int row = row0 + ai * 128 + m * 16; const size_t off = (size_t)row * DM + col0; float rsum = 0.f;
#pragma unroll
                for (int bj = 0; bj < 2; ++bj) {
                    f32x4 b0, b1;
                    if (MODE == 0) { b0 = bf0[m][bj]; b1 = bf1[m][bj]; }
                    else { const u32x4 w = bw[m][bj]; b0 = (f32x4){bflo(w.x), bfhi(w.x), bflo(w.y), bfhi(w.y)}; b1 = (f32x4){bflo(w.z), bfhi(w.z), bflo(w.w), bfhi(w.w)}; }
                    const f32x4 v0 = b0 + acc[ai][bj][m][0] * scale, v1 = b1 + acc[ai][bj][m][1] * scale;
                    if (MODE == 2) { *(f32x4*)(outf + off + bj * 128) = v0; *(f32x4*)(outf + off + bj * 128 + 4) = v1; }
                    else { rsum += (v0[0] * v0[0] + v0[1] * v0[1]) + (v0[2] * v0[2] + v0[3] * v0[3]) + (v1[0] * v1[0] + v1[1] * v1[1]) + (v1[2] * v1[2] + v1[3] * v1[3]);
                        u32x4 w; w.x = pk2(v0[0], v0[1]); w.y = pk2(v0[2], v0[3]); w.z = pk2(v1[0], v1[1]); w.w = pk2(v1[2], v1[3]);
                        *(u32x4*)(hb + off + bj * 128) = w; } }
                if (MODE != 2) { rsum += __shfl_xor(rsum, 16); rsum += __shfl_xor(rsum, 32); if (fq == 0) atomicAdd(ss + row, rsum); } }
        }
    }
};
struct EpiProj {
    static constexpr bool PERM = true;
    bf16_t* O; const float* ss; bf16_t* vts; bf16_t* vtw;
    DI void operator()(const f32x4 (&acc)[2][2][4][2], const pg8::Unit& u, int wr, int wc, int fr, int fq, int ui, LAS unsigned char* lds) const {
        const int row0 = u.pm * 256 + wr * 64 + fr, col0 = u.pn * 256 + wc * 32 + 8 * fq;
        const bool tr = (u.pn == 7) || (u.pn == 9);
#pragma unroll
        for (int ai = 0; ai < 2; ++ai)
#pragma unroll
            for (int m = 0; m < 4; ++m) { const int row = row0 + ai * 128 + m * 16; bf16_t* rowp = O + (size_t)row * NPROJ + col0;
                const float rs = ((const LAS float*)(lds + 131072))[ui * 256 + wr * 64 + fr + ai * 128 + m * 16];
#pragma unroll
                for (int bj = 0; bj < 2; ++bj) { const f32x4 v0 = acc[ai][bj][m][0] * rs, v1 = acc[ai][bj][m][1] * rs;
                    u32x4 w; w.x = pk2(v0[0], v0[1]); w.y = pk2(v0[2], v0[3]); w.z = pk2(v1[0], v1[1]); w.w = pk2(v1[2], v1[3]);
                    if (!tr) *(u32x4*)(rowp + bj * 128) = w;
                    else { bf16_t* vt = (u.pn == 7 ? vts : vtw) + ((size_t)((row >> 11) * 2 + bj) * 128 + wc * 32 + 8 * fq) * TT + (row & 2047);
                        vt[0 * TT] = (bf16_t)(w.x & 0xffffu); vt[1 * TT] = (bf16_t)(w.x >> 16); vt[2 * TT] = (bf16_t)(w.y & 0xffffu); vt[3 * TT] = (bf16_t)(w.y >> 16);
                        vt[4 * TT] = (bf16_t)(w.z & 0xffffu); vt[5 * TT] = (bf16_t)(w.z >> 16); vt[6 * TT] = (bf16_t)(w.w & 0xffffu); vt[7 * TT] = (bf16_t)(w.w >> 16); } } }
    }
};
struct EpiGLU {
    static constexpr bool PERM = true;
    const bf16_t* HG; const float* bias; bf16_t* AS;
    DI void operator()(const f32x4 (&acc)[2][2][4][2], const pg8::Unit& u, int wr, int wc, int fr, int fq, int ui, LAS unsigned char* lds) const {
        const int row0 = u.pm * 256 + wr * 64 + fr, col0 = u.pn * 256 + wc * 32 + 8 * fq;
        f32x4 bs[2][2];
#pragma unroll
        for (int bj = 0; bj < 2; ++bj) { bs[bj][0] = *(const f32x4*)(bias + col0 + bj * 128); bs[bj][1] = *(const f32x4*)(bias + col0 + bj * 128 + 4); }
#pragma unroll
        for (int ai = 0; ai < 2; ++ai) {
            u32x4 hw[4][2];
#pragma unroll
            for (int m = 0; m < 4; ++m)
#pragma unroll
                for (int bj = 0; bj < 2; ++bj) hw[m][bj] = *(const u32x4*)(HG + (size_t)(row0 + ai * 128 + m * 16) * 1024 + col0 + bj * 128);
            __builtin_amdgcn_sched_barrier(0);
#pragma unroll
            for (int m = 0; m < 4; ++m) { const int row = row0 + ai * 128 + m * 16;
#pragma unroll
                for (int bj = 0; bj < 2; ++bj) { const int col = col0 + bj * 128; const u32x4 h = hw[m][bj];
                    const f32x4 v0 = acc[ai][bj][m][0] + bs[bj][0], v1 = acc[ai][bj][m][1] + bs[bj][1];
                    u32x4 w;
                    w.x = pk2(bflo(h.x) * sigmoidf_(v0[0]), bfhi(h.x) * sigmoidf_(v0[1]));
                    w.y = pk2(bflo(h.y) * sigmoidf_(v0[2]), bfhi(h.y) * sigmoidf_(v0[3]));
                    w.z = pk2(bflo(h.z) * sigmoidf_(v1[0]), bfhi(h.z) * sigmoidf_(v1[1]));
                    w.w = pk2(bflo(h.w) * sigmoidf_(v1[2]), bfhi(h.w) * sigmoidf_(v1[3]));
                    *(u32x4*)(AS + (size_t)row * DM + 1024 + col) = w; } }
        }
    }
};

DI void tconv(const float* __restrict__ src, int K, int N, int Npad, bf16_t* __restrict__ dst, int mode, float* tile, const float* __restrict__ gk = nullptr) {
    const int tid = threadIdx.x, ntk = K >> 6, ntn = Npad >> 7, ntile = ntk * ntn;
    f32x4 v[4];
    float gv[4];
#define TC_LOAD(tt) do { const int tk_ = (tt) % ntk, tn_ = (tt) / ntk; \
        _Pragma("unroll") for (int e = 0; e < 4; ++e) { const int i = tid + 512 * e, r = i >> 5, n = tn_ * 128 + (i & 31) * 4, nn = n < N ? n : N - 4; \
            v[e] = *(const f32x4*)(src + (size_t)(tk_ * 64 + r) * N + nn); gv[e] = gk ? gk[tk_ * 64 + r] : 1.0f; } } while (0)
    int t = blockIdx.x;
    if (t < ntile) TC_LOAD(t);
    for (; t < ntile; t += gridDim.x) {
#pragma unroll
        for (int e = 0; e < 4; ++e) { const int i = tid + 512 * e, r = i >> 5, c = (i & 31) * 4; const bool ok = (t / ntk) * 128 + c < N;
            const f32x4 x = ok ? v[e] * gv[e] : (f32x4){0.f, 0.f, 0.f, 0.f};
            tile[r * 129 + c] = x[0]; tile[r * 129 + c + 1] = x[1]; tile[r * 129 + c + 2] = x[2]; tile[r * 129 + c + 3] = x[3]; }
        __syncthreads();
        const int tk = t % ntk, tn = t / ntk;
        if (t + (int)gridDim.x < ntile) TC_LOAD(t + (int)gridDim.x);
        { const int nl = tid >> 2, kg = tid & 3, n = tn * 128 + nl;
          float x[16];
#pragma unroll
          for (int j = 0; j < 16; ++j) x[j] = tile[(kg * 16 + j) * 129 + nl];
          const int drow = mode == 0 ? n : (tn * 256 + nl + (mode == 2 ? 128 : 0));
          u32x4 w0, w1; w0.x = pk2(x[0], x[1]); w0.y = pk2(x[2], x[3]); w0.z = pk2(x[4], x[5]); w0.w = pk2(x[6], x[7]);
          w1.x = pk2(x[8], x[9]); w1.y = pk2(x[10], x[11]); w1.z = pk2(x[12], x[13]); w1.w = pk2(x[14], x[15]);
          u32x4* dp = (u32x4*)(dst + (size_t)drow * K + tk * 64 + kg * 16); dp[0] = w0; dp[1] = w1; }
        __syncthreads();
    }
#undef TC_LOAD
}

DI void norm_rows(const float* src, const float* __restrict__ g, bf16_t* dstb, float* dstf) {
    const int wid = threadIdx.x >> 6, lane = threadIdx.x & 63, stride = gridDim.x * 8;
    for (int row = blockIdx.x * 8 + wid; row < MTOK; row += 2 * stride) {
        const int row2 = row + stride; const bool has2 = row2 < MTOK;
        const f32x4* p = (const f32x4*)(src + (size_t)row * DM); const f32x4* p2 = (const f32x4*)(src + (size_t)(has2 ? row2 : row) * DM);
        f32x4 v[8], w[8]; float ss = 0.f, ss2 = 0.f;
#pragma unroll
        for (int i = 0; i < 8; ++i) { v[i] = p[lane + 64 * i]; w[i] = p2[lane + 64 * i]; }
#pragma unroll
        for (int i = 0; i < 8; ++i) { ss += v[i][0] * v[i][0] + v[i][1] * v[i][1] + v[i][2] * v[i][2] + v[i][3] * v[i][3]; ss2 += w[i][0] * w[i][0] + w[i][1] * w[i][1] + w[i][2] * w[i][2] + w[i][3] * w[i][3]; }
#pragma unroll
        for (int o = 32; o >= 1; o >>= 1) { ss += __shfl_xor(ss, o); ss2 += __shfl_xor(ss2, o); }
        const float rstd = 1.0f / sqrtf(ss * (1.0f / DM) + EPSN), rstd2 = 1.0f / sqrtf(ss2 * (1.0f / DM) + EPSN);
#pragma unroll
        for (int i = 0; i < 8; ++i) { const f32x4 gg = ((const f32x4*)g)[lane + 64 * i]; const f32x4 y = v[i] * rstd * gg, y2 = w[i] * rstd2 * gg;
            if (dstb) { u32x2 o; o.x = pk2(y[0], y[1]); o.y = pk2(y[2], y[3]); *(u32x2*)(dstb + (size_t)row * DM + (lane + 64 * i) * 4) = o;
                        if (has2) { u32x2 o2; o2.x = pk2(y2[0], y2[1]); o2.y = pk2(y2[2], y2[3]); *(u32x2*)(dstb + (size_t)row2 * DM + (lane + 64 * i) * 4) = o2; } }
            else { ((f32x4*)(dstf + (size_t)row * DM))[lane + 64 * i] = y; if (has2) ((f32x4*)(dstf + (size_t)row2 * DM))[lane + 64 * i] = y2; } }
    }
}

DI void phase_prep(const Params& P, unsigned char* smem) {
    unsigned char* ws = P.ws; float* tile = (float*)smem; const int tid = threadIdx.x;
    float* sm = (float*)(ws + WS_SMALL);
    if (blockIdx.x < 8) { const int idx = blockIdx.x * 512 + tid, grp = idx >> 6;
        const float step = expf(P.in[18][grp]), lre = P.in[16][idx], lim = P.in[17][idx];
        const float mag = expf(lre * step), ar = mag * cosf(lim * step), ai = mag * sinf(lim * step);
        const float nr = ar - 1.0f, ni = ai, den = lre * lre + lim * lim, fre = (nr * lre + ni * lim) / den, fim = (ni * lre - nr * lim) / den;
        f32x4 brv[4], biv[4];
#pragma unroll
        for (int k = 0; k < 4; ++k) { brv[k] = *(const f32x4*)(P.in[19] + idx * 16 + 4 * k); biv[k] = *(const f32x4*)(P.in[20] + idx * 16 + 4 * k); }
        bf16_t* tb = (bf16_t*)(sm + SM_BB); const int p = idx & 63;
        unsigned hre[16], lre_[16], him[16], lim_[16];
#pragma unroll
        for (int h = 0; h < 16; ++h) { const float br = brv[h >> 2][h & 3], bi = biv[h >> 2][h & 3];
            const float vre = fre * br - fim * bi, vim = fre * bi + fim * br;
            hre[h] = pk2(vre, 0.f) & 0xffffu; lre_[h] = pk2(vre - bf2f(hre[h]), 0.f) & 0xffffu;
            him[h] = pk2(vim, 0.f) & 0xffffu; lim_[h] = pk2(vim - bf2f(him[h]), 0.f) & 0xffffu; }
        { u32x4* d = (u32x4*)(tb + (grp * 128 + p) * 32);
          d[0] = (u32x4){hre[0] | (hre[1] << 16), hre[2] | (hre[3] << 16), hre[4] | (hre[5] << 16), hre[6] | (hre[7] << 16)};
          d[1] = (u32x4){hre[8] | (hre[9] << 16), hre[10] | (hre[11] << 16), hre[12] | (hre[13] << 16), hre[14] | (hre[15] << 16)};
          d[2] = (u32x4){lre_[0] | (lre_[1] << 16), lre_[2] | (lre_[3] << 16), lre_[4] | (lre_[5] << 16), lre_[6] | (lre_[7] << 16)};
          d[3] = (u32x4){lre_[8] | (lre_[9] << 16), lre_[10] | (lre_[11] << 16), lre_[12] | (lre_[13] << 16), lre_[14] | (lre_[15] << 16)};
          u32x4* e = (u32x4*)(tb + (grp * 128 + 64 + p) * 32);
          e[0] = (u32x4){him[0] | (him[1] << 16), him[2] | (him[3] << 16), him[4] | (him[5] << 16), him[6] | (him[7] << 16)};
          e[1] = (u32x4){him[8] | (him[9] << 16), him[10] | (him[11] << 16), him[12] | (him[13] << 16), him[14] | (him[15] << 16)};
          e[2] = (u32x4){lim_[0] | (lim_[1] << 16), lim_[2] | (lim_[3] << 16), lim_[4] | (lim_[5] << 16), lim_[6] | (lim_[7] << 16)};
          e[3] = (u32x4){lim_[8] | (lim_[9] << 16), lim_[10] | (lim_[11] << 16), lim_[12] | (lim_[13] << 16), lim_[14] | (lim_[15] << 16)}; }
        float pr = ar, pi = ai;
        for (int s = 0; s < 6; ++s) { const float nr2 = pr * pr - pi * pi, ni2 = 2.0f * pr * pi; pr = nr2; pi = ni2; }
        sm[SM_AB + idx * 4 + 0] = ar; sm[SM_AB + idx * 4 + 1] = ai; sm[SM_AB + idx * 4 + 2] = pr; sm[SM_AB + idx * 4 + 3] = pi; }
    { const int which = blockIdx.x >> 7, chunk = blockIdx.x & 127; const float* pe = P.in[which ? 11 : 7]; const float* w1 = P.in[which ? 12 : 8];
      if (blockIdx.x < 256) {
        const int n = tid & 127, sub = tid >> 7; float s = 0.f;
#pragma unroll
        for (int j = 0; j < 8; ++j) { const int k = chunk * 32 + sub * 8 + j; s += pe[k] * w1[(size_t)k * 128 + n]; }
        tile[tid] = s; __syncthreads();
        if (tid < 128) sm[SM_CBP + (which * 128 + chunk) * 128 + tid] = (tile[tid] + tile[tid + 128]) + (tile[tid + 256] + tile[tid + 384]);
        __syncthreads(); } }
    if (blockIdx.x == 10 && tid == 0) { ((int*)(sm + SM_CTR))[0] = 0; ((int*)(sm + SM_CTR))[1] = 0; }
    for (int i = blockIdx.x * 512 + tid; i < 32768; i += gridDim.x * 512) sm[SM_SS + i] = 0.f;
    { u32x4* z = (u32x4*)(ws + WS_KCB); const u32x4 zero = {0u, 0u, 0u, 0u};
      for (int i = blockIdx.x * 512 + tid; i < 65536; i += gridDim.x * 512) z[i] = zero; }
    norm_rows(P.in[0], P.in[1], (bf16_t*)(ws + WS_XN), nullptr);
    tconv(P.in[2], DM, DFF, DFF, (bf16_t*)(ws + WS_W13A), 1, tile);
    tconv(P.in[3], DM, DFF, DFF, (bf16_t*)(ws + WS_W13A), 2, tile);
    tconv(P.in[4], DFF, DM, DM, (bf16_t*)(ws + WS_W2A), 0, tile);
    tconv(P.in[6], DM, 3608, NPROJ, (bf16_t*)(ws + WS_WIN), 0, tile, P.in[5]);
    tconv(P.in[8], 4096, 128, 128, (bf16_t*)(ws + WS_CW1K), 0, tile);
    tconv(P.in[12], 4096, 128, 128, (bf16_t*)(ws + WS_CW1V), 0, tile);
    tconv(P.in[10], 128, 128, 128, (bf16_t*)(ws + WS_CW2K), 0, tile);
    tconv(P.in[14], 128, 128, 128, (bf16_t*)(ws + WS_CW2V), 0, tile);
    tconv(P.in[24], 1024, 1024, 1024, (bf16_t*)(ws + WS_GLUW), 0, tile);
    tconv(P.in[26], DM, DM, DM, (bf16_t*)(ws + WS_WOUT), 0, tile);
    tconv(P.in[28], DM, DFF, DFF, (bf16_t*)(ws + WS_W13B), 1, tile, P.in[27]);
    tconv(P.in[29], DM, DFF, DFF, (bf16_t*)(ws + WS_W13B), 2, tile, P.in[27]);
    tconv(P.in[30], DFF, DM, DM, (bf16_t*)(ws + WS_W2B), 0, tile);
}

DI void compress_item(const Params& P, int item, unsigned char* smem) {
    unsigned char* ws = P.ws; const int tid = threadIdx.x, wid = tid >> 6, lane = tid & 63, r = lane & 15, q = lane >> 4;
    const int which = item / 127, rt = item % 127;
    const bf16_t* proj = (const bf16_t*)(ws + WS_PROJ);
    const bf16_t* w1t = (const bf16_t*)(ws + (which ? WS_CW1V : WS_CW1K));
    const bf16_t* w2t = (const bf16_t*)(ws + (which ? WS_CW2V : WS_CW2K));
    const float* cb1 = (const float*)(ws + WS_SMALL) + SM_CB1 + which * 128;
    float* part = (float*)smem;
    bf16_t* hid = (bf16_t*)(smem + 65536);
    const int grow = rt * 16 + r, bg = grow / 127, c = grow % 127, b = bg >> 1, g = bg & 1;
    const bf16_t* arow = proj + (size_t)(b * TT + 16 * c) * NPROJ + (which ? C_VC : C_KC) + g * 128;
    f32x4 acc[8];
#pragma unroll
    for (int ct = 0; ct < 8; ++ct) acc[ct] = (f32x4){0.f, 0.f, 0.f, 0.f};
    bf16x8 fa[2], fb[2][8];
#define CP_LOAD(buf, s_) do { const int kabs_ = 512 * wid + 32 * (s_) + 8 * q; fa[buf] = *(const bf16x8*)(arow + (size_t)(kabs_ >> 7) * NPROJ + (kabs_ & 127)); \
        _Pragma("unroll") for (int ct = 0; ct < 8; ++ct) fb[buf][ct] = *(const bf16x8*)(w1t + (size_t)(ct * 16 + r) * 4096 + kabs_); } while (0)
    CP_LOAD(0, 0);
#pragma unroll
    for (int s = 0; s < 16; ++s) {
        if (s + 1 < 16) CP_LOAD((s + 1) & 1, s + 1);
        __builtin_amdgcn_sched_barrier(0);
#pragma unroll
        for (int ct = 0; ct < 8; ++ct) acc[ct] = __builtin_amdgcn_mfma_f32_16x16x32_bf16(fa[s & 1], fb[s & 1][ct], acc[ct], 0, 0, 0);
        __builtin_amdgcn_sched_barrier(0);
    }
#undef CP_LOAD
#pragma unroll
    for (int ct = 0; ct < 8; ++ct)
#pragma unroll
        for (int j = 0; j < 4; ++j) part[(wid * 16 + 4 * q + j) * 128 + ct * 16 + r] = acc[ct][j];
    __syncthreads();
    { const int row = tid >> 5, c4 = (tid & 31) * 4; f32x4 s = *(const f32x4*)(cb1 + c4);
#pragma unroll
      for (int w = 0; w < 8; ++w) s += *(const f32x4*)(part + (w * 16 + row) * 128 + c4);
      u32x2 o; o.x = pk2(gelu_tanh(s[0]), gelu_tanh(s[1])); o.y = pk2(gelu_tanh(s[2]), gelu_tanh(s[3]));
      *(u32x2*)(hid + row * 136 + c4) = o; }
    __syncthreads();
    { f32x4 a2 = {0.f, 0.f, 0.f, 0.f};
#pragma unroll
      for (int s = 0; s < 4; ++s) { const bf16x8 a = *(const bf16x8*)(hid + r * 136 + 32 * s + 8 * q);
          const bf16x8 bb = *(const bf16x8*)(w2t + (size_t)(16 * wid + r) * 128 + 32 * s + 8 * q);
          a2 = __builtin_amdgcn_mfma_f32_16x16x32_bf16(a, bb, a2, 0, 0, 0); }
      bf16_t* kcb = (bf16_t*)(ws + WS_KCB); bf16_t* vcbt = (bf16_t*)(ws + WS_VCBT);
#pragma unroll
      for (int j = 0; j < 4; ++j) { const int gr = rt * 16 + 4 * q + j, bg2 = gr / 127, c2 = gr % 127, col = 16 * wid + r;
          const bf16_t v = (bf16_t)(pk2(a2[j], 0.f) & 0xffffu);
          if (which == 0) kcb[(size_t)(bg2 * 128 + c2) * 128 + col] = v; else vcbt[(size_t)(bg2 * 128 + col) * 128 + c2] = v; } }
    __syncthreads();
}

DI void s5_bu16(const bf16x8 ub, const bf16x8 (&af)[8], float* buf, int r, int q) {
#pragma unroll
    for (int pt = 0; pt < 8; ++pt) { f32x4 d = {0.f, 0.f, 0.f, 0.f}; d = __builtin_amdgcn_mfma_f32_16x16x32_bf16(af[pt], ub, d, 0, 0, 0);
#pragma unroll
        for (int j = 0; j < 4; ++j) buf[(16 * pt + 4 * q + j) * 17 + r] = d[j]; }
}
DI void s5_pass1_item(const Params& P, int bitem, unsigned char* smem) {
    int tid_ = threadIdx.x; asm volatile("" : "+v"(tid_));
    unsigned char* ws = P.ws; const int tid = tid_, wid = tid >> 6, lane = tid & 63, r = lane & 15, q = lane >> 4;
    const int item = bitem * 8 + wid, ch = item & 31, grp = (item >> 5) & 63, b = item >> 11;
    const bf16_t* proj = (const bf16_t*)(ws + WS_PROJ); const float* sm = (const float*)(ws + WS_SMALL);
    float* buf = (float*)smem + wid * 2176;
    const bf16_t* tb = (const bf16_t*)(sm + SM_BB);
    bf16x8 af[8];
#pragma unroll
    for (int pt = 0; pt < 8; ++pt) af[pt] = *(const bf16x8*)(tb + (grp * 128 + 16 * pt + r) * 32 + 8 * q);
    const f32x4 ab = *(const f32x4*)(sm + SM_AB + (grp * 64 + lane) * 4);
    const bf16_t* ubase = proj + (size_t)(b * TT + ch * 64) * NPROJ + C_SSM + grp * 16;
    float xr = 0.f, xi = 0.f;
    bf16x8 ubs[4];
#pragma unroll
    for (int sub = 0; sub < 4; ++sub) ubs[sub] = *(const bf16x8*)(ubase + (size_t)(sub * 16 + r) * NPROJ + 8 * (q & 1));
#pragma unroll
    for (int sub = 0; sub < 4; ++sub) {
        s5_bu16(ubs[sub], af, buf, r, q);
        asm volatile("s_waitcnt lgkmcnt(0)" ::: "memory");
#pragma unroll
        for (int tt = 0; tt < 16; ++tt) { const float bur = buf[lane * 17 + tt], bui = buf[(64 + lane) * 17 + tt];
            const float nxr = ab[0] * xr - ab[1] * xi + bur, nxi = ab[0] * xi + ab[1] * xr + bui; xr = nxr; xi = nxi; }
        asm volatile("s_waitcnt lgkmcnt(0)" ::: "memory");
    }
    f32x2_t e = {xr, xi};
    *(f32x2_t*)(ws + WS_S5END + ((size_t)((b * 64 + grp) * 32 + ch) * 64 + lane) * 8) = e;
}

DI void vtrans_item(const Params& P, int item, unsigned char* smem) {
    unsigned char* ws = P.ws; const int tid = threadIdx.x;
    const int tokblk = item >> 3, cseg = item & 7, tok0 = tokblk * 64, b = tok0 >> 11, t0 = tok0 & 2047;
    const int col = (cseg < 4 ? C_VS + cseg * 64 : C_VW + (cseg - 4) * 64), g = (cseg & 3) >> 1, d0 = (cseg & 1) * 64;
    const bf16_t* proj = (const bf16_t*)(ws + WS_PROJ);
    bf16_t* dst = (bf16_t*)(ws + (cseg < 4 ? WS_VTS : WS_VTW)) + (size_t)((b * 2 + g) * 128 + d0) * TT + t0;
    bf16_t* tl = (bf16_t*)smem;
    { const int r = tid >> 3, sg = tid & 7; *(u32x4*)(tl + r * 72 + sg * 8) = *(const u32x4*)(proj + (size_t)(tok0 + r) * NPROJ + col + sg * 8); }
    __syncthreads();
    { const int d = tid >> 3, tsg = tid & 7; unsigned v[8];
#pragma unroll
      for (int j = 0; j < 8; ++j) v[j] = tl[(tsg * 8 + j) * 72 + d];
      u32x4 w; w.x = v[0] | (v[1] << 16); w.y = v[2] | (v[3] << 16); w.z = v[4] | (v[5] << 16); w.w = v[6] | (v[7] << 16);
      *(u32x4*)(dst + (size_t)d * TT + tsg * 8) = w; }
    __syncthreads();
}

DI void s5_pass3_item(const Params& P, int bitem, unsigned char* smem) {
    int tid_ = threadIdx.x; asm volatile("" : "+v"(tid_));
    unsigned char* ws = P.ws; const int tid = tid_, wid = tid >> 6, lane = tid & 63, r = lane & 15, q = lane >> 4;
    const int item = bitem * 8 + wid, ch = item & 31, grp = (item >> 5) & 63, b = item >> 11;
    const bf16_t* proj = (const bf16_t*)(ws + WS_PROJ); const float* sm = (const float*)(ws + WS_SMALL);
    float* xs = (float*)smem + wid * 2176;
    bf16_t* HG = (bf16_t*)(ws + WS_HG);
    const bf16_t* tb = (const bf16_t*)(sm + SM_BB);
    bf16x8 af[8];
#pragma unroll
    for (int pt = 0; pt < 8; ++pt) af[pt] = *(const bf16x8*)(tb + (grp * 128 + 16 * pt + r) * 32 + 8 * q);
    const f32x4 ab = *(const f32x4*)(sm + SM_AB + (grp * 64 + lane) * 4);
    float cB[32];
    { const float* cre = P.in[21] + (size_t)(grp * 16 + r) * 64; const float* cim = P.in[22] + (size_t)(grp * 16 + r) * 64;
#pragma unroll
      for (int i = 0; i < 32; ++i) { const int k = 4 * i + q; cB[i] = (i < 16) ? cre[k] : -cim[k - 64]; } }
    const float dsk = P.in[23][grp * 16 + r];
    const bf16_t* ubase = proj + (size_t)(b * TT + ch * 64) * NPROJ + C_SSM + grp * 16;
    bf16x8 ubs[4]; unsigned short uvs[4][4];
#pragma unroll
    for (int sub = 0; sub < 4; ++sub) { ubs[sub] = *(const bf16x8*)(ubase + (size_t)(sub * 16 + r) * NPROJ + 8 * (q & 1));
#pragma unroll
        for (int j = 0; j < 4; ++j) uvs[sub][j] = ubase[(size_t)(sub * 16 + 4 * q + j) * NPROJ + r]; }
    float xr = 0.f, xi = 0.f;
    {
      const f32x2_t* e = (const f32x2_t*)(ws + WS_S5END) + (size_t)((b * 64 + grp) * 32) * 64 + lane;
      f32x2_t ev[31];
#pragma unroll
      for (int j = 0; j < 31; ++j) ev[j] = e[(j < ch ? j : 0) * 64];
#pragma unroll
      for (int j = 0; j < 31; ++j) { const float ex = j < ch ? ev[j][0] : 0.f, ey = j < ch ? ev[j][1] : 0.f;
          const float ncr = ab[2] * xr - ab[3] * xi + ex, nci = ab[2] * xi + ab[3] * xr + ey; xr = j < ch ? ncr : xr; xi = j < ch ? nci : xi; } }
#pragma unroll
    for (int sub = 0; sub < 4; ++sub) {
        s5_bu16(ubs[sub], af, xs, r, q);
        float uv[4];
#pragma unroll
        for (int j = 0; j < 4; ++j) uv[j] = bf2f(uvs[sub][j]);
        asm volatile("s_waitcnt lgkmcnt(0)" ::: "memory");
#pragma unroll
        for (int tt = 0; tt < 16; ++tt) { const float bur = xs[lane * 17 + tt], bui = xs[(64 + lane) * 17 + tt];
            const float nxr = ab[0] * xr - ab[1] * xi + bur, nxi = ab[0] * xi + ab[1] * xr + bui; xr = nxr; xi = nxi;
            xs[lane * 17 + tt] = xr; xs[(64 + lane) * 17 + tt] = xi; }
        asm volatile("s_waitcnt lgkmcnt(0)" ::: "memory");
        f32x4 ya[4];
#pragma unroll
        for (int j = 0; j < 4; ++j) ya[j] = (f32x4){0.f, 0.f, 0.f, 0.f};
#pragma unroll
        for (int i = 0; i < 32; ++i) { const float a = xs[(4 * i + q) * 17 + r]; ya[i & 3] = __builtin_amdgcn_mfma_f32_16x16x4f32(a, cB[i], ya[i & 3], 0, 0, 0); }
        const f32x4 y = (ya[0] + ya[1]) + (ya[2] + ya[3]);
#pragma unroll
        for (int j = 0; j < 4; ++j) { const int tl = sub * 16 + 4 * q + j; const float v = y[j] + dsk * uv[j];
            HG[(size_t)(b * TT + ch * 64 + tl) * 1024 + grp * 16 + r] = (bf16_t)(pk2(gelu_tanh(v), 0.f) & 0xffffu); }
        asm volatile("s_waitcnt lgkmcnt(0)" ::: "memory");
    }
}

DI float xor32_max(float x) { const auto r_ = __builtin_amdgcn_permlane32_swap(__float_as_uint(x), __float_as_uint(x), false, false); return fmaxf(__uint_as_float(r_[0]), __uint_as_float(r_[1])); }
DI float xor32_sum(float x) { const auto r_ = __builtin_amdgcn_permlane32_swap(__float_as_uint(x), __float_as_uint(x), false, false); return __uint_as_float(r_[0]) + __uint_as_float(r_[1]); }
#define MFMA32(a, b, c) __builtin_amdgcn_mfma_f32_32x32x16_bf16((a), (b), (c), 0, 0, 0)
DI bf16x8 ld2x4(const bf16_t* p0) { const s16x4 a = *(const s16x4*)p0, b = *(const s16x4*)(p0 + 8); return __builtin_shufflevector(a, b, 0, 1, 2, 3, 4, 5, 6, 7); }
DI bf16x8 packp(const f32x16& x, int s) { u32x4 p; p.x = pk2(x[8 * s], x[8 * s + 1]); p.y = pk2(x[8 * s + 2], x[8 * s + 3]); p.z = pk2(x[8 * s + 4], x[8 * s + 5]); p.w = pk2(x[8 * s + 6], x[8 * s + 7]); return __builtin_bit_cast(bf16x8, p); }
DI int crow(int i, int hh) { return (i & 3) + 8 * (i >> 2) + 4 * hh; }

constexpr int A_STG = 0;
constexpr int A_BUF = 34816, A_VOFF = 17408;
constexpr int A_IMPM = 69632, A_IMPS = A_IMPM + 33792, A_IMPV = A_IMPS + 33792, A_LUT = A_IMPV + 8192, A_SELM = A_LUT + 4096;
DI bf16x8 lds2x4(const unsigned char* p) { const s16x4 a = *(const s16x4*)p, b = *(const s16x4*)(p + 16); return __builtin_shufflevector(a, b, 0, 1, 2, 3, 4, 5, 6, 7); }

constexpr float QK_C1 = 0.08838834764831845f * 1.4426950408889634f;
template <int MODE, bool FAR>
DI void attn_tile(const unsigned char* kl  , const unsigned char* vl  ,
                  int k0, int tq, int r, int hh, bool bit, const bf16x8 (&qf)[8], const float* lutH, f32x16 (&o)[4], float& m, float& l) {
    f32x16 s;
#pragma unroll
    for (int i = 0; i < 16; ++i) s[i] = 0.f;
    const unsigned char* kp = kl + r * 272 + 16 * hh;
#pragma unroll
    for (int kk = 0; kk < 8; ++kk) { const bf16x8 a = *(const bf16x8*)(kp + 32 * kk); s = MFMA32(a, qf[kk], s); }
    float tmax = NEGF;
    if (FAR) {
        const float b31 = lutH[255];
#pragma unroll
        for (int i = 0; i < 16; ++i) { const float v = s[i] * QK_C1 + b31; s[i] = (MODE == 0 && !bit) ? NEGF : v; tmax = fmaxf(tmax, s[i]); }
    } else {
#pragma unroll
        for (int i = 0; i < 16; ++i) { const int dist = tq - (k0 + crow(i, hh));
            const bool valid = MODE == 0 ? (bit && dist >= 0) : (dist >= 0 && dist < 512);
            const int di = dist < 0 ? 0 : (dist > 255 ? 255 : dist);
            const float v = s[i] * QK_C1 + lutH[di];
            s[i] = valid ? v : NEGF; tmax = fmaxf(tmax, s[i]); }
    }
    tmax = xor32_max(tmax);
    const float mnew = fmaxf(m, tmax);
    if (__ballot(mnew != m) != 0ull) {
        const float alpha = __builtin_amdgcn_exp2f(m - mnew);
        l *= alpha; m = mnew;
#pragma unroll
        for (int dt = 0; dt < 4; ++dt)
#pragma unroll
            for (int i = 0; i < 16; ++i) o[dt][i] *= alpha;
    }
    float psum = 0.f;
    if (FAR) {
#pragma unroll
        for (int i = 0; i < 16; ++i) { const float p = __builtin_amdgcn_exp2f(s[i] - mnew); s[i] = p; psum += p; }
    } else {
#pragma unroll
        for (int i = 0; i < 16; ++i) { const float p = (s[i] > -1e29f) ? __builtin_amdgcn_exp2f(s[i] - mnew) : 0.f; s[i] = p; psum += p; }
    }
    psum = xor32_sum(psum);
    l += psum;
    const unsigned char* vp = vl + r * 136 + 8 * hh;
#pragma unroll
    for (int s2 = 0; s2 < 2; ++s2) { const bf16x8 pb = packp(s, s2);
#pragma unroll
        for (int dt = 0; dt < 4; ++dt) { const bf16x8 a = lds2x4(vp + dt * (32 * 136) + 32 * s2); o[dt] = MFMA32(a, pb, o[dt]); } }
}

template <int MODE>
DI void attn_tile64_far(const unsigned char* bp  , int r, int hh, bool bit, const bf16x8 (&qf)[8], const float* lutH, f32x16 (&o)[4], float& m, float& l) {
    f32x16 s0, s1;
#pragma unroll
    for (int i = 0; i < 16; ++i) { s0[i] = 0.f; s1[i] = 0.f; }
    const unsigned char* kp = bp + r * 272 + 16 * hh;
#pragma unroll
    for (int kk = 0; kk < 8; ++kk) { const bf16x8 a0 = *(const bf16x8*)(kp + 32 * kk), a1 = *(const bf16x8*)(kp + 32 * 272 + 32 * kk); s0 = MFMA32(a0, qf[kk], s0); s1 = MFMA32(a1, qf[kk], s1); }
    const float b31 = lutH[255];
    float tmax = NEGF;
#pragma unroll
    for (int i = 0; i < 16; ++i) { const float v0 = s0[i] * QK_C1 + b31, v1 = s1[i] * QK_C1 + b31;
        s0[i] = (MODE == 0 && !bit) ? NEGF : v0; s1[i] = (MODE == 0 && !bit) ? NEGF : v1; tmax = fmaxf(tmax, fmaxf(s0[i], s1[i])); }
    tmax = xor32_max(tmax);
    const float mnew = fmaxf(m, tmax);
    if (__ballot(mnew != m) != 0ull) {
        const float alpha = __builtin_amdgcn_exp2f(m - mnew);
        l *= alpha; m = mnew;
#pragma unroll
        for (int dt = 0; dt < 4; ++dt)
#pragma unroll
            for (int i = 0; i < 16; ++i) o[dt][i] *= alpha;
    }
    float psum = 0.f;
#pragma unroll
    for (int i = 0; i < 16; ++i) { const float p0 = __builtin_amdgcn_exp2f(s0[i] - mnew), p1 = __builtin_amdgcn_exp2f(s1[i] - mnew); s0[i] = p0; s1[i] = p1; psum += p0 + p1; }
    l += xor32_sum(psum);
    const unsigned char* vp = bp + A_VOFF + r * 136 + 8 * hh;
#pragma unroll
    for (int s2 = 0; s2 < 2; ++s2) { const bf16x8 pb0 = packp(s0, s2), pb1 = packp(s1, s2);
#pragma unroll
        for (int dt = 0; dt < 4; ++dt) { const bf16x8 a0 = lds2x4(vp + dt * (32 * 136) + 32 * s2), a1 = lds2x4(vp + dt * (32 * 136) + 64 + 32 * s2);
            o[dt] = MFMA32(a0, pb0, o[dt]); o[dt] = MFMA32(a1, pb1, o[dt]); } }
}

template <int MODE>
DI void attn_branch(unsigned char* smem, const bf16_t* kb  , const bf16_t* vt  , unsigned need, unsigned mymask,
                    int t0w, int tq, int r, int hh, const bf16x8 (&qf)[8], const float* lutH, f32x16 (&o)[4], float& m, float& l) {
    int tid = threadIdx.x; asm volatile("" : "+v"(tid));
    if (need == 0u) return;
    u32x4 kreg[2], vreg[2];
    const int krow0 = tid >> 4, kcc = tid & 15, vd0 = tid >> 3, vcc = tid & 7;
#define AB_LOAD(j) do { _Pragma("unroll") for (int e = 0; e < 2; ++e) { \
        kreg[e] = *(const u32x4*)(kb + (size_t)(64 * (j) + krow0 + 32 * e) * NPROJ + kcc * 8); \
        vreg[e] = *(const u32x4*)(vt + (size_t)(vd0 + 64 * e) * TT + 64 * (j) + vcc * 8); } } while (0)
#define AB_STORE(buf) do { unsigned char* bp_ = smem + A_STG + (buf) * A_BUF; _Pragma("unroll") for (int e = 0; e < 2; ++e) { \
        *(u32x4*)(bp_ + (krow0 + 32 * e) * 272 + kcc * 16) = kreg[e]; \
        unsigned char* vp_ = bp_ + A_VOFF + (vd0 + 64 * e) * 136 + vcc * 16; \
        *(u32x2*)vp_ = (u32x2){vreg[e].x, vreg[e].y}; *(u32x2*)(vp_ + 8) = (u32x2){vreg[e].z, vreg[e].w}; } } while (0)
    int j = __builtin_ctz(need); need &= need - 1u;
    AB_LOAD(j); AB_STORE(0);
    __syncthreads();
    int n = 0;
    for (;;) {
        const bool has_next = need != 0u;
        int jn = 0;
        if (has_next) { jn = __builtin_ctz(need); need &= need - 1u; AB_LOAD(jn); }
        const unsigned char* bp = smem + A_STG + (n & 1) * A_BUF;
        const bool bit = MODE == 0 ? ((mymask >> j) & 1u) : true;
        const bool any = MODE == 0 ? (__ballot(bit) != 0ull) : true;
        const bool far64 = any && (64 * j + 63 + 128 <= t0w) && (MODE == 0 || 64 * j >= t0w + 31 - 511);
        if (far64) attn_tile64_far<MODE>(bp, r, hh, bit, qf, lutH, o, m, l);
        else {
#pragma unroll 1
        for (int half = 0; half < 2; ++half) { const int k0 = 64 * j + 32 * half;
            bool act = any && (k0 <= t0w + 31);
            if (MODE == 1) act = act && (k0 + 31 + 511 >= t0w);
            const bool far = (k0 + 31 + 128 <= t0w) && (MODE == 0 || k0 >= t0w + 31 - 511);
            if (act) { if (far) attn_tile<MODE, true>(bp + half * (32 * 272), bp + A_VOFF + half * 64, k0, tq, r, hh, bit, qf, lutH, o, m, l);
                       else attn_tile<MODE, false>(bp + half * (32 * 272), bp + A_VOFF + half * 64, k0, tq, r, hh, bit, qf, lutH, o, m, l); } }
        }
        if (has_next) AB_STORE((n + 1) & 1);
        __syncthreads();
        if (!has_next) break;
        j = jn; ++n;
    }
#undef AB_LOAD
#undef AB_STORE
}

DI void attn_item(const Params& P, int item, unsigned char* smem) {
    int tid_ = threadIdx.x; asm volatile("" : "+v"(tid_));
    unsigned char* ws = P.ws; const int tid = tid_, wid = tid >> 6, lane = tid & 63, r = lane & 31, hh = lane >> 5;
    const int bg = item & 15, qt = 31 - (item >> 4), b = bg >> 1, g = bg & 1, t0 = qt * 64;
    const int hg = wid >> 1, t0w = t0 + 32 * (wid & 1), tq = t0w + r, head = g * 4 + hg, qloc = 32 * (wid & 1) + r;
    const bf16_t* proj = (const bf16_t*)(ws + WS_PROJ);
    float* outs = (float*)(ws + WS_OUTS) + ((size_t)blockIdx.x * 8 + wid) * 4096;
    float* impM = (float*)(smem + A_IMPM); float* impS = (float*)(smem + A_IMPS); float* impv = (float*)(smem + A_IMPV);
    float* lut = (float*)(smem + A_LUT); unsigned* selm = (unsigned*)(smem + A_SELM);
    for (int i = tid; i < 1024; i += 512) { const int h4 = i >> 8, n = i & 255; int bk;
        if (n < 16) bk = n; else { bk = 16 + (int)(logf((float)n / 16.0f) / 2.0794415416798357f * 16.0f); bk = bk > 31 ? 31 : bk; }
        lut[i] = P.in[15][bk * 8 + g * 4 + h4] * 1.4426950408889634f; }
    { const bf16_t* kcb = (const bf16_t*)(ws + WS_KCB) + (size_t)bg * 16384; const bf16_t* vcbt = (const bf16_t*)(ws + WS_VCBT) + (size_t)bg * 16384;
#pragma unroll
      for (int e = 0; e < 4; ++e) { const int id = tid + 512 * e, row = id >> 4, cc = id & 15;
          *(u32x4*)(smem + A_STG + row * 272 + cc * 16) = *(const u32x4*)(kcb + row * 128 + cc * 8);
          *(u32x4*)(smem + A_STG + A_BUF + row * 272 + cc * 16) = *(const u32x4*)(vcbt + row * 128 + cc * 8); } }
    bf16x8 qf[8];
    { const bf16_t* qrow = proj + (size_t)(b * TT + tq) * NPROJ + head * 128 + 8 * hh;
#pragma unroll
      for (int kk = 0; kk < 8; ++kk) qf[kk] = *(const bf16x8*)(qrow + 16 * kk); }
    __syncthreads();
    const float* lutH = lut + hg * 256;
    f32x16 oc[4];
    {
        const unsigned char* kl = smem + A_STG + r * 272 + 16 * hh;
        const unsigned char* vl = smem + A_STG + A_BUF + r * 272 + 8 * hh;
        float mx = NEGF, sum = 0.f;
#pragma unroll 1
        for (int kt = 0; kt < 4; ++kt) {
            f32x16 sc;
#pragma unroll
            for (int i = 0; i < 16; ++i) sc[i] = 0.f;
#pragma unroll
            for (int kk = 0; kk < 8; ++kk) { const bf16x8 a = *(const bf16x8*)(kl + kt * (32 * 272) + 32 * kk); sc = MFMA32(a, qf[kk], sc); }
            float tmax = NEGF;
#pragma unroll
            for (int i = 0; i < 16; ++i) { const int c = 32 * kt + crow(i, hh), dist = tq - (16 * c + 31);
                const int di = dist < 0 ? 0 : (dist > 255 ? 255 : dist);
                const float v = sc[i] * QK_C1 + lutH[di];
                sc[i] = (dist >= 0 && c < 127) ? v : NEGF; tmax = fmaxf(tmax, sc[i]); }
            tmax = xor32_max(tmax);
            const float mnew = fmaxf(mx, tmax); float ps = 0.f;
#pragma unroll
            for (int i = 0; i < 16; ++i) ps += (sc[i] > -1e29f) ? __builtin_amdgcn_exp2f(sc[i] - mnew) : 0.f;
            ps = xor32_sum(ps);
            sum = sum * __builtin_amdgcn_exp2f(mx - mnew) + ps; mx = mnew;
        }
        const float inv = 1.0f / fmaxf(sum, 1e-30f);
#pragma unroll
        for (int dt = 0; dt < 4; ++dt)
#pragma unroll
            for (int i = 0; i < 16; ++i) oc[dt][i] = 0.f;
#pragma unroll 1
        for (int kt = 0; kt < 4; ++kt) {
            f32x16 sc;
#pragma unroll
            for (int i = 0; i < 16; ++i) sc[i] = 0.f;
#pragma unroll
            for (int kk = 0; kk < 8; ++kk) { const bf16x8 a = *(const bf16x8*)(kl + kt * (32 * 272) + 32 * kk); sc = MFMA32(a, qf[kk], sc); }
#pragma unroll
            for (int i = 0; i < 16; ++i) { const int c = 32 * kt + crow(i, hh), dist = tq - (16 * c + 31);
                const int di = dist < 0 ? 0 : (dist > 255 ? 255 : dist);
                const float v = sc[i] * QK_C1 + lutH[di];
                sc[i] = (dist >= 0 && c < 127) ? __builtin_amdgcn_exp2f(v - mx) * inv : 0.f; }
#pragma unroll
            for (int gi = 0; gi < 4; ++gi) { const int jb = 8 * kt + 2 * gi + hh; const float p3 = 0.5f * sc[4 * gi + 3];
                impM[(hg * 64 + qloc) * 33 + jb] = sc[4 * gi] + sc[4 * gi + 1] + sc[4 * gi + 2] + p3;
                impS[(hg * 64 + qloc) * 33 + jb] = p3; }
#pragma unroll
            for (int s2 = 0; s2 < 2; ++s2) { const bf16x8 pb = packp(sc, s2);
#pragma unroll
                for (int dt = 0; dt < 4; ++dt) { const bf16x8 a = lds2x4(vl + dt * (32 * 272) + 64 * kt + 32 * s2); oc[dt] = MFMA32(a, pb, oc[dt]); } }
        }
    }
    __syncthreads();
#pragma unroll 1
    for (int e = 0; e < 4; ++e) { const int idx = tid + 512 * e, qq = idx >> 5, j = idx & 31, t = t0 + qq, cur = t >> 6;
        float v = 0.f;
#pragma unroll
        for (int h = 0; h < 4; ++h) { v += impM[(h * 64 + qq) * 33 + j]; if (j > 0) v += impS[(h * 64 + qq) * 33 + j - 1]; }
        const bool forced = (j == 0) || (j == cur) || (j == cur - 1);
        impv[idx] = forced ? 1e6f : (j <= cur ? v : -1e9f); }
    __syncthreads();
#pragma unroll 1
    for (int e = 0; e < 4; ++e) { const int idx = tid + 512 * e, qq = idx >> 5, j = idx & 31;
        const float my = impv[idx]; int rank = 0;
#pragma unroll 8
        for (int j2 = 0; j2 < 32; ++j2) { const float o2 = impv[qq * 32 + j2]; rank += (o2 > my || (o2 == my && j2 < j)) ? 1 : 0; }
        const unsigned long long bal = __ballot(rank < 16);
        if (lane == 0) selm[qq] = (unsigned)bal; if (lane == 32) selm[qq] = (unsigned)(bal >> 32); }
    __syncthreads();
    float gc, gs, gw;
    { const bf16_t* gp = proj + (size_t)(b * TT + tq) * NPROJ + C_GATE + head * 3;
      gc = sigmoidf_(bf2f(gp[0])); gs = sigmoidf_(bf2f(gp[1])); gw = sigmoidf_(bf2f(gp[2])); }
    { float* outs1_ = outs + lane; asm volatile("" : "+v"(outs1_)); GAS float* outs1 = (GAS float*)outs1_;
#pragma unroll
    for (int dt = 0; dt < 4; ++dt)
#pragma unroll
        for (int i = 0; i < 16; ++i) outs1[(dt * 16 + i) * 64] = gc * oc[dt][i]; }
    const unsigned mymask = selm[qloc];
    unsigned uni = selm[lane];
#pragma unroll
    for (int o_ = 32; o_ >= 1; o_ >>= 1) uni |= (unsigned)__shfl_xor((int)uni, o_);
    uni = __builtin_amdgcn_readfirstlane(uni);
    f32x16 o[4]; float m, l;
    {
#pragma unroll
        for (int dt = 0; dt < 4; ++dt)
#pragma unroll
            for (int i = 0; i < 16; ++i) o[dt][i] = 0.f;
        m = NEGF; l = 0.f;
        const bf16_t* kb = proj + (size_t)(b * TT) * NPROJ + C_KS + g * 128;
        const bf16_t* vt = (const bf16_t*)(ws + WS_VTS) + (size_t)bg * 128 * TT;
        const unsigned need = uni & (qt == 31 ? 0xffffffffu : ((1u << (qt + 1)) - 1u));
        attn_branch<0>(smem, kb, vt, need, mymask, t0w, tq, r, hh, qf, lutH, o, m, l);
        const float sc = gs / fmaxf(l, 1e-30f);
        float* outs2_ = outs + lane; asm volatile("" : "+v"(outs2_)); GAS float* outs2 = (GAS float*)outs2_;
        f32x16 pv[4];
#pragma unroll
        for (int dt = 0; dt < 4; ++dt)
#pragma unroll
            for (int i = 0; i < 16; ++i) pv[dt][i] = outs2[(dt * 16 + i) * 64];
        __builtin_amdgcn_sched_barrier(0);
#pragma unroll
        for (int dt = 0; dt < 4; ++dt)
#pragma unroll
            for (int i = 0; i < 16; ++i) outs2[(dt * 16 + i) * 64] = pv[dt][i] + sc * o[dt][i];
    }
    {
#pragma unroll
        for (int dt = 0; dt < 4; ++dt)
#pragma unroll
            for (int i = 0; i < 16; ++i) o[dt][i] = 0.f;
        m = NEGF; l = 0.f;
        const bf16_t* kb = proj + (size_t)(b * TT) * NPROJ + C_KW + g * 128;
        const bf16_t* vt = (const bf16_t*)(ws + WS_VTW) + (size_t)bg * 128 * TT;
        const int jlo = qt >= 8 ? qt - 8 : 0;
        const unsigned need = (qt == 31 ? 0xffffffffu : ((1u << (qt + 1)) - 1u)) & ~((1u << jlo) - 1u);
        attn_branch<1>(smem, kb, vt, need, 0u, t0w, tq, r, hh, qf, lutH, o, m, l);
        const float sc = gw / fmaxf(l, 1e-30f);
        float* outs3_ = outs + lane; asm volatile("" : "+v"(outs3_)); GAS float* outs3 = (GAS float*)outs3_;
        bf16_t* as = (bf16_t*)(ws + WS_AS) + (size_t)(b * TT + tq) * DM + head * 128;
        f32x16 pv[4];
#pragma unroll
        for (int dt = 0; dt < 4; ++dt)
#pragma unroll
            for (int i = 0; i < 16; ++i) pv[dt][i] = outs3[(dt * 16 + i) * 64];
        __builtin_amdgcn_sched_barrier(0);
#pragma unroll
        for (int dt = 0; dt < 4; ++dt)
#pragma unroll
            for (int gi = 0; gi < 4; ++gi) { float v[4];
#pragma unroll
                for (int j = 0; j < 4; ++j) { const int i = 4 * gi + j; v[j] = pv[dt][i] + sc * o[dt][i]; }
                u32x2 w; w.x = pk2(v[0], v[1]); w.y = pk2(v[2], v[3]);
                *(u32x2*)(as + 32 * dt + 8 * gi + 4 * hh) = w; }
    }
}

DI void fill_rstd(const pg8::StaticOrder& S, const float* ss, unsigned char* smem) {
    float* rl = (float*)(smem + 131072);
    for (int i = 0; i < 16; ++i) { pg8::Unit u; if (!S.next(i, u)) break;
        if (threadIdx.x < 256) rl[i * 256 + threadIdx.x] = 1.0f / sqrtf(ss[u.pm * 256 + threadIdx.x] * (1.0f / DM) + EPSN); }
    __syncthreads();
}

#define XB_TMO      128
#define XB_XCNT(j)  (256  + 64 * (j))
#define XB_XSUB(j)  (1280 + 64 * (j))
#define XB_XGEN(j)  (2304 + 64 * (j))
#define XB_TOP      3328
#define XB_TOPGEN   3392
#define XCD_BAR_WORDS 3456
#define XB_SPIN_CAP (1u << 18)
DI unsigned xb_ld(unsigned* p)              { return __hip_atomic_load(p, __ATOMIC_RELAXED, __HIP_MEMORY_SCOPE_AGENT); }
DI unsigned xb_add(unsigned* p, unsigned v) { return __hip_atomic_fetch_add(p, v, __ATOMIC_RELAXED, __HIP_MEMORY_SCOPE_AGENT); }
DI unsigned xb_xcc_id() { return (unsigned)__builtin_amdgcn_s_getreg((3 << 11) | 20) & 0xFu; }
#define XB_SPIN(cond, bar) do { unsigned _sp = 0; while (cond) { __builtin_amdgcn_s_sleep(1); \
    if ((++_sp & 255u) == 0u) { if (xb_ld(&(bar)[XB_TMO])) break; if (_sp > XB_SPIN_CAP) { atomicAdd(&(bar)[XB_TMO], 1u); break; } } } } while (0)
struct XcdBarrier { unsigned* bar; unsigned x; volatile LAS unsigned* st; };
DI XcdBarrier xcd_barrier_post(unsigned* bar, volatile LAS unsigned* st) {
    XcdBarrier b; b.bar = bar; b.x = xb_xcc_id(); b.st = st;
    if (threadIdx.x == 0) (void)xb_add(&bar[XB_XCNT(b.x)], 1u);
    return b;
}
DI void xcd_barrier_complete(unsigned* bar, unsigned x, unsigned& nloc, unsigned& nx) {
    const unsigned G = gridDim.x * gridDim.y * gridDim.z;
    unsigned sum, cnt, mine, sp = 0u;
    for (;;) {
        sum = 0u; cnt = 0u; mine = 0u;
#pragma unroll
        for (unsigned j = 0; j < 16; ++j) { const unsigned c = xb_ld(&bar[XB_XCNT(j)]); sum += c; cnt += (c > 0u) ? 1u : 0u; mine = (j == x) ? c : mine; }
        if (sum == G) break;
        __builtin_amdgcn_s_sleep(1);
        if ((++sp & 255u) == 0u) { if (xb_ld(&bar[XB_TMO])) break; if (sp > XB_SPIN_CAP) { atomicAdd(&bar[XB_TMO], 1u); break; } }
    }
    nloc = mine > 0u ? mine : 1u; nx = cnt > 0u ? cnt : 1u;
}
DI void xcd_barrier(const XcdBarrier& b) {
    asm volatile("s_waitcnt vmcnt(0)" ::: "memory");
    __syncthreads();
    if (threadIdx.x == 0) {
        unsigned* bar = b.bar;
        __builtin_amdgcn_s_waitcnt(0);
        unsigned nloc = b.st[0], nx = b.st[1];
        if (nloc == 0u) { xcd_barrier_complete(bar, b.x, nloc, nx); b.st[0] = nloc; b.st[1] = nx; }
        const unsigned old = xb_add(&bar[XB_XSUB(b.x)], 1u);
        const unsigned gen = old / nloc;
        if (old + 1u == (gen + 1u) * nloc) {
            __builtin_amdgcn_fence(__ATOMIC_RELEASE, "agent");
            asm volatile("s_waitcnt vmcnt(0)" ::: "memory");
            const unsigned og = xb_add(&bar[XB_TOP], 1u);
            const unsigned tg = og / nx;
            if (og + 1u == (tg + 1u) * nx) xb_add(&bar[XB_TOPGEN], 1u);
            else XB_SPIN(xb_ld(&bar[XB_TOPGEN]) == tg, bar);
            __builtin_amdgcn_fence(__ATOMIC_ACQUIRE, "agent");
            xb_add(&bar[XB_XGEN(b.x)], 1u);
            asm volatile("s_waitcnt vmcnt(0)" ::: "memory");
        } else {
            XB_SPIN(xb_ld(&bar[XB_XGEN(b.x)]) == gen, bar);
            __builtin_amdgcn_fence(__ATOMIC_ACQUIRE, "agent");
            asm volatile("s_waitcnt vmcnt(0)" ::: "memory");
        }
    }
    __syncthreads();
}

__global__ void __launch_bounds__(512, 2) hymba_fwd(Params P) {
    extern __shared__ __attribute__((aligned(16))) unsigned char shm[];
    cg::grid_group grid = cg::this_grid();
    unsigned char* ws = P.ws;
    LAS unsigned char* lds = (LAS unsigned char*)shm;
    const int tid = threadIdx.x, G = gridDim.x;
    float* hres = P.out;
    const int lo = P.ph_lo, hi = P.ph_hi;
    volatile LAS unsigned* xbst = (volatile LAS unsigned*)(lds + L_CUR + 16);
    if (tid == 0) { xbst[0] = 0u; xbst[1] = 0u; }
    __syncthreads();
    const XcdBarrier xbar = xcd_barrier_post((unsigned*)((float*)(ws + WS_SMALL) + SM_BAR), xbst);
    unsigned* xrank = xbar.bar + XCD_BAR_WORDS;
    if (tid == 0) xbst[2] = xb_add(&xrank[xbar.x], 1u);
    __syncthreads();
    const unsigned myrank = xbst[2];
    int cid = (int)blockIdx.x;
#define IN(k) (lo <= (k) && (k) < hi)
#define SYNC(k) do { if (IN(k) && IN((k) + 1)) { if ((k) == 0) grid.sync(); else xcd_barrier(xbar); } } while (0)
#ifndef DUP_PH
#define DUP_PH -1
#endif
#define REP(k) for (int rep_ = 0; rep_ < ((k) == DUP_PH ? 2 : 1); ++rep_, (((k) == DUP_PH && rep_ == 1) ? grid.sync() : (void)0))
    if (IN(0)) REP(0) phase_prep(P, shm);
    SYNC(0);
    { bool ok = (G % 8) == 0;
      for (int j = 0; j < 16; ++j) { const unsigned c = xb_ld(&xrank[j]); ok = ok && (c == (j < 8 ? (unsigned)G / 8u : 0u)); }
      if (ok && lo == 0 && hi > 1) cid = (int)(myrank * 8u + xbar.x); }
    if (IN(1)) REP(1) { pg8::Gemm g{(const bf16_t*)(ws + WS_XN), (const bf16_t*)(ws + WS_W13A), MTOK, 2 * DFF, DM};
        pg8::StaticOrder S; S.init(MTOK, 2 * DFF, G, cid); EpiSwiGLU E{(bf16_t*)(ws + WS_H), nullptr};
        pg8::gemm_phase<EpiSwiGLU, pg8::StaticOrder>(lds, g, S, E); }
    SYNC(1);
    if (IN(2)) REP(2) { pg8::Gemm g{(const bf16_t*)(ws + WS_H), (const bf16_t*)(ws + WS_W2A), MTOK, DM, DFF};
        pg8::StaticOrder S; S.init(MTOK, DM, G, cid); EpiResid<0> E{P.in[0], nullptr, nullptr, (bf16_t*)hres, (float*)(ws + WS_SMALL) + SM_SS, 0.5f};
        pg8::gemm_phase<EpiResid<0>, pg8::StaticOrder>(lds, g, S, E); }
    if (IN(2) && hi > 3) xcd_barrier(xbar);
    if (IN(4)) REP(4) {
        if (blockIdx.x == 0 && tid < 256) { float* sm = (float*)(ws + WS_SMALL); const int which = tid >> 7, n = tid & 127; float s = P.in[which ? 13 : 9][n];
            for (int c = 0; c < 128; ++c) s += sm[SM_CBP + (which * 128 + c) * 128 + n];
            sm[SM_CB1 + which * 128 + n] = s; }
        pg8::Gemm g{(const bf16_t*)hres, (const bf16_t*)(ws + WS_WIN), MTOK, NPROJ, DM};
        pg8::StaticOrder S; S.init(MTOK, NPROJ, G, cid); EpiProj E{(bf16_t*)(ws + WS_PROJ), (const float*)(ws + WS_SMALL) + SM_SS, (bf16_t*)(ws + WS_VTS), (bf16_t*)(ws + WS_VTW)}; fill_rstd(S, E.ss, shm);
        pg8::gemm_phase<EpiProj, pg8::StaticOrder>(lds, g, S, E); }
    SYNC(4);
    if (IN(5)) REP(5) {
        for (int it = blockIdx.x; it < 254 + 2048; it += G) {
            if (it < 254) compress_item(P, it, shm);
            else { s5_pass1_item(P, it - 254, shm); __syncthreads(); }
        } }
    SYNC(5);
    if (IN(6)) REP(6) {
        int* ctr = (int*)((float*)(ws + WS_SMALL) + SM_CTR) + rep_;
        volatile int* curw = (volatile int*)(shm + L_CUR);
        for (;;) {
            __syncthreads();
            if (tid == 0) *curw = atomicAdd(ctr, 1);
            __syncthreads();
            const int it = *curw;
            if (it >= 512 + 2048) break;
            if (it < 512) attn_item(P, it, shm); else s5_pass3_item(P, it - 512, shm);
        } }
    SYNC(6);
    if (IN(7)) REP(7) { pg8::Gemm g{(const bf16_t*)(ws + WS_HG), (const bf16_t*)(ws + WS_GLUW), MTOK, 1024, 1024};
        pg8::StaticOrder S; S.init(MTOK, 1024, G, cid); EpiGLU E{(const bf16_t*)(ws + WS_HG), P.in[25], (bf16_t*)(ws + WS_AS)};
        pg8::gemm_phase<EpiGLU, pg8::StaticOrder>(lds, g, S, E); }
    SYNC(7);
    if (IN(8)) REP(8) { pg8::Gemm g{(const bf16_t*)(ws + WS_AS), (const bf16_t*)(ws + WS_WOUT), MTOK, DM, DM};
        pg8::StaticOrder S; S.init(MTOK, DM, G, cid); EpiResid<1> E{nullptr, (const bf16_t*)hres, nullptr, (bf16_t*)(ws + WS_XN), (float*)(ws + WS_SMALL) + SM_SS + 16384, 1.0f};
        pg8::gemm_phase<EpiResid<1>, pg8::StaticOrder>(lds, g, S, E); }
    if (IN(8) && hi > 9) xcd_barrier(xbar);
    if (IN(10)) REP(10) { pg8::Gemm g{(const bf16_t*)(ws + WS_XN), (const bf16_t*)(ws + WS_W13B), MTOK, 2 * DFF, DM};
        pg8::StaticOrder S; S.init(MTOK, 2 * DFF, G, cid); EpiSwiGLU E{(bf16_t*)(ws + WS_H), (const float*)(ws + WS_SMALL) + SM_SS + 16384}; fill_rstd(S, E.ss, shm);
        pg8::gemm_phase<EpiSwiGLU, pg8::StaticOrder>(lds, g, S, E); }
    SYNC(10);
    if (IN(11)) REP(11) { pg8::Gemm g{(const bf16_t*)(ws + WS_H), (const bf16_t*)(ws + WS_W2B), MTOK, DM, DFF};
        pg8::StaticOrder S; S.init(MTOK, DM, G, cid); EpiResid<2> E{nullptr, (const bf16_t*)(ws + WS_XN), hres, nullptr, nullptr, 0.5f};
        pg8::gemm_phase<EpiResid<2>, pg8::StaticOrder>(lds, g, S, E); }
    SYNC(11);
    if (IN(12)) REP(12) norm_rows(hres, P.in[31], nullptr, hres);
}

#ifndef N_LAUNCH_MODE
#define N_LAUNCH_MODE 0
#endif

extern "C" void kernel_launch(void* const* d_in, const int* in_sizes, int n_in, void* d_out, int out_size, void* d_ws, size_t ws_size, hipStream_t stream) {
    static int grid = 0;
    if (grid == 0) {
        int dev = 0, cus = 0, per_cu = 0;
        hipGetDevice(&dev);
        hipDeviceGetAttribute(&cus, hipDeviceAttributeMultiprocessorCount, dev);
        hipFuncSetAttribute((const void*)hymba_fwd, hipFuncAttributeMaxDynamicSharedMemorySize, LDS_BYTES);
        hipOccupancyMaxActiveBlocksPerMultiprocessor(&per_cu, (const void*)hymba_fwd, 512, LDS_BYTES);
        if (per_cu < 1) { fprintf(stderr, "occupancy query says %d blocks/CU\n", per_cu); per_cu = 1; }
        (void)hipGetLastError();
        grid = cus * 1;
        if (n_in != 32 || ws_size < WS_END) fprintf(stderr, "kernel_launch: unexpected n_in %d / ws %zu\n", n_in, ws_size);
    }
    Params p{};
    for (int i = 0; i < 32; ++i) p.in[i] = (const float*)d_in[i];
    p.out = (float*)d_out; p.ws = (unsigned char*)d_ws;
    (void)hipMemsetAsync((unsigned char*)d_ws + WS_SMALL + (size_t)SM_BAR * 4, 0, XCD_BAR_WORDS * 4 + 64, stream);
#if N_LAUNCH_MODE == 0
    p.ph_lo = 0; p.ph_hi = NPH;
    { void* args[] = {&p};
      hipError_t e = hipLaunchCooperativeKernel((const void*)hymba_fwd, dim3(grid), dim3(512), args, LDS_BYTES, stream);
      if (e != hipSuccess) fprintf(stderr, "cooperative launch failed: %s (grid %d)\n", hipGetErrorString(e), grid); }
#else
    for (int ph = 0; ph < NPH; ++ph) { p.ph_lo = ph; p.ph_hi = ph + 1;
        void* args[] = {&p};
        hipError_t e = hipLaunchCooperativeKernel((const void*)hymba_fwd, dim3(grid), dim3(512), args, LDS_BYTES, stream);
        if (e != hipSuccess) fprintf(stderr, "launch %d failed: %s (grid %d)\n", ph, hipGetErrorString(e), grid); }
#endif
}
```

```cpp
#include <hip/hip_runtime.h>
#include <hip/hip_cooperative_groups.h>
#include <cstdio>
namespace cg = cooperative_groups;

#define DI __device__ __forceinline__
#define LAS __attribute__((address_space(3)))
#define GAS __attribute__((address_space(1)))
typedef unsigned short bf16_t;
typedef short bf16x8 __attribute__((ext_vector_type(8)));
typedef short s16x4 __attribute__((ext_vector_type(4)));
typedef float f32x4 __attribute__((ext_vector_type(4)));
typedef float f32x16 __attribute__((ext_vector_type(16)));
typedef unsigned u32x4 __attribute__((ext_vector_type(4)));
typedef unsigned u32x2 __attribute__((ext_vector_type(2)));
typedef __bf16 bf16x2_t __attribute__((ext_vector_type(2)));
typedef float f32x2_t __attribute__((ext_vector_type(2)));

constexpr int MTOK = 16384, DM = 2048, DFF = 5632, TT = 2048;
constexpr int NPROJ = 3840;
constexpr int C_KC = 1024, C_VC = 1280, C_KS = 1536, C_VS = 1792, C_KW = 2048, C_VW = 2304, C_GATE = 2560, C_SSM = 2584;
constexpr float EPSN = 1e-6f;
constexpr float NEGF = -1e30f;

constexpr size_t WS_W13A = 0;
constexpr size_t WS_W2A = WS_W13A + 46137344;
constexpr size_t WS_W13B = WS_W2A + 23068672;
constexpr size_t WS_W2B = WS_W13B + 46137344;
constexpr size_t WS_WIN = WS_W2B + 23068672;
constexpr size_t WS_WOUT = WS_WIN + 15728640;
constexpr size_t WS_GLUW = WS_WOUT + 8388608;
constexpr size_t WS_CW1K = WS_GLUW + 2097152;
constexpr size_t WS_CW1V = WS_CW1K + 1048576;
constexpr size_t WS_CW2K = WS_CW1V + 1048576;
constexpr size_t WS_CW2V = WS_CW2K + 32768;
constexpr size_t WS_SMALL = WS_CW2V + 32768;
constexpr size_t WS_KCB = WS_SMALL + 1048576;
constexpr size_t WS_VCBT = WS_KCB + 524288;
constexpr size_t WS_S5END = WS_VCBT + 524288;
constexpr size_t WS_VTS = WS_S5END + 8388608;
constexpr size_t WS_VTW = WS_VTS + 8388608;
constexpr size_t WS_XN = WS_VTW + 8388608;
constexpr size_t WS_H = WS_XN + 67108864;
constexpr size_t WS_PROJ = WS_H;
constexpr size_t WS_AS = WS_H + 125829120;
constexpr size_t WS_HG = WS_XN;
constexpr size_t WS_OUTS = WS_H + 184549376 + 8388608;
constexpr size_t WS_END = WS_OUTS + 33554432;
constexpr int SM_CB1 = 0;
constexpr int SM_AB = 256;
constexpr int SM_BB = 256 + 16384;
constexpr int SM_CTR = 256 + 16384 + 131072;
constexpr int SM_CBP = SM_CTR + 64;
constexpr int SM_SS = SM_CBP + 32768;
constexpr int SM_BAR = 213504;

constexpr int LDS_BYTES = 151552;
constexpr int L_CUR = 149776;
constexpr int NPH = 13;

struct Params { const float* in[32]; float* out; unsigned char* ws; int ph_lo, ph_hi; };

DI unsigned pk2(float a, float b) { f32x2_t v = {a, b}; return __builtin_bit_cast(unsigned, __builtin_convertvector(v, bf16x2_t)); }
DI float bf2f(unsigned x) { return __uint_as_float(x << 16); }
DI float bflo(unsigned w) { return __uint_as_float(w << 16); }
DI float bfhi(unsigned w) { return __uint_as_float(w & 0xffff0000u); }
DI float sigmoidf_(float x) { return __builtin_amdgcn_rcpf(1.0f + __builtin_amdgcn_exp2f(-1.4426950408889634f * x)); }
DI float gelu_tanh(float v) { const float z = 0.7978845608028654f * (v + 0.044715f * v * v * v); const float th = 1.0f - 2.0f * __builtin_amdgcn_rcpf(__builtin_amdgcn_exp2f(2.8853900817779268f * z) + 1.0f); return 0.5f * v * (1.0f + th); }

namespace pg8 {
constexpr int BM = 256, BK = 64, HALF = 128, HTB = HALF * BK * 2, STAGE_BYTES = 8 * HTB, NXCD = 8, WGM = 8;
__host__ __device__ __forceinline__ int lds_byte(int r, int c) { const int st = (r >> 4) * 2 + (c >> 5), rr = r & 15, cc = c & 31, ob = rr * 64 + cc * 2; return st * 1024 + (ob ^ (((ob >> 9) & 1) << 5)); }
__host__ __device__ __forceinline__ void stage_rc(int b, int& R, int& C) { const int st = b / 1024, sb = b % 1024, swz = sb ^ (((sb >> 9) & 1) << 5); R = (st >> 1) * 16 + swz / 64; C = (st & 1) * 32 + (swz % 64) / 2; }
__host__ __device__ __forceinline__ int perm32(int rho) { const int n = rho >> 4, i = rho & 15; return 8 * (i >> 2) + 4 * n + (i & 3); }
struct Unit { int pm, pn; };
struct Gemm { const bf16_t* A; const bf16_t* Bt; int M, N, K; };
struct StaticOrder {
    int nM, nN, nwg, G, c;
    __host__ __device__ void init(int M, int N, int G_, int c_) { nM = M / BM; nN = N / BM; nwg = nM * nN; G = G_; c = c_; }
    __host__ __device__ bool next(int i, Unit& u) const {
        const long L = (long)i * G + c; if (L >= nwg) return false;
        int wgid = (int)L; { const int q = nwg / NXCD, r = nwg % NXCD, xcd = wgid % NXCD, off = wgid / NXCD; wgid = (xcd < r ? xcd * (q + 1) : r * (q + 1) + (xcd - r) * q) + off; }
        const int nig = WGM * nN, gid = wgid / nig, fm = gid * WGM, gsz = (nM - fm) < WGM ? (nM - fm) : WGM;
        u.pm = fm + ((wgid % nig) % gsz); u.pn = (wgid % nig) / gsz; return true;
    }
    __device__ __forceinline__ void a_ready(const Unit&) const {}
    __device__ __forceinline__ void done(const Unit&) const {}
};

template <class Epi, class Sched>
__device__ __forceinline__ void gemm_phase(LAS unsigned char* lds, const Gemm g, const Sched& S, const Epi& E) {
    const int tid = threadIdx.x, wid = __builtin_amdgcn_readfirstlane(tid >> 6), lane = tid & 63, wr = wid >> 2, wc = wid & 3, fr = lane & 15, fq = lane >> 4;
    const int K = g.K, nt = K / BK;
    unsigned voffA[2], voffB[2];
#pragma unroll
    for (int i = 0; i < 2; ++i) { int R, C; stage_rc(tid * 16 + i * 8192, R, C); const int Rb = Epi::PERM ? ((R & ~31) + perm32(R & 31)) : R;
        voffA[i] = (unsigned)(R * K + C) * 2u; voffB[i] = (unsigned)(Rb * K + C) * 2u; }
    const size_t kstep = (size_t)(BK * 2);
    const size_t hstep = (size_t)HALF * K * 2;
    const size_t tstep = 2 * hstep;
    const unsigned ldsw = (unsigned)wid * 1024u;
    const int aoff = lds_byte(wr * 64 + fr, fq * 8), boff = lds_byte(wc * 32 + fr, fq * 8);
#define PG8_SA(b, h) (((b) * 2 + (h)) * HTB)
#define PG8_SB(b, h) ((4 + (b) * 2 + (h)) * HTB)
#define PG8_STAGE(bufoff, gbase, voff) do { _Pragma("unroll") for (int _i = 0; _i < 2; ++_i) \
        __builtin_amdgcn_global_load_lds((const unsigned*)((const char*)(gbase) + (voff)[_i]), (LAS unsigned*)(lds + (bufoff) + ldsw + _i * 8192), 16, 0, 0); } while (0)
#define PG8_LDA(dst, b, h) do { _Pragma("unroll") for (int m = 0; m < 4; ++m) _Pragma("unroll") for (int k = 0; k < 2; ++k) dst[m][k] = *(const LAS bf16x8*)(lds + PG8_SA(b, h) + aoff + m * 2048 + k * 1024); } while (0)
#define PG8_LDB(dst, b, h) do { _Pragma("unroll") for (int n = 0; n < 2; ++n) _Pragma("unroll") for (int k = 0; k < 2; ++k) dst[n][k] = *(const LAS bf16x8*)(lds + PG8_SB(b, h) + boff + n * 2048 + k * 1024); } while (0)
#define PG8_MMA(ai, bj, At, Bt) do { __builtin_amdgcn_s_setprio(1); _Pragma("unroll") for (int m = 0; m < 4; ++m) _Pragma("unroll") for (int n = 0; n < 2; ++n) _Pragma("unroll") for (int k = 0; k < 2; ++k) \
        acc[ai][bj][m][n] = __builtin_amdgcn_mfma_f32_16x16x32_bf16(Bt[n][k], At[m][k], acc[ai][bj][m][n], 0, 0, 0); __builtin_amdgcn_s_setprio(0); } while (0)
#define PG8_WAIT_V(n) asm volatile("s_waitcnt vmcnt(" #n ")" ::: "memory")
#define PG8_WAIT_L(n) asm volatile("s_waitcnt lgkmcnt(" #n ")" ::: "memory")
#define PG8_BAR __builtin_amdgcn_s_barrier()
#define PG8_SCHED __builtin_amdgcn_sched_barrier(0)
    Unit cur, nxt; int ui = 0;
    if (!S.next(0, cur)) return;
    f32x4 acc[2][2][4][2];
#pragma unroll
    for (int a = 0; a < 2; ++a)
#pragma unroll
        for (int b = 0; b < 2; ++b)
#pragma unroll
            for (int m = 0; m < 4; ++m)
#pragma unroll
                for (int n = 0; n < 2; ++n) acc[a][b][m][n] = (f32x4){0.f, 0.f, 0.f, 0.f};
    bf16x8 At[4][2], B0[2][2], B1[2][2];
    const char* cA = (const char*)g.A + (size_t)cur.pm * tstep; const char* cB = (const char*)g.Bt + (size_t)cur.pn * tstep;
    S.a_ready(cur);
    PG8_STAGE(PG8_SB(0, 0), cB, voffB); PG8_STAGE(PG8_SA(0, 0), cA, voffA); PG8_STAGE(PG8_SB(0, 1), cB + hstep, voffB); PG8_STAGE(PG8_SA(0, 1), cA + hstep, voffA);
    if (wr == 1) PG8_BAR;
    PG8_WAIT_V(4); PG8_BAR;
    PG8_STAGE(PG8_SB(1, 0), cB + kstep, voffB); PG8_STAGE(PG8_SA(1, 0), cA + kstep, voffA); PG8_STAGE(PG8_SB(1, 1), cB + hstep + kstep, voffB);
    PG8_WAIT_V(6); PG8_BAR;
    for (;;) {
        const bool has_next = S.next(ui + 1, nxt);
        const char* nA = has_next ? (const char*)g.A + (size_t)nxt.pm * tstep : cA; const char* nB = has_next ? (const char*)g.Bt + (size_t)nxt.pn * tstep : cB;
        for (int t = 0; t < nt; t += 2) {
            const bool last = (t == nt - 2);
            const char* a1 = cA + (size_t)(t + 1) * kstep;
            const char* a2 = last ? nA : cA + (size_t)(t + 2) * kstep; const char* b2 = last ? nB : cB + (size_t)(t + 2) * kstep;
            const char* a3 = a2 + kstep; const char* b3 = b2 + kstep;
            if (last && has_next) S.a_ready(nxt);
            PG8_LDB(B0, 0, 0); PG8_SCHED; PG8_LDA(At, 0, 0); PG8_STAGE(PG8_SA(1, 1), a1 + hstep, voffA);
            PG8_WAIT_L(8); PG8_BAR; PG8_WAIT_L(0); PG8_MMA(0, 0, At, B0); PG8_BAR; PG8_SCHED;
            PG8_LDB(B1, 0, 1); PG8_STAGE(PG8_SB(0, 0), b2, voffB);
            PG8_BAR; PG8_WAIT_L(0); PG8_MMA(0, 1, At, B1); PG8_BAR;
            PG8_LDA(At, 0, 1); PG8_STAGE(PG8_SA(0, 0), a2, voffA);
            PG8_BAR; PG8_WAIT_L(0); PG8_MMA(1, 0, At, B0); PG8_BAR; PG8_SCHED;
            PG8_STAGE(PG8_SB(0, 1), b2 + hstep, voffB);
            PG8_WAIT_V(6); PG8_BAR; PG8_MMA(1, 1, At, B1); PG8_BAR;
            PG8_LDB(B0, 1, 0); PG8_SCHED; PG8_LDA(At, 1, 0); PG8_STAGE(PG8_SA(0, 1), a2 + hstep, voffA);
            PG8_WAIT_L(8); PG8_BAR; PG8_WAIT_L(0); PG8_MMA(0, 0, At, B0); PG8_BAR; PG8_SCHED;
            PG8_LDB(B1, 1, 1); PG8_STAGE(PG8_SB(1, 0), b3, voffB);
            PG8_BAR; PG8_WAIT_L(0); PG8_MMA(0, 1, At, B1); PG8_BAR;
            PG8_LDA(At, 1, 1); PG8_STAGE(PG8_SA(1, 0), a3, voffA);
            PG8_BAR; PG8_WAIT_L(0); PG8_MMA(1, 0, At, B0); PG8_BAR; PG8_SCHED;
            PG8_STAGE(PG8_SB(1, 1), b3 + hstep, voffB);
            PG8_WAIT_V(6); PG8_BAR; PG8_MMA(1, 1, At, B1); PG8_BAR;
        }
        E(acc, cur, wr, wc, fr, fq, ui, lds); S.done(cur);
        if (!has_next) break;
#pragma unroll
        for (int a = 0; a < 2; ++a)
#pragma unroll
            for (int b = 0; b < 2; ++b)
#pragma unroll
                for (int m = 0; m < 4; ++m)
#pragma unroll
                    for (int n = 0; n < 2; ++n) acc[a][b][m][n] = (f32x4){0.f, 0.f, 0.f, 0.f};
        cur = nxt; cA = nA; cB = nB; ++ui;
    }
    PG8_WAIT_V(0);
    if (wr == 0) PG8_BAR;
    PG8_BAR;
#undef PG8_SA
#undef PG8_SB
#undef PG8_STAGE
#undef PG8_LDA
#undef PG8_LDB
#undef PG8_MMA
#undef PG8_WAIT_V
#undef PG8_WAIT_L
#undef PG8_BAR
#undef PG8_SCHED
}
}

struct EpiSwiGLU {
    static constexpr bool PERM = true;
    bf16_t* H; const float* ss;
    DI void operator()(const f32x4 (&acc)[2][2][4][2], const pg8::Unit& u, int wr, int wc, int fr, int fq, int ui, LAS unsigned char* lds) const {
        const int row0 = u.pm * 256 + wr * 64 + fr, col0 = u.pn * 128 + wc * 32 + 8 * fq;
#pragma unroll
        for (int ai = 0; ai < 2; ++ai)
#pragma unroll
            for (int m = 0; m < 4; ++m) {
                const float rs = ss ? ((const LAS float*)(lds + 131072))[ui * 256 + wr * 64 + fr + ai * 128 + m * 16] : 1.0f;
                float v[8];
#pragma unroll
                for (int n = 0; n < 2; ++n)
#pragma unroll
                    for (int j = 0; j < 4; ++j) { const float gt = acc[ai][0][m][n][j] * rs, up = acc[ai][1][m][n][j] * rs; v[n * 4 + j] = gt * up * __builtin_amdgcn_rcpf(1.0f + __builtin_amdgcn_exp2f(-1.4426950408889634f * gt)); }
                u32x4 w; w.x = pk2(v[0], v[1]); w.y = pk2(v[2], v[3]); w.z = pk2(v[4], v[5]); w.w = pk2(v[6], v[7]);
                *(u32x4*)(H + (size_t)(row0 + ai * 128 + m * 16) * DFF + col0) = w;
            }
    }
};
template <int MODE> struct EpiResid {
    static constexpr bool PERM = true;
    const float* basef; const bf16_t* baseb; float* outf; bf16_t* hb; float* ss; float scale;
    DI void operator()(const f32x4 (&acc)[2][2][4][2], const pg8::Unit& u, int wr, int wc, int fr, int fq, int ui, LAS unsigned char* lds) const {
        const int row0 = u.pm * 256 + wr * 64 + fr, col0 = u.pn * 256 + wc * 32 + 8 * fq;
#pragma unroll
        for (int ai = 0; ai < 2; ++ai) {
            f32x4 bf0[4][2], bf1[4][2]; u32x4 bw[4][2];
#pragma unroll
            for (int m = 0; m < 4; ++m)
#pragma unroll
                for (int bj = 0; bj < 2; ++bj) { const size_t off = (size_t)(row0 + ai * 128 + m * 16) * DM + col0 + bj * 128;
                    if (MODE == 0) { bf0[m][bj] = *(const f32x4*)(basef + off); bf1[m][bj] = *(const f32x4*)(basef + off + 4); }
                    else bw[m][bj] = *(const u32x4*)(baseb + off); }
            __builtin_amdgcn_sched_barrier(0);
#pragma unroll
            for (int m = 0; m < 4; ++m) { const int row = row0 + ai * 128 + m * 16; const size_t off = (size_t)row * DM + col0; float rsum = 0.f;
#pragma unroll
                for (int bj = 0; bj < 2; ++bj) {
                    f32x4 b0, b1;
                    if (MODE == 0) { b0 = bf0[m][bj]; b1 = bf1[m][bj]; }
                    else { const u32x4 w = bw[m][bj]; b0 = (f32x4){bflo(w.x), bfhi(w.x), bflo(w.y), bfhi(w.y)}; b1 = (f32x4){bflo(w.z), bfhi(w.z), bflo(w.w), bfhi(w.w)}; }
                    const f32x4 v0 = b0 + acc[ai][bj][m][0] * scale, v1 = b1 + acc[ai][bj][m][1] * scale;
                    if (MODE == 2) { *(f32x4*)(outf + off + bj * 128) = v0; *(f32x4*)(outf + off + bj * 128 + 4) = v1; }
                    else { rsum += (v0[0] * v0[0] + v0[1] * v0[1]) + (v0[2] * v0[2] + v0[3] * v0[3]) + (v1[0] * v1[0] + v1[1] * v1[1]) + (v1[2] * v1[2] + v1[3] * v1[3]);
                        u32x4 w; w.x = pk2(v0[0], v0[1]); w.y = pk2(v0[2], v0[3]); w.z = pk2(v1[0], v1[1]); w.w = pk2(v1[2], v1[3]);
                        *(u32x4*)(hb + off + bj * 128) = w; } }
                if (MODE != 2) { rsum += __shfl_xor(rsum, 16); rsum += __shfl_xor(rsum, 32); if (fq == 0) atomicAdd(ss + row, rsum); } }
        }
    }
};
struct EpiProj {
    static constexpr bool PERM = true;
    bf16_t* O; const float* ss; bf16_t* vts; bf16_t* vtw;
    DI void operator()(const f32x4 (&acc)[2][2][4][2], const pg8::Unit& u, int wr, int wc, int fr, int fq, int ui, LAS unsigned char* lds) const {
        const int row0 = u.pm * 256 + wr * 64 + fr, col0 = u.pn * 256 + wc * 32 + 8 * fq;
        const bool tr = (u.pn == 7) || (u.pn == 9);
#pragma unroll
        for (int ai = 0; ai < 2; ++ai)
#pragma unroll
            for (int m = 0; m < 4; ++m) { const int row = row0 + ai * 128 + m * 16; bf16_t* rowp = O + (size_t)row * NPROJ + col0;
                const float rs = ((const LAS float*)(lds + 131072))[ui * 256 + wr * 64 + fr + ai * 128 + m * 16];
#pragma unroll
                for (int bj = 0; bj < 2; ++bj) { const f32x4 v0 = acc[ai][bj][m][0] * rs, v1 = acc[ai][bj][m][1] * rs;
                    u32x4 w; w.x = pk2(v0[0], v0[1]); w.y = pk2(v0[2], v0[3]); w.z = pk2(v1[0], v1[1]); w.w = pk2(v1[2], v1[3]);
                    if (!tr) *(u32x4*)(rowp + bj * 128) = w;
                    else { bf16_t* vt = (u.pn == 7 ? vts : vtw) + ((size_t)((row >> 11) * 2 + bj) * 128 + wc * 32 + 8 * fq) * TT + (row & 2047);
                        vt[0 * TT] = (bf16_t)(w.x & 0xffffu); vt[1 * TT] = (bf16_t)(w.x >> 16); vt[2 * TT] = (bf16_t)(w.y & 0xffffu); vt[3 * TT] = (bf16_t)(w.y >> 16);
                        vt[4 * TT] = (bf16_t)(w.z & 0xffffu); vt[5 * TT] = (bf16_t)(w.z >> 16); vt[6 * TT] = (bf16_t)(w.w & 0xffffu); vt[7 * TT] = (bf16_t)(w.w >> 16); } } }
    }
};
struct EpiGLU {
    static constexpr bool PERM = true;
    const bf16_t* HG; const float* bias; bf16_t* AS;
    DI void operator()(const f32x4 (&acc)[2][2][4][2], const pg8::Unit& u, int wr, int wc, int fr, int fq, int ui, LAS unsigned char* lds) const {
        const int row0 = u.pm * 256 + wr * 64 + fr, col0 = u.pn * 256 + wc * 32 + 8 * fq;
        f32x4 bs[2][2];
#pragma unroll
        for (int bj = 0; bj < 2; ++bj) { bs[bj][0] = *(const f32x4*)(bias + col0 + bj * 128); bs[bj][1] = *(const f32x4*)(bias + col0 + bj * 128 + 4); }
#pragma unroll
        for (int ai = 0; ai < 2; ++ai) {
            u32x4 hw[4][2];
#pragma unroll
            for (int m = 0; m < 4; ++m)
#pragma unroll
                for (int bj = 0; bj < 2; ++bj) hw[m][bj] = *(const u32x4*)(HG + (size_t)(row0 + ai * 128 + m * 16) * 1024 + col0 + bj * 128);
            __builtin_amdgcn_sched_barrier(0);
#pragma unroll
            for (int m = 0; m < 4; ++m) { const int row = row0 + ai * 128 + m * 16;
#pragma unroll
                for (int bj = 0; bj < 2; ++bj) { const int col = col0 + bj * 128; const u32x4 h = hw[m][bj];
                    const f32x4 v0 = acc[ai][bj][m][0] + bs[bj][0], v1 = acc[ai][bj][m][1] + bs[bj][1];
                    u32x4 w;
                    w.x = pk2(bflo(h.x) * sigmoidf_(v0[0]), bfhi(h.x) * sigmoidf_(v0[1]));
                    w.y = pk2(bflo(h.y) * sigmoidf_(v0[2]), bfhi(h.y) * sigmoidf_(v0[3]));
                    w.z = pk2(bflo(h.z) * sigmoidf_(v1[0]), bfhi(h.z) * sigmoidf_(v1[1]));
                    w.w = pk2(bflo(h.w) * sigmoidf_(v1[2]), bfhi(h.w) * sigmoidf_(v1[3]));
                    *(u32x4*)(AS + (size_t)row * DM + 1024 + col) = w; } }
        }
    }
};

DI void tconv(const float* __restrict__ src, int K, int N, int Npad, bf16_t* __restrict__ dst, int mode, float* tile, const float* __restrict__ gk = nullptr) {
    const int tid = threadIdx.x, ntk = K >> 6, ntn = Npad >> 7, ntile = ntk * ntn;
    f32x4 v[4];
    float gv[4];
#define TC_LOAD(tt) do { const int tk_ = (tt) % ntk, tn_ = (tt) / ntk; \
        _Pragma("unroll") for (int e = 0; e < 4; ++e) { const int i = tid + 512 * e, r = i >> 5, n = tn_ * 128 + (i & 31) * 4, nn = n < N ? n : N - 4; \
            v[e] = *(const f32x4*)(src + (size_t)(tk_ * 64 + r) * N + nn); gv[e] = gk ? gk[tk_ * 64 + r] : 1.0f; } } while (0)
    int t = blockIdx.x;
    if (t < ntile) TC_LOAD(t);
    for (; t < ntile; t += gridDim.x) {
#pragma unroll
        for (int e = 0; e < 4; ++e) { const int i = tid + 512 * e, r = i >> 5, c = (i & 31) * 4; const bool ok = (t / ntk) * 128 + c < N;
            const f32x4 x = ok ? v[e] * gv[e] : (f32x4){0.f, 0.f, 0.f, 0.f};
            tile[r * 129 + c] = x[0]; tile[r * 129 + c + 1] = x[1]; tile[r * 129 + c + 2] = x[2]; tile[r * 129 + c + 3] = x[3]; }
        __syncthreads();
        const int tk = t % ntk, tn = t / ntk;
        if (t + (int)gridDim.x < ntile) TC_LOAD(t + (int)gridDim.x);
        { const int nl = tid >> 2, kg = tid & 3, n = tn * 128 + nl;
          float x[16];
#pragma unroll
          for (int j = 0; j < 16; ++j) x[j] = tile[(kg * 16 + j) * 129 + nl];
          const int drow = mode == 0 ? n : (tn * 256 + nl + (mode == 2 ? 128 : 0));
          u32x4 w0, w1; w0.x = pk2(x[0], x[1]); w0.y = pk2(x[2], x[3]); w0.z = pk2(x[4], x[5]); w0.w = pk2(x[6], x[7]);
          w1.x = pk2(x[8], x[9]); w1.y = pk2(x[10], x[11]); w1.z = pk2(x[12], x[13]); w1.w = pk2(x[14], x[15]);
          u32x4* dp = (u32x4*)(dst + (size_t)drow * K + tk * 64 + kg * 16); dp[0] = w0; dp[1] = w1; }
        __syncthreads();
    }
#undef TC_LOAD
}

DI void norm_rows(const float* src, const float* __restrict__ g, bf16_t* dstb, float* dstf) {
    const int wid = threadIdx.x >> 6, lane = threadIdx.x & 63, stride = gridDim.x * 8;
    for (int row = blockIdx.x * 8 + wid; row < MTOK; row += 2 * stride) {
        const int row2 = row + stride; const bool has2 = row2 < MTOK;
        const f32x4* p = (const f32x4*)(src + (size_t)row * DM); const f32x4* p2 = (const f32x4*)(src + (size_t)(has2 ? row2 : row) * DM);
        f32x4 v[8], w[8]; float ss = 0.f, ss2 = 0.f;
#pragma unroll
        for (int i = 0; i < 8; ++i) { v[i] = p[lane + 64 * i]; w[i] = p2[lane + 64 * i]; }
#pragma unroll
        for (int i = 0; i < 8; ++i) { ss += v[i][0] * v[i][0] + v[i][1] * v[i][1] + v[i][2] * v[i][2] + v[i][3] * v[i][3]; ss2 += w[i][0] * w[i][0] + w[i][1] * w[i][1] + w[i][2] * w[i][2] + w[i][3] * w[i][3]; }
#pragma unroll
        for (int o = 32; o >= 1; o >>= 1) { ss += __shfl_xor(ss, o); ss2 += __shfl_xor(ss2, o); }
        const float rstd = 1.0f / sqrtf(ss * (1.0f / DM) + EPSN), rstd2 = 1.0f / sqrtf(ss2 * (1.0f / DM) + EPSN);
#pragma unroll
        for (int i = 0; i < 8; ++i) { const f32x4 gg = ((const f32x4*)g)[lane + 64 * i]; const f32x4 y = v[i] * rstd * gg, y2 = w[i] * rstd2 * gg;
            if (dstb) { u32x2 o; o.x = pk2(y[0], y[1]); o.y = pk2(y[2], y[3]); *(u32x2*)(dstb + (size_t)row * DM + (lane + 64 * i) * 4) = o;
                        if (has2) { u32x2 o2; o2.x = pk2(y2[0], y2[1]); o2.y = pk2(y2[2], y2[3]); *(u32x2*)(dstb + (size_t)row2 * DM + (lane + 64 * i) * 4) = o2; } }
            else { ((f32x4*)(dstf + (size_t)row * DM))[lane + 64 * i] = y; if (has2) ((f32x4*)(dstf + (size_t)row2 * DM))[lane + 64 * i] = y2; } }
    }
}

DI void phase_prep(const Params& P, unsigned char* smem) {
    unsigned char* ws = P.ws; float* tile = (float*)smem; const int tid = threadIdx.x;
    float* sm = (float*)(ws + WS_SMALL);
    if (blockIdx.x < 8) { const int idx = blockIdx.x * 512 + tid, grp = idx >> 6;
        const float step = expf(P.in[18][grp]), lre = P.in[16][idx], lim = P.in[17][idx];
        const float mag = expf(lre * step), ar = mag * cosf(lim * step), ai = mag * sinf(lim * step);
        const float nr = ar - 1.0f, ni = ai, den = lre * lre + lim * lim, fre = (nr * lre + ni * lim) / den, fim = (ni * lre - nr * lim) / den;
        f32x4 brv[4], biv[4];
#pragma unroll
        for (int k = 0; k < 4; ++k) { brv[k] = *(const f32x4*)(P.in[19] + idx * 16 + 4 * k); biv[k] = *(const f32x4*)(P.in[20] + idx * 16 + 4 * k); }
        bf16_t* tb = (bf16_t*)(sm + SM_BB); const int p = idx & 63;
        unsigned hre[16], lre_[16], him[16], lim_[16];
#pragma unroll
        for (int h = 0; h < 16; ++h) { const float br = brv[h >> 2][h & 3], bi = biv[h >> 2][h & 3];
            const float vre = fre * br - fim * bi, vim = fre * bi + fim * br;
            hre[h] = pk2(vre, 0.f) & 0xffffu; lre_[h] = pk2(vre - bf2f(hre[h]), 0.f) & 0xffffu;
            him[h] = pk2(vim, 0.f) & 0xffffu; lim_[h] = pk2(vim - bf2f(him[h]), 0.f) & 0xffffu; }
        { u32x4* d = (u32x4*)(tb + (grp * 128 + p) * 32);
          d[0] = (u32x4){hre[0] | (hre[1] << 16), hre[2] | (hre[3] << 16), hre[4] | (hre[5] << 16), hre[6] | (hre[7] << 16)};
          d[1] = (u32x4){hre[8] | (hre[9] << 16), hre[10] | (hre[11] << 16), hre[12] | (hre[13] << 16), hre[14] | (hre[15] << 16)};
          d[2] = (u32x4){lre_[0] | (lre_[1] << 16), lre_[2] | (lre_[3] << 16), lre_[4] | (lre_[5] << 16), lre_[6] | (lre_[7] << 16)};
          d[3] = (u32x4){lre_[8] | (lre_[9] << 16), lre_[10] | (lre_[11] << 16), lre_[12] | (lre_[13] << 16), lre_[14] | (lre_[15] << 16)};
          u32x4* e = (u32x4*)(tb + (grp * 128 + 64 + p) * 32);
          e[0] = (u32x4){him[0] | (him[1] << 16), him[2] | (him[3] << 16), him[4] | (him[5] << 16), him[6] | (him[7] << 16)};
          e[1] = (u32x4){him[8] | (him[9] << 16), him[10] | (him[11] << 16), him[12] | (him[13] << 16), him[14] | (him[15] << 16)};
          e[2] = (u32x4){lim_[0] | (lim_[1] << 16), lim_[2] | (lim_[3] << 16), lim_[4] | (lim_[5] << 16), lim_[6] | (lim_[7] << 16)};
          e[3] = (u32x4){lim_[8] | (lim_[9] << 16), lim_[10] | (lim_[11] << 16), lim_[12] | (lim_[13] << 16), lim_[14] | (lim_[15] << 16)}; }
        float pr = ar, pi = ai;
        for (int s = 0; s < 6; ++s) { const float nr2 = pr * pr - pi * pi, ni2 = 2.0f * pr * pi; pr = nr2; pi = ni2; }
        sm[SM_AB + idx * 4 + 0] = ar; sm[SM_AB + idx * 4 + 1] = ai; sm[SM_AB + idx * 4 + 2] = pr; sm[SM_AB + idx * 4 + 3] = pi; }
    { const int which = blockIdx.x >> 7, chunk = blockIdx.x & 127; const float* pe = P.in[which ? 11 : 7]; const float* w1 = P.in[which ? 12 : 8];
      if (blockIdx.x < 256) {
        const int n = tid & 127, sub = tid >> 7; float s = 0.f;
#pragma unroll
        for (int j = 0; j < 8; ++j) { const int k = chunk * 32 + sub * 8 + j; s += pe[k] * w1[(size_t)k * 128 + n]; }
        tile[tid] = s; __syncthreads();
        if (tid < 128) sm[SM_CBP + (which * 128 + chunk) * 128 + tid] = (tile[tid] + tile[tid + 128]) + (tile[tid + 256] + tile[tid + 384]);
        __syncthreads(); } }
    if (blockIdx.x == 10 && tid == 0) { ((int*)(sm + SM_CTR))[0] = 0; ((int*)(sm + SM_CTR))[1] = 0; }
    for (int i = blockIdx.x * 512 + tid; i < 32768; i += gridDim.x * 512) sm[SM_SS + i] = 0.f;
    { u32x4* z = (u32x4*)(ws + WS_KCB); const u32x4 zero = {0u, 0u, 0u, 0u};
      for (int i = blockIdx.x * 512 + tid; i < 65536; i += gridDim.x * 512) z[i] = zero; }
    norm_rows(P.in[0], P.in[1], (bf16_t*)(ws + WS_XN), nullptr);
    tconv(P.in[2], DM, DFF, DFF, (bf16_t*)(ws + WS_W13A), 1, tile);
    tconv(P.in[3], DM, DFF, DFF, (bf16_t*)(ws + WS_W13A), 2, tile);
    tconv(P.in[4], DFF, DM, DM, (bf16_t*)(ws + WS_W2A), 0, tile);
    tconv(P.in[6], DM, 3608, NPROJ, (bf16_t*)(ws + WS_WIN), 0, tile, P.in[5]);
    tconv(P.in[8], 4096, 128, 128, (bf16_t*)(ws + WS_CW1K), 0, tile);
    tconv(P.in[12], 4096, 128, 128, (bf16_t*)(ws + WS_CW1V), 0, tile);
    tconv(P.in[10], 128, 128, 128, (bf16_t*)(ws + WS_CW2K), 0, tile);
    tconv(P.in[14], 128, 128, 128, (bf16_t*)(ws + WS_CW2V), 0, tile);
    tconv(P.in[24], 1024, 1024, 1024, (bf16_t*)(ws + WS_GLUW), 0, tile);
    tconv(P.in[26], DM, DM, DM, (bf16_t*)(ws + WS_WOUT), 0, tile);
    tconv(P.in[28], DM, DFF, DFF, (bf16_t*)(ws + WS_W13B), 1, tile, P.in[27]);
    tconv(P.in[29], DM, DFF, DFF, (bf16_t*)(ws + WS_W13B), 2, tile, P.in[27]);
    tconv(P.in[30], DFF, DM, DM, (bf16_t*)(ws + WS_W2B), 0, tile);
}

DI void compress_item(const Params& P, int item, unsigned char* smem) {
    unsigned char* ws = P.ws; const int tid = threadIdx.x, wid = tid >> 6, lane = tid & 63, r = lane & 15, q = lane >> 4;
    const int which = item / 127, rt = item % 127;
    const bf16_t* proj = (const bf16_t*)(ws + WS_PROJ);
    const bf16_t* w1t = (const bf16_t*)(ws + (which ? WS_CW1V : WS_CW1K));
    const bf16_t* w2t = (const bf16_t*)(ws + (which ? WS_CW2V : WS_CW2K));
    const float* cb1 = (const float*)(ws + WS_SMALL) + SM_CB1 + which * 128;
    float* part = (float*)smem;
    bf16_t* hid = (bf16_t*)(smem + 65536);
    const int grow = rt * 16 + r, bg = grow / 127, c = grow % 127, b = bg >> 1, g = bg & 1;
    const bf16_t* arow = proj + (size_t)(b * TT + 16 * c) * NPROJ + (which ? C_VC : C_KC) + g * 128;
    f32x4 acc[8];
#pragma unroll
    for (int ct = 0; ct < 8; ++ct) acc[ct] = (f32x4){0.f, 0.f, 0.f, 0.f};
    bf16x8 fa[2], fb[2][8];
#define CP_LOAD(buf, s_) do { const int kabs_ = 512 * wid + 32 * (s_) + 8 * q; fa[buf] = *(const bf16x8*)(arow + (size_t)(kabs_ >> 7) * NPROJ + (kabs_ & 127)); \
        _Pragma("unroll") for (int ct = 0; ct < 8; ++ct) fb[buf][ct] = *(const bf16x8*)(w1t + (size_t)(ct * 16 + r) * 4096 + kabs_); } while (0)
    CP_LOAD(0, 0);
#pragma unroll
    for (int s = 0; s < 16; ++s) {
        if (s + 1 < 16) CP_LOAD((s + 1) & 1, s + 1);
        __builtin_amdgcn_sched_barrier(0);
#pragma unroll
        for (int ct = 0; ct < 8; ++ct) acc[ct] = __builtin_amdgcn_mfma_f32_16x16x32_bf16(fa[s & 1], fb[s & 1][ct], acc[ct], 0, 0, 0);
        __builtin_amdgcn_sched_barrier(0);
    }
#undef CP_LOAD
#pragma unroll
    for (int ct = 0; ct < 8; ++ct)
#pragma unroll
        for (int j = 0; j < 4; ++j) part[(wid * 16 + 4 * q + j) * 128 + ct * 16 + r] = acc[ct][j];
    __syncthreads();
    { const int row = tid >> 5, c4 = (tid & 31) * 4; f32x4 s = *(const f32x4*)(cb1 + c4);
#pragma unroll
      for (int w = 0; w < 8; ++w) s += *(const f32x4*)(part + (w * 16 + row) * 128 + c4);
      u32x2 o; o.x = pk2(gelu_tanh(s[0]), gelu_tanh(s[1])); o.y = pk2(gelu_tanh(s[2]), gelu_tanh(s[3]));
      *(u32x2*)(hid + row * 136 + c4) = o; }
    __syncthreads();
    { f32x4 a2 = {0.f, 0.f, 0.f, 0.f};
#pragma unroll
      for (int s = 0; s < 4; ++s) { const bf16x8 a = *(const bf16x8*)(hid + r * 136 + 32 * s + 8 * q);
          const bf16x8 bb = *(const bf16x8*)(w2t + (size_t)(16 * wid + r) * 128 + 32 * s + 8 * q);
          a2 = __builtin_amdgcn_mfma_f32_16x16x32_bf16(a, bb, a2, 0, 0, 0); }
      bf16_t* kcb = (bf16_t*)(ws + WS_KCB); bf16_t* vcbt = (bf16_t*)(ws + WS_VCBT);
#pragma unroll
      for (int j = 0; j < 4; ++j) { const int gr = rt * 16 + 4 * q + j, bg2 = gr / 127, c2 = gr % 127, col = 16 * wid + r;
          const bf16_t v = (bf16_t)(pk2(a2[j], 0.f) & 0xffffu);
          if (which == 0) kcb[(size_t)(bg2 * 128 + c2) * 128 + col] = v; else vcbt[(size_t)(bg2 * 128 + col) * 128 + c2] = v; } }
    __syncthreads();
}

DI void s5_bu16(const bf16x8 ub, const bf16x8 (&af)[8], float* buf, int r, int q) {
#pragma unroll
    for (int pt = 0; pt < 8; ++pt) { f32x4 d = {0.f, 0.f, 0.f, 0.f}; d = __builtin_amdgcn_mfma_f32_16x16x32_bf16(af[pt], ub, d, 0, 0, 0);
#pragma unroll
        for (int j = 0; j < 4; ++j) buf[(16 * pt + 4 * q + j) * 17 + r] = d[j]; }
}
DI void s5_pass1_item(const Params& P, int bitem, unsigned char* smem) {
    int tid_ = threadIdx.x; asm volatile("" : "+v"(tid_));
    unsigned char* ws = P.ws; const int tid = tid_, wid = tid >> 6, lane = tid & 63, r = lane & 15, q = lane >> 4;
    const int item = bitem * 8 + wid, ch = item & 31, grp = (item >> 5) & 63, b = item >> 11;
    const bf16_t* proj = (const bf16_t*)(ws + WS_PROJ); const float* sm = (const float*)(ws + WS_SMALL);
    float* buf = (float*)smem + wid * 2176;
    const bf16_t* tb = (const bf16_t*)(sm + SM_BB);
    bf16x8 af[8];
#pragma unroll
    for (int pt = 0; pt < 8; ++pt) af[pt] = *(const bf16x8*)(tb + (grp * 128 + 16 * pt + r) * 32 + 8 * q);
    const f32x4 ab = *(const f32x4*)(sm + SM_AB + (grp * 64 + lane) * 4);
    const bf16_t* ubase = proj + (size_t)(b * TT + ch * 64) * NPROJ + C_SSM + grp * 16;
    float xr = 0.f, xi = 0.f;
    bf16x8 ubs[4];
#pragma unroll
    for (int sub = 0; sub < 4; ++sub) ubs[sub] = *(const bf16x8*)(ubase + (size_t)(sub * 16 + r) * NPROJ + 8 * (q & 1));
#pragma unroll
    for (int sub = 0; sub < 4; ++sub) {
        s5_bu16(ubs[sub], af, buf, r, q);
        asm volatile("s_waitcnt lgkmcnt(0)" ::: "memory");
#pragma unroll
        for (int tt = 0; tt < 16; ++tt) { const float bur = buf[lane * 17 + tt], bui = buf[(64 + lane) * 17 + tt];
            const float nxr = ab[0] * xr - ab[1] * xi + bur, nxi = ab[0] * xi + ab[1] * xr + bui; xr = nxr; xi = nxi; }
        asm volatile("s_waitcnt lgkmcnt(0)" ::: "memory");
    }
    f32x2_t e = {xr, xi};
    *(f32x2_t*)(ws + WS_S5END + ((size_t)((b * 64 + grp) * 32 + ch) * 64 + lane) * 8) = e;
}

DI void vtrans_item(const Params& P, int item, unsigned char* smem) {
    unsigned char* ws = P.ws; const int tid = threadIdx.x;
    const int tokblk = item >> 3, cseg = item & 7, tok0 = tokblk * 64, b = tok0 >> 11, t0 = tok0 & 2047;
    const int col = (cseg < 4 ? C_VS + cseg * 64 : C_VW + (cseg - 4) * 64), g = (cseg & 3) >> 1, d0 = (cseg & 1) * 64;
    const bf16_t* proj = (const bf16_t*)(ws + WS_PROJ);
    bf16_t* dst = (bf16_t*)(ws + (cseg < 4 ? WS_VTS : WS_VTW)) + (size_t)((b * 2 + g) * 128 + d0) * TT + t0;
    bf16_t* tl = (bf16_t*)smem;
    { const int r = tid >> 3, sg = tid & 7; *(u32x4*)(tl + r * 72 + sg * 8) = *(const u32x4*)(proj + (size_t)(tok0 + r) * NPROJ + col + sg * 8); }
    __syncthreads();
    { const int d = tid >> 3, tsg = tid & 7; unsigned v[8];
#pragma unroll
      for (int j = 0; j < 8; ++j) v[j] = tl[(tsg * 8 + j) * 72 + d];
      u32x4 w; w.x = v[0] | (v[1] << 16); w.y = v[2] | (v[3] << 16); w.z = v[4] | (v[5] << 16); w.w = v[6] | (v[7] << 16);
      *(u32x4*)(dst + (size_t)d * TT + tsg * 8) = w; }
    __syncthreads();
}

DI void s5_pass3_item(const Params& P, int bitem, unsigned char* smem) {
    int tid_ = threadIdx.x; asm volatile("" : "+v"(tid_));
    unsigned char* ws = P.ws; const int tid = tid_, wid = tid >> 6, lane = tid & 63, r = lane & 15, q = lane >> 4;
    const int item = bitem * 8 + wid, ch = item & 31, grp = (item >> 5) & 63, b = item >> 11;
    const bf16_t* proj = (const bf16_t*)(ws + WS_PROJ); const float* sm = (const float*)(ws + WS_SMALL);
    float* xs = (float*)smem + wid * 2176;
    bf16_t* HG = (bf16_t*)(ws + WS_HG);
    const bf16_t* tb = (const bf16_t*)(sm + SM_BB);
    bf16x8 af[8];
#pragma unroll
    for (int pt = 0; pt < 8; ++pt) af[pt] = *(const bf16x8*)(tb + (grp * 128 + 16 * pt + r) * 32 + 8 * q);
    const f32x4 ab = *(const f32x4*)(sm + SM_AB + (grp * 64 + lane) * 4);
    float cB[32];
    { const float* cre = P.in[21] + (size_t)(grp * 16 + r) * 64; const float* cim = P.in[22] + (size_t)(grp * 16 + r) * 64;
#pragma unroll
      for (int i = 0; i < 32; ++i) { const int k = 4 * i + q; cB[i] = (i < 16) ? cre[k] : -cim[k - 64]; } }
    const float dsk = P.in[23][grp * 16 + r];
    const bf16_t* ubase = proj + (size_t)(b * TT + ch * 64) * NPROJ + C_SSM + grp * 16;
    bf16x8 ubs[4]; unsigned short uvs[4][4];
#pragma unroll
    for (int sub = 0; sub < 4; ++sub) { ubs[sub] = *(const bf16x8*)(ubase + (size_t)(sub * 16 + r) * NPROJ + 8 * (q & 1));
#pragma unroll
        for (int j = 0; j < 4; ++j) uvs[sub][j] = ubase[(size_t)(sub * 16 + 4 * q + j) * NPROJ + r]; }
    float xr = 0.f, xi = 0.f;
    {
      const f32x2_t* e = (const f32x2_t*)(ws + WS_S5END) + (size_t)((b * 64 + grp) * 32) * 64 + lane;
      f32x2_t ev[31];
#pragma unroll
      for (int j = 0; j < 31; ++j) ev[j] = e[(j < ch ? j : 0) * 64];
#pragma unroll
      for (int j = 0; j < 31; ++j) { const float ex = j < ch ? ev[j][0] : 0.f, ey = j < ch ? ev[j][1] : 0.f;
          const float ncr = ab[2] * xr - ab[3] * xi + ex, nci = ab[2] * xi + ab[3] * xr + ey; xr = j < ch ? ncr : xr; xi = j < ch ? nci : xi; } }
#pragma unroll
    for (int sub = 0; sub < 4; ++sub) {
        s5_bu16(ubs[sub], af, xs, r, q);
        float uv[4];
#pragma unroll
        for (int j = 0; j < 4; ++j) uv[j] = bf2f(uvs[sub][j]);
        asm volatile("s_waitcnt lgkmcnt(0)" ::: "memory");
#pragma unroll
        for (int tt = 0; tt < 16; ++tt) { const float bur = xs[lane * 17 + tt], bui = xs[(64 + lane) * 17 + tt];
            const float nxr = ab[0] * xr - ab[1] * xi + bur, nxi = ab[0] * xi + ab[1] * xr + bui; xr = nxr; xi = nxi;
            xs[lane * 17 + tt] = xr; xs[(64 + lane) * 17 + tt] = xi; }
        asm volatile("s_waitcnt lgkmcnt(0)" ::: "memory");
        f32x4 ya[4];
#pragma unroll
        for (int j = 0; j < 4; ++j) ya[j] = (f32x4){0.f, 0.f, 0.f, 0.f};
#pragma unroll
        for (int i = 0; i < 32; ++i) { const float a = xs[(4 * i + q) * 17 + r]; ya[i & 3] = __builtin_amdgcn_mfma_f32_16x16x4f32(a, cB[i], ya[i & 3], 0, 0, 0); }
        const f32x4 y = (ya[0] + ya[1]) + (ya[2] + ya[3]);
#pragma unroll
        for (int j = 0; j < 4; ++j) { const int tl = sub * 16 + 4 * q + j; const float v = y[j] + dsk * uv[j];
            HG[(size_t)(b * TT + ch * 64 + tl) * 1024 + grp * 16 + r] = (bf16_t)(pk2(gelu_tanh(v), 0.f) & 0xffffu); }
        asm volatile("s_waitcnt lgkmcnt(0)" ::: "memory");
    }
}

DI float xor32_max(float x) { const auto r_ = __builtin_amdgcn_permlane32_swap(__float_as_uint(x), __float_as_uint(x), false, false); return fmaxf(__uint_as_float(r_[0]), __uint_as_float(r_[1])); }
DI float xor32_sum(float x) { const auto r_ = __builtin_amdgcn_permlane32_swap(__float_as_uint(x), __float_as_uint(x), false, false); return __uint_as_float(r_[0]) + __uint_as_float(r_[1]); }
#define MFMA32(a, b, c) __builtin_amdgcn_mfma_f32_32x32x16_bf16((a), (b), (c), 0, 0, 0)
DI bf16x8 ld2x4(const bf16_t* p0) { const s16x4 a = *(const s16x4*)p0, b = *(const s16x4*)(p0 + 8); return __builtin_shufflevector(a, b, 0, 1, 2, 3, 4, 5, 6, 7); }
DI bf16x8 packp(const f32x16& x, int s) { u32x4 p; p.x = pk2(x[8 * s], x[8 * s + 1]); p.y = pk2(x[8 * s + 2], x[8 * s + 3]); p.z = pk2(x[8 * s + 4], x[8 * s + 5]); p.w = pk2(x[8 * s + 6], x[8 * s + 7]); return __builtin_bit_cast(bf16x8, p); }
DI int crow(int i, int hh) { return (i & 3) + 8 * (i >> 2) + 4 * hh; }

constexpr int A_STG = 0;
constexpr int A_BUF = 34816, A_VOFF = 17408;
constexpr int A_IMPM = 69632, A_IMPS = A_IMPM + 33792, A_IMPV = A_IMPS + 33792, A_LUT = A_IMPV + 8192, A_SELM = A_LUT + 4096;
DI bf16x8 lds2x4(const unsigned char* p) { const s16x4 a = *(const s16x4*)p, b = *(const s16x4*)(p + 16); return __builtin_shufflevector(a, b, 0, 1, 2, 3, 4, 5, 6, 7); }

constexpr float QK_C1 = 0.08838834764831845f * 1.4426950408889634f;
template <int MODE, bool FAR>
DI void attn_tile(const unsigned char* kl  , const unsigned char* vl  ,
                  int k0, int tq, int r, int hh, bool bit, const bf16x8 (&qf)[8], const float* lutH, f32x16 (&o)[4], float& m, float& l) {
    f32x16 s;
#pragma unroll
    for (int i = 0; i < 16; ++i) s[i] = 0.f;
    const unsigned char* kp = kl + r * 272 + 16 * hh;
#pragma unroll
    for (int kk = 0; kk < 8; ++kk) { const bf16x8 a = *(const bf16x8*)(kp + 32 * kk); s = MFMA32(a, qf[kk], s); }
    float tmax = NEGF;
    if (FAR) {
        const float b31 = lutH[255];
#pragma unroll
        for (int i = 0; i < 16; ++i) { const float v = s[i] * QK_C1 + b31; s[i] = (MODE == 0 && !bit) ? NEGF : v; tmax = fmaxf(tmax, s[i]); }
    } else {
#pragma unroll
        for (int i = 0; i < 16; ++i) { const int dist = tq - (k0 + crow(i, hh));
            const bool valid = MODE == 0 ? (bit && dist >= 0) : (dist >= 0 && dist < 512);
            const int di = dist < 0 ? 0 : (dist > 255 ? 255 : dist);
            const float v = s[i] * QK_C1 + lutH[di];
            s[i] = valid ? v : NEGF; tmax = fmaxf(tmax, s[i]); }
    }
    tmax = xor32_max(tmax);
    const float mnew = fmaxf(m, tmax);
    if (__ballot(mnew != m) != 0ull) {
        const float alpha = __builtin_amdgcn_exp2f(m - mnew);
        l *= alpha; m = mnew;
#pragma unroll
        for (int dt = 0; dt < 4; ++dt)
#pragma unroll
            for (int i = 0; i < 16; ++i) o[dt][i] *= alpha;
    }
    float psum = 0.f;
    if (FAR) {
#pragma unroll
        for (int i = 0; i < 16; ++i) { const float p = __builtin_amdgcn_exp2f(s[i] - mnew); s[i] = p; psum += p; }
    } else {
#pragma unroll
        for (int i = 0; i < 16; ++i) { const float p = (s[i] > -1e29f) ? __builtin_amdgcn_exp2f(s[i] - mnew) : 0.f; s[i] = p; psum += p; }
    }
    psum = xor32_sum(psum);
    l += psum;
    const unsigned char* vp = vl + r * 136 + 8 * hh;
#pragma unroll
    for (int s2 = 0; s2 < 2; ++s2) { const bf16x8 pb = packp(s, s2);
#pragma unroll
        for (int dt = 0; dt < 4; ++dt) { const bf16x8 a = lds2x4(vp + dt * (32 * 136) + 32 * s2); o[dt] = MFMA32(a, pb, o[dt]); } }
}

template <int MODE>
DI void attn_tile64_far(const unsigned char* bp  , int r, int hh, bool bit, const bf16x8 (&qf)[8], const float* lutH, f32x16 (&o)[4], float& m, float& l) {
    f32x16 s0, s1;
#pragma unroll
    for (int i = 0; i < 16; ++i) { s0[i] = 0.f; s1[i] = 0.f; }
    const unsigned char* kp = bp + r * 272 + 16 * hh;
#pragma unroll
    for (int kk = 0; kk < 8; ++kk) { const bf16x8 a0 = *(const bf16x8*)(kp + 32 * kk), a1 = *(const bf16x8*)(kp + 32 * 272 + 32 * kk); s0 = MFMA32(a0, qf[kk], s0); s1 = MFMA32(a1, qf[kk], s1); }
    const float b31 = lutH[255];
    float tmax = NEGF;
#pragma unroll
    for (int i = 0; i < 16; ++i) { const float v0 = s0[i] * QK_C1 + b31, v1 = s1[i] * QK_C1 + b31;
        s0[i] = (MODE == 0 && !bit) ? NEGF : v0; s1[i] = (MODE == 0 && !bit) ? NEGF : v1; tmax = fmaxf(tmax, fmaxf(s0[i], s1[i])); }
    tmax = xor32_max(tmax);
    const float mnew = fmaxf(m, tmax);
    if (__ballot(mnew != m) != 0ull) {
        const float alpha = __builtin_amdgcn_exp2f(m - mnew);
        l *= alpha; m = mnew;
#pragma unroll
        for (int dt = 0; dt < 4; ++dt)
#pragma unroll
            for (int i = 0; i < 16; ++i) o[dt][i] *= alpha;
    }
    float psum = 0.f;
#pragma unroll
    for (int i = 0; i < 16; ++i) { const float p0 = __builtin_amdgcn_exp2f(s0[i] - mnew), p1 = __builtin_amdgcn_exp2f(s1[i] - mnew); s0[i] = p0; s1[i] = p1; psum += p0 + p1; }
    l += xor32_sum(psum);
    const unsigned char* vp = bp + A_VOFF + r * 136 + 8 * hh;
#pragma unroll
    for (int s2 = 0; s2 < 2; ++s2) { const bf16x8 pb0 = packp(s0, s2), pb1 = packp(s1, s2);
#pragma unroll
        for (int dt = 0; dt < 4; ++dt) { const bf16x8 a0 = lds2x4(vp + dt * (32 * 136) + 32 * s2), a1 = lds2x4(vp + dt * (32 * 136) + 64 + 32 * s2);
            o[dt] = MFMA32(a0, pb0, o[dt]); o[dt] = MFMA32(a1, pb1, o[dt]); } }
}

template <int MODE>
DI void attn_branch(unsigned char* smem, const bf16_t* kb  , const bf16_t* vt  , unsigned need, unsigned mymask,
                    int t0w, int tq, int r, int hh, const bf16x8 (&qf)[8], const float* lutH, f32x16 (&o)[4], float& m, float& l) {
    int tid = threadIdx.x; asm volatile("" : "+v"(tid));
    if (need == 0u) return;
    u32x4 kreg[2], vreg[2];
    const int krow0 = tid >> 4, kcc = tid & 15, vd0 = tid >> 3, vcc = tid & 7;
#define AB_LOAD(j) do { _Pragma("unroll") for (int e = 0; e < 2; ++e) { \
        kreg[e] = *(const u32x4*)(kb + (size_t)(64 * (j) + krow0 + 32 * e) * NPROJ + kcc * 8); \
        vreg[e] = *(const u32x4*)(vt + (size_t)(vd0 + 64 * e) * TT + 64 * (j) + vcc * 8); } } while (0)
#define AB_STORE(buf) do { unsigned char* bp_ = smem + A_STG + (buf) * A_BUF; _Pragma("unroll") for (int e = 0; e < 2; ++e) { \
        *(u32x4*)(bp_ + (krow0 + 32 * e) * 272 + kcc * 16) = kreg[e]; \
        unsigned char* vp_ = bp_ + A_VOFF + (vd0 + 64 * e) * 136 + vcc * 16; \
        *(u32x2*)vp_ = (u32x2){vreg[e].x, vreg[e].y}; *(u32x2*)(vp_ + 8) = (u32x2){vreg[e].z, vreg[e].w}; } } while (0)
    int j = __builtin_ctz(need); need &= need - 1u;
    AB_LOAD(j); AB_STORE(0);
    __syncthreads();
    int n = 0;
    for (;;) {
        const bool has_next = need != 0u;
        int jn = 0;
        if (has_next) { jn = __builtin_ctz(need); need &= need - 1u; AB_LOAD(jn); }
        const unsigned char* bp = smem + A_STG + (n & 1) * A_BUF;
        const bool bit = MODE == 0 ? ((mymask >> j) & 1u) : true;
        const bool any = MODE == 0 ? (__ballot(bit) != 0ull) : true;
        const bool far64 = any && (64 * j + 63 + 128 <= t0w) && (MODE == 0 || 64 * j >= t0w + 31 - 511);
        if (far64) attn_tile64_far<MODE>(bp, r, hh, bit, qf, lutH, o, m, l);
        else {
#pragma unroll 1
        for (int half = 0; half < 2; ++half) { const int k0 = 64 * j + 32 * half;
            bool act = any && (k0 <= t0w + 31);
            if (MODE == 1) act = act && (k0 + 31 + 511 >= t0w);
            const bool far = (k0 + 31 + 128 <= t0w) && (MODE == 0 || k0 >= t0w + 31 - 511);
            if (act) { if (far) attn_tile<MODE, true>(bp + half * (32 * 272), bp + A_VOFF + half * 64, k0, tq, r, hh, bit, qf, lutH, o, m, l);
                       else attn_tile<MODE, false>(bp + half * (32 * 272), bp + A_VOFF + half * 64, k0, tq, r, hh, bit, qf, lutH, o, m, l); } }
        }
        if (has_next) AB_STORE((n + 1) & 1);
        __syncthreads();
        if (!has_next) break;
        j = jn; ++n;
    }
#undef AB_LOAD
#undef AB_STORE
}

DI void attn_item(const Params& P, int item, unsigned char* smem) {
    int tid_ = threadIdx.x; asm volatile("" : "+v"(tid_));
    unsigned char* ws = P.ws; const int tid = tid_, wid = tid >> 6, lane = tid & 63, r = lane & 31, hh = lane >> 5;
    const int bg = item & 15, qt = 31 - (item >> 4), b = bg >> 1, g = bg & 1, t0 = qt * 64;
    const int hg = wid >> 1, t0w = t0 + 32 * (wid & 1), tq = t0w + r, head = g * 4 + hg, qloc = 32 * (wid & 1) + r;
    const bf16_t* proj = (const bf16_t*)(ws + WS_PROJ);
    float* outs = (float*)(ws + WS_OUTS) + ((size_t)blockIdx.x * 8 + wid) * 4096;
    float* impM = (float*)(smem + A_IMPM); float* impS = (float*)(smem + A_IMPS); float* impv = (float*)(smem + A_IMPV);
    float* lut = (float*)(smem + A_LUT); unsigned* selm = (unsigned*)(smem + A_SELM);
    for (int i = tid; i < 1024; i += 512) { const int h4 = i >> 8, n = i & 255; int bk;
        if (n < 16) bk = n; else { bk = 16 + (int)(logf((float)n / 16.0f) / 2.0794415416798357f * 16.0f); bk = bk > 31 ? 31 : bk; }
        lut[i] = P.in[15][bk * 8 + g * 4 + h4] * 1.4426950408889634f; }
    { const bf16_t* kcb = (const bf16_t*)(ws + WS_KCB) + (size_t)bg * 16384; const bf16_t* vcbt = (const bf16_t*)(ws + WS_VCBT) + (size_t)bg * 16384;
#pragma unroll
      for (int e = 0; e < 4; ++e) { const int id = tid + 512 * e, row = id >> 4, cc = id & 15;
          *(u32x4*)(smem + A_STG + row * 272 + cc * 16) = *(const u32x4*)(kcb + row * 128 + cc * 8);
          *(u32x4*)(smem + A_STG + A_BUF + row * 272 + cc * 16) = *(const u32x4*)(vcbt + row * 128 + cc * 8); } }
    bf16x8 qf[8];
    { const bf16_t* qrow = proj + (size_t)(b * TT + tq) * NPROJ + head * 128 + 8 * hh;
#pragma unroll
      for (int kk = 0; kk < 8; ++kk) qf[kk] = *(const bf16x8*)(qrow + 16 * kk); }
    __syncthreads();
    const float* lutH = lut + hg * 256;
    f32x16 oc[4];
    {
        const unsigned char* kl = smem + A_STG + r * 272 + 16 * hh;
        const unsigned char* vl = smem + A_STG + A_BUF + r * 272 + 8 * hh;
        float mx = NEGF, sum = 0.f;
#pragma unroll 1
        for (int kt = 0; kt < 4; ++kt) {
            f32x16 sc;
#pragma unroll
            for (int i = 0; i < 16; ++i) sc[i] = 0.f;
#pragma unroll
            for (int kk = 0; kk < 8; ++kk) { const bf16x8 a = *(const bf16x8*)(kl + kt * (32 * 272) + 32 * kk); sc = MFMA32(a, qf[kk], sc); }
            float tmax = NEGF;
#pragma unroll
            for (int i = 0; i < 16; ++i) { const int c = 32 * kt + crow(i, hh), dist = tq - (16 * c + 31);
                const int di = dist < 0 ? 0 : (dist > 255 ? 255 : dist);
                const float v = sc[i] * QK_C1 + lutH[di];
                sc[i] = (dist >= 0 && c < 127) ? v : NEGF; tmax = fmaxf(tmax, sc[i]); }
            tmax = xor32_max(tmax);
            const float mnew = fmaxf(mx, tmax); float ps = 0.f;
#pragma unroll
            for (int i = 0; i < 16; ++i) ps += (sc[i] > -1e29f) ? __builtin_amdgcn_exp2f(sc[i] - mnew) : 0.f;
            ps = xor32_sum(ps);
            sum = sum * __builtin_amdgcn_exp2f(mx - mnew) + ps; mx = mnew;
        }
        const float inv = 1.0f / fmaxf(sum, 1e-30f);
#pragma unroll
        for (int dt = 0; dt < 4; ++dt)
#pragma unroll
            for (int i = 0; i < 16; ++i) oc[dt][i] = 0.f;
#pragma unroll 1
        for (int kt = 0; kt < 4; ++kt) {
            f32x16 sc;
#pragma unroll
            for (int i = 0; i < 16; ++i) sc[i] = 0.f;
#pragma unroll
            for (int kk = 0; kk < 8; ++kk) { const bf16x8 a = *(const bf16x8*)(kl + kt * (32 * 272) + 32 * kk); sc = MFMA32(a, qf[kk], sc); }
#pragma unroll
            for (int i = 0; i < 16; ++i) { const int c = 32 * kt + crow(i, hh), dist = tq - (16 * c + 31);
                const int di = dist < 0 ? 0 : (dist > 255 ? 255 : dist);
                const float v = sc[i] * QK_C1 + lutH[di];
                sc[i] = (dist >= 0 && c < 127) ? __builtin_amdgcn_exp2f(v - mx) * inv : 0.f; }
#pragma unroll
            for (int gi = 0; gi < 4; ++gi) { const int jb = 8 * kt + 2 * gi + hh; const float p3 = 0.5f * sc[4 * gi + 3];
                impM[(hg * 64 + qloc) * 33 + jb] = sc[4 * gi] + sc[4 * gi + 1] + sc[4 * gi + 2] + p3;
                impS[(hg * 64 + qloc) * 33 + jb] = p3; }
#pragma unroll
            for (int s2 = 0; s2 < 2; ++s2) { const bf16x8 pb = packp(sc, s2);
#pragma unroll
                for (int dt = 0; dt < 4; ++dt) { const bf16x8 a = lds2x4(vl + dt * (32 * 272) + 64 * kt + 32 * s2); oc[dt] = MFMA32(a, pb, oc[dt]); } }
        }
    }
    __syncthreads();
#pragma unroll 1
    for (int e = 0; e < 4; ++e) { const int idx = tid + 512 * e, qq = idx >> 5, j = idx & 31, t = t0 + qq, cur = t >> 6;
        float v = 0.f;
#pragma unroll
        for (int h = 0; h < 4; ++h) { v += impM[(h * 64 + qq) * 33 + j]; if (j > 0) v += impS[(h * 64 + qq) * 33 + j - 1]; }
        const bool forced = (j == 0) || (j == cur) || (j == cur - 1);
        impv[idx] = forced ? 1e6f : (j <= cur ? v : -1e9f); }
    __syncthreads();
#pragma unroll 1
    for (int e = 0; e < 4; ++e) { const int idx = tid + 512 * e, qq = idx >> 5, j = idx & 31;
        const float my = impv[idx]; int rank = 0;
#pragma unroll 8
        for (int j2 = 0; j2 < 32; ++j2) { const float o2 = impv[qq * 32 + j2]; rank += (o2 > my || (o2 == my && j2 < j)) ? 1 : 0; }
        const unsigned long long bal = __ballot(rank < 16);
        if (lane == 0) selm[qq] = (unsigned)bal; if (lane == 32) selm[qq] = (unsigned)(bal >> 32); }
    __syncthreads();
    float gc, gs, gw;
    { const bf16_t* gp = proj + (size_t)(b * TT + tq) * NPROJ + C_GATE + head * 3;
      gc = sigmoidf_(bf2f(gp[0])); gs = sigmoidf_(bf2f(gp[1])); gw = sigmoidf_(bf2f(gp[2])); }
    { float* outs1_ = outs + lane; asm volatile("" : "+v"(outs1_)); GAS float* outs1 = (GAS float*)outs1_;
#pragma unroll
    for (int dt = 0; dt < 4; ++dt)
#pragma unroll
        for (int i = 0; i < 16; ++i) outs1[(dt * 16 + i) * 64] = gc * oc[dt][i]; }
    const unsigned mymask = selm[qloc];
    unsigned uni = selm[lane];
#pragma unroll
    for (int o_ = 32; o_ >= 1; o_ >>= 1) uni |= (unsigned)__shfl_xor((int)uni, o_);
    uni = __builtin_amdgcn_readfirstlane(uni);
    f32x16 o[4]; float m, l;
    {
#pragma unroll
        for (int dt = 0; dt < 4; ++dt)
#pragma unroll
            for (int i = 0; i < 16; ++i) o[dt][i] = 0.f;
        m = NEGF; l = 0.f;
        const bf16_t* kb = proj + (size_t)(b * TT) * NPROJ + C_KS + g * 128;
        const bf16_t* vt = (const bf16_t*)(ws + WS_VTS) + (size_t)bg * 128 * TT;
        const unsigned need = uni & (qt == 31 ? 0xffffffffu : ((1u << (qt + 1)) - 1u));
        attn_branch<0>(smem, kb, vt, need, mymask, t0w, tq, r, hh, qf, lutH, o, m, l);
        const float sc = gs / fmaxf(l, 1e-30f);
        float* outs2_ = outs + lane; asm volatile("" : "+v"(outs2_)); GAS float* outs2 = (GAS float*)outs2_;
        f32x16 pv[4];
#pragma unroll
        for (int dt = 0; dt < 4; ++dt)
#pragma unroll
            for (int i = 0; i < 16; ++i) pv[dt][i] = outs2[(dt * 16 + i) * 64];
        __builtin_amdgcn_sched_barrier(0);
#pragma unroll
        for (int dt = 0; dt < 4; ++dt)
#pragma unroll
            for (int i = 0; i < 16; ++i) outs2[(dt * 16 + i) * 64] = pv[dt][i] + sc * o[dt][i];
    }
    {
#pragma unroll
        for (int dt = 0; dt < 4; ++dt)
#pragma unroll
            for (int i = 0; i < 16; ++i) o[dt][i] = 0.f;
        m = NEGF; l = 0.f;
        const bf16_t* kb = proj + (size_t)(b * TT) * NPROJ + C_KW + g * 128;
        const bf16_t* vt = (const bf16_t*)(ws + WS_VTW) + (size_t)bg * 128 * TT;
        const int jlo = qt >= 8 ? qt - 8 : 0;
        const unsigned need = (qt == 31 ? 0xffffffffu : ((1u << (qt + 1)) - 1u)) & ~((1u << jlo) - 1u);
        attn_branch<1>(smem, kb, vt, need, 0u, t0w, tq, r, hh, qf, lutH, o, m, l);
        const float sc = gw / fmaxf(l, 1e-30f);
        float* outs3_ = outs + lane; asm volatile("" : "+v"(outs3_)); GAS float* outs3 = (GAS float*)outs3_;
        bf16_t* as = (bf16_t*)(ws + WS_AS) + (size_t)(b * TT + tq) * DM + head * 128;
        f32x16 pv[4];
#pragma unroll
        for (int dt = 0; dt < 4; ++dt)
#pragma unroll
            for (int i = 0; i < 16; ++i) pv[dt][i] = outs3[(dt * 16 + i) * 64];
        __builtin_amdgcn_sched_barrier(0);
#pragma unroll
        for (int dt = 0; dt < 4; ++dt)
#pragma unroll
            for (int gi = 0; gi < 4; ++gi) { float v[4];
#pragma unroll
                for (int j = 0; j < 4; ++j) { const int i = 4 * gi + j; v[j] = pv[dt][i] + sc * o[dt][i]; }
                u32x2 w; w.x = pk2(v[0], v[1]); w.y = pk2(v[2], v[3]);
                *(u32x2*)(as + 32 * dt + 8 * gi + 4 * hh) = w; }
    }
}

DI void fill_rstd(const pg8::StaticOrder& S, const float* ss, unsigned char* smem) {
    float* rl = (float*)(smem + 131072);
    for (int i = 0; i < 16; ++i) { pg8::Unit u; if (!S.next(i, u)) break;
        if (threadIdx.x < 256) rl[i * 256 + threadIdx.x] = 1.0f / sqrtf(ss[u.pm * 256 + threadIdx.x] * (1.0f / DM) + EPSN); }
    __syncthreads();
}

#define XB_TMO      128
#define XB_XCNT(j)  (256  + 64 * (j))
#define XB_XSUB(j)  (1280 + 64 * (j))
#define XB_XGEN(j)  (2304 + 64 * (j))
#define XB_TOP      3328
#define XB_TOPGEN   3392
#define XCD_BAR_WORDS 3456
#define XB_SPIN_CAP (1u << 18)
DI unsigned xb_ld(unsigned* p)              { return __hip_atomic_load(p, __ATOMIC_RELAXED, __HIP_MEMORY_SCOPE_AGENT); }
DI unsigned xb_add(unsigned* p, unsigned v) { return __hip_atomic_fetch_add(p, v, __ATOMIC_RELAXED, __HIP_MEMORY_SCOPE_AGENT); }
DI unsigned xb_xcc_id() { return (unsigned)__builtin_amdgcn_s_getreg((3 << 11) | 20) & 0xFu; }
#define XB_SPIN(cond, bar) do { unsigned _sp = 0; while (cond) { __builtin_amdgcn_s_sleep(1); \
    if ((++_sp & 255u) == 0u) { if (xb_ld(&(bar)[XB_TMO])) break; if (_sp > XB_SPIN_CAP) { atomicAdd(&(bar)[XB_TMO], 1u); break; } } } } while (0)
struct XcdBarrier { unsigned* bar; unsigned x; volatile LAS unsigned* st; };
DI XcdBarrier xcd_barrier_post(unsigned* bar, volatile LAS unsigned* st) {
    XcdBarrier b; b.bar = bar; b.x = xb_xcc_id(); b.st = st;
    if (threadIdx.x == 0) (void)xb_add(&bar[XB_XCNT(b.x)], 1u);
    return b;
}
DI void xcd_barrier_complete(unsigned* bar, unsigned x, unsigned& nloc, unsigned& nx) {
    const unsigned G = gridDim.x * gridDim.y * gridDim.z;
    unsigned sum, cnt, mine, sp = 0u;
    for (;;) {
        sum = 0u; cnt = 0u; mine = 0u;
#pragma unroll
        for (unsigned j = 0; j < 16; ++j) { const unsigned c = xb_ld(&bar[XB_XCNT(j)]); sum += c; cnt += (c > 0u) ? 1u : 0u; mine = (j == x) ? c : mine; }
        if (sum == G) break;
        __builtin_amdgcn_s_sleep(1);
        if ((++sp & 255u) == 0u) { if (xb_ld(&bar[XB_TMO])) break; if (sp > XB_SPIN_CAP) { atomicAdd(&bar[XB_TMO], 1u); break; } }
    }
    nloc = mine > 0u ? mine : 1u; nx = cnt > 0u ? cnt : 1u;
}
DI void xcd_barrier(const XcdBarrier& b) {
    asm volatile("s_waitcnt vmcnt(0)" ::: "memory");
    __syncthreads();
    if (threadIdx.x == 0) {
        unsigned* bar = b.bar;
        __builtin_amdgcn_s_waitcnt(0);
        unsigned nloc = b.st[0], nx = b.st[1];
        if (nloc == 0u) { xcd_barrier_complete(bar, b.x, nloc, nx); b.st[0] = nloc; b.st[1] = nx; }
        const unsigned old = xb_add(&bar[XB_XSUB(b.x)], 1u);
        const unsigned gen = old / nloc;
        if (old + 1u == (gen + 1u) * nloc) {
            __builtin_amdgcn_fence(__ATOMIC_RELEASE, "agent");
            asm volatile("s_waitcnt vmcnt(0)" ::: "memory");
            const unsigned og = xb_add(&bar[XB_TOP], 1u);
            const unsigned tg = og / nx;
            if (og + 1u == (tg + 1u) * nx) xb_add(&bar[XB_TOPGEN], 1u);
            else XB_SPIN(xb_ld(&bar[XB_TOPGEN]) == tg, bar);
            __builtin_amdgcn_fence(__ATOMIC_ACQUIRE, "agent");
            xb_add(&bar[XB_XGEN(b.x)], 1u);
            asm volatile("s_waitcnt vmcnt(0)" ::: "memory");
        } else {
            XB_SPIN(xb_ld(&bar[XB_XGEN(b.x)]) == gen, bar);
            __builtin_amdgcn_fence(__ATOMIC_ACQUIRE, "agent");
            asm volatile("s_waitcnt vmcnt(0)" ::: "memory");
        }
    }
    __syncthreads();
}

__global__ void __launch_bounds__(512, 2) hymba_fwd(Params P) {
    extern __shared__ __attribute__((aligned(16))) unsigned char shm[];
    cg::grid_group grid = cg::this_grid();
    unsigned char* ws = P.ws;
    LAS unsigned char* lds = (LAS unsigned char*)shm;
    const int tid = threadIdx.x, G = gridDim.x;
    float* hres = P.out;
    const int lo = P.ph_lo, hi = P.ph_hi;
    volatile LAS unsigned* xbst = (volatile LAS unsigned*)(lds + L_CUR + 16);
    if (tid == 0) { xbst[0] = 0u; xbst[1] = 0u; }
    __syncthreads();
    const XcdBarrier xbar = xcd_barrier_post((unsigned*)((float*)(ws + WS_SMALL) + SM_BAR), xbst);
#define IN(k) (lo <= (k) && (k) < hi)
#define SYNC(k) do { if (IN(k) && IN((k) + 1)) { if ((k) == 0) grid.sync(); else xcd_barrier(xbar); } } while (0)
#ifndef DUP_PH
#define DUP_PH -1
#endif
#define REP(k) for (int rep_ = 0; rep_ < ((k) == DUP_PH ? 2 : 1); ++rep_, (((k) == DUP_PH && rep_ == 1) ? grid.sync() : (void)0))
    if (IN(0)) REP(0) phase_prep(P, shm);
    SYNC(0);
    if (IN(1)) REP(1) { pg8::Gemm g{(const bf16_t*)(ws + WS_XN), (const bf16_t*)(ws + WS_W13A), MTOK, 2 * DFF, DM};
        pg8::StaticOrder S; S.init(MTOK, 2 * DFF, G, (int)blockIdx.x); EpiSwiGLU E{(bf16_t*)(ws + WS_H), nullptr};
        pg8::gemm_phase<EpiSwiGLU, pg8::StaticOrder>(lds, g, S, E); }
    SYNC(1);
    if (IN(2)) REP(2) { pg8::Gemm g{(const bf16_t*)(ws + WS_H), (const bf16_t*)(ws + WS_W2A), MTOK, DM, DFF};
        pg8::StaticOrder S; S.init(MTOK, DM, G, (int)blockIdx.x); EpiResid<0> E{P.in[0], nullptr, nullptr, (bf16_t*)hres, (float*)(ws + WS_SMALL) + SM_SS, 0.5f};
        pg8::gemm_phase<EpiResid<0>, pg8::StaticOrder>(lds, g, S, E); }
    if (IN(2) && hi > 3) xcd_barrier(xbar);
    if (IN(4)) REP(4) {
        if (blockIdx.x == 0 && tid < 256) { float* sm = (float*)(ws + WS_SMALL); const int which = tid >> 7, n = tid & 127; float s = P.in[which ? 13 : 9][n];
            for (int c = 0; c < 128; ++c) s += sm[SM_CBP + (which * 128 + c) * 128 + n];
            sm[SM_CB1 + which * 128 + n] = s; }
        pg8::Gemm g{(const bf16_t*)hres, (const bf16_t*)(ws + WS_WIN), MTOK, NPROJ, DM};
        pg8::StaticOrder S; S.init(MTOK, NPROJ, G, (int)blockIdx.x); EpiProj E{(bf16_t*)(ws + WS_PROJ), (const float*)(ws + WS_SMALL) + SM_SS, (bf16_t*)(ws + WS_VTS), (bf16_t*)(ws + WS_VTW)}; fill_rstd(S, E.ss, shm);
        pg8::gemm_phase<EpiProj, pg8::StaticOrder>(lds, g, S, E); }
    SYNC(4);
    if (IN(5)) REP(5) {
        for (int it = blockIdx.x; it < 254 + 2048; it += G) {
            if (it < 254) compress_item(P, it, shm);
            else { s5_pass1_item(P, it - 254, shm); __syncthreads(); }
        } }
    SYNC(5);
    if (IN(6)) REP(6) {
        int* ctr = (int*)((float*)(ws + WS_SMALL) + SM_CTR) + rep_;
        volatile int* curw = (volatile int*)(shm + L_CUR);
        for (int it = blockIdx.x; it < 2048; it += G) { s5_pass3_item(P, it, shm); __syncthreads(); }
        for (;;) {
            __syncthreads();
            if (tid == 0) *curw = atomicAdd(ctr, 1);
            __syncthreads();
            const int it = *curw;
            if (it >= 512) break;
            attn_item(P, it, shm);
        } }
    SYNC(6);
    if (IN(7)) REP(7) { pg8::Gemm g{(const bf16_t*)(ws + WS_HG), (const bf16_t*)(ws + WS_GLUW), MTOK, 1024, 1024};
        pg8::StaticOrder S; S.init(MTOK, 1024, G, (int)blockIdx.x); EpiGLU E{(const bf16_t*)(ws + WS_HG), P.in[25], (bf16_t*)(ws + WS_AS)};
        pg8::gemm_phase<EpiGLU, pg8::StaticOrder>(lds, g, S, E); }
    SYNC(7);
    if (IN(8)) REP(8) { pg8::Gemm g{(const bf16_t*)(ws + WS_AS), (const bf16_t*)(ws + WS_WOUT), MTOK, DM, DM};
        pg8::StaticOrder S; S.init(MTOK, DM, G, (int)blockIdx.x); EpiResid<1> E{nullptr, (const bf16_t*)hres, nullptr, (bf16_t*)(ws + WS_XN), (float*)(ws + WS_SMALL) + SM_SS + 16384, 1.0f};
        pg8::gemm_phase<EpiResid<1>, pg8::StaticOrder>(lds, g, S, E); }
    if (IN(8) && hi > 9) xcd_barrier(xbar);
    if (IN(10)) REP(10) { pg8::Gemm g{(const bf16_t*)(ws + WS_XN), (const bf16_t*)(ws + WS_W13B), MTOK, 2 * DFF, DM};
        pg8::StaticOrder S; S.init(MTOK, 2 * DFF, G, (int)blockIdx.x); EpiSwiGLU E{(bf16_t*)(ws + WS_H), (const float*)(ws + WS_SMALL) + SM_SS + 16384}; fill_rstd(S, E.ss, shm);
        pg8::gemm_phase<EpiSwiGLU, pg8::StaticOrder>(lds, g, S, E); }
    SYNC(10);
    if (IN(11)) REP(11) { pg8::Gemm g{(const bf16_t*)(ws + WS_H), (const bf16_t*)(ws + WS_W2B), MTOK, DM, DFF};
        pg8::StaticOrder S; S.init(MTOK, DM, G, (int)blockIdx.x); EpiResid<2> E{nullptr, (const bf16_t*)(ws + WS_XN), hres, nullptr, nullptr, 0.5f};
        pg8::gemm_phase<EpiResid<2>, pg8::StaticOrder>(lds, g, S, E); }
    SYNC(11);
    if (IN(12)) REP(12) norm_rows(hres, P.in[31], nullptr, hres);
}

#ifndef N_LAUNCH_MODE
#define N_LAUNCH_MODE 0
#endif

extern "C" void kernel_launch(void* const* d_in, const int* in_sizes, int n_in, void* d_out, int out_size, void* d_ws, size_t ws_size, hipStream_t stream) {
    static int grid = 0;
    if (grid == 0) {
        int dev = 0, cus = 0, per_cu = 0;
        hipGetDevice(&dev);
        hipDeviceGetAttribute(&cus, hipDeviceAttributeMultiprocessorCount, dev);
        hipFuncSetAttribute((const void*)hymba_fwd, hipFuncAttributeMaxDynamicSharedMemorySize, LDS_BYTES);
        hipOccupancyMaxActiveBlocksPerMultiprocessor(&per_cu, (const void*)hymba_fwd, 512, LDS_BYTES);
        if (per_cu < 1) { fprintf(stderr, "occupancy query says %d blocks/CU\n", per_cu); per_cu = 1; }
        (void)hipGetLastError();
        grid = cus * 1;
        if (n_in != 32 || ws_size < WS_END) fprintf(stderr, "kernel_launch: unexpected n_in %d / ws %zu\n", n_in, ws_size);
    }
    Params p{};
    for (int i = 0; i < 32; ++i) p.in[i] = (const float*)d_in[i];
    p.out = (float*)d_out; p.ws = (unsigned char*)d_ws;
    (void)hipMemsetAsync((unsigned char*)d_ws + WS_SMALL + (size_t)SM_BAR * 4, 0, XCD_BAR_WORDS * 4, stream);
#if N_LAUNCH_MODE == 0
    p.ph_lo = 0; p.ph_hi = NPH;
    { void* args[] = {&p};
      hipError_t e = hipLaunchCooperativeKernel((const void*)hymba_fwd, dim3(grid), dim3(512), args, LDS_BYTES, stream);
      if (e != hipSuccess) fprintf(stderr, "cooperative launch failed: %s (grid %d)\n", hipGetErrorString(e), grid); }
#else
    for (int ph = 0; ph < NPH; ++ph) { p.ph_lo = ph; p.ph_hi = ph + 1;
        void* args[] = {&p};
        hipError_t e = hipLaunchCooperativeKernel((const void*)hymba_fwd, dim3(grid), dim3(512), args, LDS_BYTES, stream);
        if (e != hipSuccess) fprintf(stderr, "launch %d failed: %s (grid %d)\n", ph, hipGetErrorString(e), grid); }
#endif
}
```

```cpp
#include <hip/hip_runtime.h>
#include <hip/hip_cooperative_groups.h>
#include <cstdio>
namespace cg = cooperative_groups;

#define DI __device__ __forceinline__
#define LAS __attribute__((address_space(3)))
#define GAS __attribute__((address_space(1)))
typedef unsigned short bf16_t;
typedef short bf16x8 __attribute__((ext_vector_type(8)));
typedef short s16x4 __attribute__((ext_vector_type(4)));
typedef float f32x4 __attribute__((ext_vector_type(4)));
typedef float f32x16 __attribute__((ext_vector_type(16)));
typedef unsigned u32x4 __attribute__((ext_vector_type(4)));
typedef unsigned u32x2 __attribute__((ext_vector_type(2)));
typedef __bf16 bf16x2_t __attribute__((ext_vector_type(2)));
typedef float f32x2_t __attribute__((ext_vector_type(2)));

constexpr int MTOK = 16384, DM = 2048, DFF = 5632, TT = 2048;
constexpr int NPROJ = 3840;
constexpr int C_KC = 1024, C_VC = 1280, C_KS = 1536, C_VS = 1792, C_KW = 2048, C_VW = 2304, C_GATE = 2560, C_SSM = 2584;
constexpr float EPSN = 1e-6f;
constexpr float NEGF = -1e30f;

constexpr size_t WS_W13A = 0;
constexpr size_t WS_W2A = WS_W13A + 46137344;
constexpr size_t WS_W13B = WS_W2A + 23068672;
constexpr size_t WS_W2B = WS_W13B + 46137344;
constexpr size_t WS_WIN = WS_W2B + 23068672;
constexpr size_t WS_WOUT = WS_WIN + 15728640;
constexpr size_t WS_GLUW = WS_WOUT + 8388608;
constexpr size_t WS_CW1K = WS_GLUW + 2097152;
constexpr size_t WS_CW1V = WS_CW1K + 1048576;
constexpr size_t WS_CW2K = WS_CW1V + 1048576;
constexpr size_t WS_CW2V = WS_CW2K + 32768;
constexpr size_t WS_SMALL = WS_CW2V + 32768;
constexpr size_t WS_KCB = WS_SMALL + 1048576;
constexpr size_t WS_VCBT = WS_KCB + 524288;
constexpr size_t WS_S5END = WS_VCBT + 524288;
constexpr size_t WS_VTS = WS_S5END + 8388608;
constexpr size_t WS_VTW = WS_VTS + 8388608;
constexpr size_t WS_XN = WS_VTW + 8388608;
constexpr size_t WS_H = WS_XN + 67108864;
constexpr size_t WS_PROJ = WS_H;
constexpr size_t WS_AS = WS_H + 125829120;
constexpr size_t WS_HG = WS_XN;
constexpr size_t WS_OUTS = WS_H + 184549376 + 8388608;
constexpr size_t WS_END = WS_OUTS + 33554432;
constexpr int SM_CB1 = 0;
constexpr int SM_AB = 256;
constexpr int SM_BB = 256 + 16384;
constexpr int SM_CTR = 256 + 16384 + 131072;
constexpr int SM_CBP = SM_CTR + 64;
constexpr int SM_SS = SM_CBP + 32768;
constexpr int SM_BAR = 213504;

constexpr int LDS_BYTES = 151552;
constexpr int L_CUR = 149776;
constexpr int NPH = 13;

struct Params { const float* in[32]; float* out; unsigned char* ws; int ph_lo, ph_hi; };

DI unsigned pk2(float a, float b) { f32x2_t v = {a, b}; return __builtin_bit_cast(unsigned, __builtin_convertvector(v, bf16x2_t)); }
DI float bf2f(unsigned x) { return __uint_as_float(x << 16); }
DI float bflo(unsigned w) { return __uint_as_float(w << 16); }
DI float bfhi(unsigned w) { return __uint_as_float(w & 0xffff0000u); }
DI float sigmoidf_(float x) { return __builtin_amdgcn_rcpf(1.0f + __builtin_amdgcn_exp2f(-1.4426950408889634f * x)); }
DI float gelu_tanh(float v) { const float z = 0.7978845608028654f * (v + 0.044715f * v * v * v); const float th = 1.0f - 2.0f * __builtin_amdgcn_rcpf(__builtin_amdgcn_exp2f(2.8853900817779268f * z) + 1.0f); return 0.5f * v * (1.0f + th); }

namespace pg8 {
constexpr int BM = 256, BK = 64, HALF = 128, HTB = HALF * BK * 2, STAGE_BYTES = 8 * HTB, NXCD = 8, WGM = 8;
__host__ __device__ __forceinline__ int lds_byte(int r, int c) { const int st = (r >> 4) * 2 + (c >> 5), rr = r & 15, cc = c & 31, ob = rr * 64 + cc * 2; return st * 1024 + (ob ^ (((ob >> 9) & 1) << 5)); }
__host__ __device__ __forceinline__ void stage_rc(int b, int& R, int& C) { const int st = b / 1024, sb = b % 1024, swz = sb ^ (((sb >> 9) & 1) << 5); R = (st >> 1) * 16 + swz / 64; C = (st & 1) * 32 + (swz % 64) / 2; }
__host__ __device__ __forceinline__ int perm32(int rho) { const int n = rho >> 4, i = rho & 15; return 8 * (i >> 2) + 4 * n + (i & 3); }
struct Unit { int pm, pn; };
struct Gemm { const bf16_t* A; const bf16_t* Bt; int M, N, K; };
struct StaticOrder {
    int nM, nN, nwg, G, c;
    __host__ __device__ void init(int M, int N, int G_, int c_) { nM = M / BM; nN = N / BM; nwg = nM * nN; G = G_; c = c_; }
    __host__ __device__ bool next(int i, Unit& u) const {
        const long L = (long)i * G + c; if (L >= nwg) return false;
        int wgid = (int)L; { const int q = nwg / NXCD, r = nwg % NXCD, xcd = wgid % NXCD, off = wgid / NXCD; wgid = (xcd < r ? xcd * (q + 1) : r * (q + 1) + (xcd - r) * q) + off; }
        const int nig = WGM * nN, gid = wgid / nig, fm = gid * WGM, gsz = (nM - fm) < WGM ? (nM - fm) : WGM;
        u.pm = fm + ((wgid % nig) % gsz); u.pn = (wgid % nig) / gsz; return true;
    }
    __device__ __forceinline__ void a_ready(const Unit&) const {}
    __device__ __forceinline__ void done(const Unit&) const {}
};

template <class Epi, class Sched>
__device__ __forceinline__ void gemm_phase(LAS unsigned char* lds, const Gemm g, const Sched& S, const Epi& E) {
    const int tid = threadIdx.x, wid = __builtin_amdgcn_readfirstlane(tid >> 6), lane = tid & 63, wr = wid >> 2, wc = wid & 3, fr = lane & 15, fq = lane >> 4;
    const int K = g.K, nt = K / BK;
    unsigned voffA[2], voffB[2];
#pragma unroll
    for (int i = 0; i < 2; ++i) { int R, C; stage_rc(tid * 16 + i * 8192, R, C); const int Rb = Epi::PERM ? ((R & ~31) + perm32(R & 31)) : R;
        voffA[i] = (unsigned)(R * K + C) * 2u; voffB[i] = (unsigned)(Rb * K + C) * 2u; }
    const size_t kstep = (size_t)(BK * 2);
    const size_t hstep = (size_t)HALF * K * 2;
    const size_t tstep = 2 * hstep;
    const unsigned ldsw = (unsigned)wid * 1024u;
    const int aoff = lds_byte(wr * 64 + fr, fq * 8), boff = lds_byte(wc * 32 + fr, fq * 8);
#define PG8_SA(b, h) (((b) * 2 + (h)) * HTB)
#define PG8_SB(b, h) ((4 + (b) * 2 + (h)) * HTB)
#define PG8_STAGE(bufoff, gbase, voff) do { _Pragma("unroll") for (int _i = 0; _i < 2; ++_i) \
        __builtin_amdgcn_global_load_lds((const unsigned*)((const char*)(gbase) + (voff)[_i]), (LAS unsigned*)(lds + (bufoff) + ldsw + _i * 8192), 16, 0, 0); } while (0)
#define PG8_LDA(dst, b, h) do { _Pragma("unroll") for (int m = 0; m < 4; ++m) _Pragma("unroll") for (int k = 0; k < 2; ++k) dst[m][k] = *(const LAS bf16x8*)(lds + PG8_SA(b, h) + aoff + m * 2048 + k * 1024); } while (0)
#define PG8_LDB(dst, b, h) do { _Pragma("unroll") for (int n = 0; n < 2; ++n) _Pragma("unroll") for (int k = 0; k < 2; ++k) dst[n][k] = *(const LAS bf16x8*)(lds + PG8_SB(b, h) + boff + n * 2048 + k * 1024); } while (0)
#define PG8_MMA(ai, bj, At, Bt) do { __builtin_amdgcn_s_setprio(1); _Pragma("unroll") for (int m = 0; m < 4; ++m) _Pragma("unroll") for (int n = 0; n < 2; ++n) _Pragma("unroll") for (int k = 0; k < 2; ++k) \
        acc[ai][bj][m][n] = __builtin_amdgcn_mfma_f32_16x16x32_bf16(Bt[n][k], At[m][k], acc[ai][bj][m][n], 0, 0, 0); __builtin_amdgcn_s_setprio(0); } while (0)
#define PG8_WAIT_V(n) asm volatile("s_waitcnt vmcnt(" #n ")" ::: "memory")
#define PG8_WAIT_L(n) asm volatile("s_waitcnt lgkmcnt(" #n ")" ::: "memory")
#define PG8_BAR __builtin_amdgcn_s_barrier()
#define PG8_SCHED __builtin_amdgcn_sched_barrier(0)
    Unit cur, nxt; int ui = 0;
    if (!S.next(0, cur)) return;
    f32x4 acc[2][2][4][2];
#pragma unroll
    for (int a = 0; a < 2; ++a)
#pragma unroll
        for (int b = 0; b < 2; ++b)
#pragma unroll
            for (int m = 0; m < 4; ++m)
#pragma unroll
                for (int n = 0; n < 2; ++n) acc[a][b][m][n] = (f32x4){0.f, 0.f, 0.f, 0.f};
    bf16x8 At[4][2], B0[2][2], B1[2][2];
    const char* cA = (const char*)g.A + (size_t)cur.pm * tstep; const char* cB = (const char*)g.Bt + (size_t)cur.pn * tstep;
    S.a_ready(cur);
    PG8_STAGE(PG8_SB(0, 0), cB, voffB); PG8_STAGE(PG8_SA(0, 0), cA, voffA); PG8_STAGE(PG8_SB(0, 1), cB + hstep, voffB); PG8_STAGE(PG8_SA(0, 1), cA + hstep, voffA);
    if (wr == 1) PG8_BAR;
    PG8_WAIT_V(4); PG8_BAR;
    PG8_STAGE(PG8_SB(1, 0), cB + kstep, voffB); PG8_STAGE(PG8_SA(1, 0), cA + kstep, voffA); PG8_STAGE(PG8_SB(1, 1), cB + hstep + kstep, voffB);
    PG8_WAIT_V(6); PG8_BAR;
    for (;;) {
        const bool has_next = S.next(ui + 1, nxt);
        const char* nA = has_next ? (const char*)g.A + (size_t)nxt.pm * tstep : cA; const char* nB = has_next ? (const char*)g.Bt + (size_t)nxt.pn * tstep : cB;
        for (int t = 0; t < nt; t += 2) {
            const bool last = (t == nt - 2);
            const char* a1 = cA + (size_t)(t + 1) * kstep;
            const char* a2 = last ? nA : cA + (size_t)(t + 2) * kstep; const char* b2 = last ? nB : cB + (size_t)(t + 2) * kstep;
            const char* a3 = a2 + kstep; const char* b3 = b2 + kstep;
            if (last && has_next) S.a_ready(nxt);
            PG8_LDB(B0, 0, 0); PG8_SCHED; PG8_LDA(At, 0, 0); PG8_STAGE(PG8_SA(1, 1), a1 + hstep, voffA);
            PG8_WAIT_L(8); PG8_BAR; PG8_WAIT_L(0); PG8_MMA(0, 0, At, B0); PG8_BAR; PG8_SCHED;
            PG8_LDB(B1, 0, 1); PG8_STAGE(PG8_SB(0, 0), b2, voffB);
            PG8_BAR; PG8_WAIT_L(0); PG8_MMA(0, 1, At, B1); PG8_BAR;
            PG8_LDA(At, 0, 1); PG8_STAGE(PG8_SA(0, 0), a2, voffA);
            PG8_BAR; PG8_WAIT_L(0); PG8_MMA(1, 0, At, B0); PG8_BAR; PG8_SCHED;
            PG8_STAGE(PG8_SB(0, 1), b2 + hstep, voffB);
            PG8_WAIT_V(6); PG8_BAR; PG8_MMA(1, 1, At, B1); PG8_BAR;
            PG8_LDB(B0, 1, 0); PG8_SCHED; PG8_LDA(At, 1, 0); PG8_STAGE(PG8_SA(0, 1), a2 + hstep, voffA);
            PG8_WAIT_L(8); PG8_BAR; PG8_WAIT_L(0); PG8_MMA(0, 0, At, B0); PG8_BAR; PG8_SCHED;
            PG8_LDB(B1, 1, 1); PG8_STAGE(PG8_SB(1, 0), b3, voffB);
            PG8_BAR; PG8_WAIT_L(0); PG8_MMA(0, 1, At, B1); PG8_BAR;
            PG8_LDA(At, 1, 1); PG8_STAGE(PG8_SA(1, 0), a3, voffA);
            PG8_BAR; PG8_WAIT_L(0); PG8_MMA(1, 0, At, B0); PG8_BAR; PG8_SCHED;
            PG8_STAGE(PG8_SB(1, 1), b3 + hstep, voffB);
            PG8_WAIT_V(6); PG8_BAR; PG8_MMA(1, 1, At, B1); PG8_BAR;
        }
        E(acc, cur, wr, wc, fr, fq, ui, lds); S.done(cur);
        if (!has_next) break;
#pragma unroll
        for (int a = 0; a < 2; ++a)
#pragma unroll
            for (int b = 0; b < 2; ++b)
#pragma unroll
                for (int m = 0; m < 4; ++m)
#pragma unroll
                    for (int n = 0; n < 2; ++n) acc[a][b][m][n] = (f32x4){0.f, 0.f, 0.f, 0.f};
        cur = nxt; cA = nA; cB = nB; ++ui;
    }
    PG8_WAIT_V(0);
    if (wr == 0) PG8_BAR;
    PG8_BAR;
#undef PG8_SA
#undef PG8_SB
#undef PG8_STAGE
#undef PG8_LDA
#undef PG8_LDB
#undef PG8_MMA
#undef PG8_WAIT_V
#undef PG8_WAIT_L
#undef PG8_BAR
#undef PG8_SCHED
}
}

struct EpiSwiGLU {
    static constexpr bool PERM = true;
    bf16_t* H; const float* ss;
    DI void operator()(const f32x4 (&acc)[2][2][4][2], const pg8::Unit& u, int wr, int wc, int fr, int fq, int ui, LAS unsigned char* lds) const {
        const int row0 = u.pm * 256 + wr * 64 + fr, col0 = u.pn * 128 + wc * 32 + 8 * fq;
#pragma unroll
        for (int ai = 0; ai < 2; ++ai)
#pragma unroll
            for (int m = 0; m < 4; ++m) {
                const float rs = ss ? ((const LAS float*)(lds + 131072))[ui * 256 + wr * 64 + fr + ai * 128 + m * 16] : 1.0f;
                float v[8];
#pragma unroll
                for (int n = 0; n < 2; ++n)
#pragma unroll
                    for (int j = 0; j < 4; ++j) { const float gt = acc[ai][0][m][n][j] * rs, up = acc[ai][1][m][n][j] * rs; v[n * 4 + j] = gt * up * __builtin_amdgcn_rcpf(1.0f + __builtin_amdgcn_exp2f(-1.4426950408889634f * gt)); }
                u32x4 w; w.x = pk2(v[0], v[1]); w.y = pk2(v[2], v[3]); w.z = pk2(v[4], v[5]); w.w = pk2(v[6], v[7]);
                *(u32x4*)(H + (size_t)(row0 + ai * 128 + m * 16) * DFF + col0) = w;
            }
    }
};
template <int MODE> struct EpiResid {
    static constexpr bool PERM = true;
    const float* basef; const bf16_t* baseb; float* outf; bf16_t* hb; float* ss; float scale;
    DI void operator()(const f32x4 (&acc)[2][2][4][2], const pg8::Unit& u, int wr, int wc, int fr, int fq, int ui, LAS unsigned char* lds) const {
        const int row0 = u.pm * 256 + wr * 64 + fr, col0 = u.pn * 256 + wc * 32 + 8 * fq;
#pragma unroll
        for (int ai = 0; ai < 2; ++ai) {
            f32x4 bf0[4][2], bf1[4][2]; u32x4 bw[4][2];
#pragma unroll
            for (int m = 0; m < 4; ++m)
#pragma unroll
                for (int bj = 0; bj < 2; ++bj) { const size_t off = (size_t)(row0 + ai * 128 + m * 16) * DM + col0 + bj * 128;
                    if (MODE == 0) { bf0[m][bj] = *(const f32x4*)(basef + off); bf1[m][bj] = *(const f32x4*)(basef + off + 4); }
                    else bw[m][bj] = *(const u32x4*)(baseb + off); }
            __builtin_amdgcn_sched_barrier(0);
#pragma unroll
            for (int m = 0; m < 4; ++m) { const int row = row0 + ai * 128 + m * 16; const size_t off = (size_t)row * DM + col0; float rsum = 0.f;
#pragma unroll
                for (int bj = 0; bj < 2; ++bj) {
                    f32x4 b0, b1;
                    if (MODE == 0) { b0 = bf0[m][bj]; b1 = bf1[m][bj]; }
                    else { const u32x4 w = bw[m][bj]; b0 = (f32x4){bflo(w.x), bfhi(w.x), bflo(w.y), bfhi(w.y)}; b1 = (f32x4){bflo(w.z), bfhi(w.z), bflo(w.w), bfhi(w.w)}; }
                    const f32x4 v0 = b0 + acc[ai][bj][m][0] * scale, v1 = b1 + acc[ai][bj][m][1] * scale;
                    if (MODE == 2) { *(f32x4*)(outf + off + bj * 128) = v0; *(f32x4*)(outf + off + bj * 128 + 4) = v1; }
                    else { rsum += (v0[0] * v0[0] + v0[1] * v0[1]) + (v0[2] * v0[2] + v0[3] * v0[3]) + (v1[0] * v1[0] + v1[1] * v1[1]) + (v1[2] * v1[2] + v1[3] * v1[3]);
                        u32x4 w; w.x = pk2(v0[0], v0[1]); w.y = pk2(v0[2], v0[3]); w.z = pk2(v1[0], v1[1]); w.w = pk2(v1[2], v1[3]);
                        *(u32x4*)(hb + off + bj * 128) = w; } }
                if (MODE != 2) { rsum += __shfl_xor(rsum, 16); rsum += __shfl_xor(rsum, 32); if (fq == 0) atomicAdd(ss + row, rsum); } }
        }
    }
};
struct EpiProj {
    static constexpr bool PERM = true;
    bf16_t* O; const float* ss; bf16_t* vts; bf16_t* vtw;
    DI void operator()(const f32x4 (&acc)[2][2][4][2], const pg8::Unit& u, int wr, int wc, int fr, int fq, int ui, LAS unsigned char* lds) const {
        const int row0 = u.pm * 256 + wr * 64 + fr, col0 = u.pn * 256 + wc * 32 + 8 * fq;
        const bool tr = (u.pn == 7) || (u.pn == 9);
#pragma unroll
        for (int ai = 0; ai < 2; ++ai)
#pragma unroll
            for (int m = 0; m < 4; ++m) { const int row = row0 + ai * 128 + m * 16; bf16_t* rowp = O + (size_t)row * NPROJ + col0;
                const float rs = ((const LAS float*)(lds + 131072))[ui * 256 + wr * 64 + fr + ai * 128 + m * 16];
#pragma unroll
                for (int bj = 0; bj < 2; ++bj) { const f32x4 v0 = acc[ai][bj][m][0] * rs, v1 = acc[ai][bj][m][1] * rs;
                    u32x4 w; w.x = pk2(v0[0], v0[1]); w.y = pk2(v0[2], v0[3]); w.z = pk2(v1[0], v1[1]); w.w = pk2(v1[2], v1[3]);
                    if (!tr) *(u32x4*)(rowp + bj * 128) = w;
                    else { bf16_t* vt = (u.pn == 7 ? vts : vtw) + ((size_t)((row >> 11) * 2 + bj) * 128 + wc * 32 + 8 * fq) * TT + (row & 2047);
                        vt[0 * TT] = (bf16_t)(w.x & 0xffffu); vt[1 * TT] = (bf16_t)(w.x >> 16); vt[2 * TT] = (bf16_t)(w.y & 0xffffu); vt[3 * TT] = (bf16_t)(w.y >> 16);
                        vt[4 * TT] = (bf16_t)(w.z & 0xffffu); vt[5 * TT] = (bf16_t)(w.z >> 16); vt[6 * TT] = (bf16_t)(w.w & 0xffffu); vt[7 * TT] = (bf16_t)(w.w >> 16); } } }
    }
};
struct EpiGLU {
    static constexpr bool PERM = true;
    const bf16_t* HG; const float* bias; bf16_t* AS;
    DI void operator()(const f32x4 (&acc)[2][2][4][2], const pg8::Unit& u, int wr, int wc, int fr, int fq, int ui, LAS unsigned char* lds) const {
        const int row0 = u.pm * 256 + wr * 64 + fr, col0 = u.pn * 256 + wc * 32 + 8 * fq;
        f32x4 bs[2][2];
#pragma unroll
        for (int bj = 0; bj < 2; ++bj) { bs[bj][0] = *(const f32x4*)(bias + col0 + bj * 128); bs[bj][1] = *(const f32x4*)(bias + col0 + bj * 128 + 4); }
#pragma unroll
        for (int ai = 0; ai < 2; ++ai) {
            u32x4 hw[4][2];
#pragma unroll
            for (int m = 0; m < 4; ++m)
#pragma unroll
                for (int bj = 0; bj < 2; ++bj) hw[m][bj] = *(const u32x4*)(HG + (size_t)(row0 + ai * 128 + m * 16) * 1024 + col0 + bj * 128);
            __builtin_amdgcn_sched_barrier(0);
#pragma unroll
            for (int m = 0; m < 4; ++m) { const int row = row0 + ai * 128 + m * 16;
#pragma unroll
                for (int bj = 0; bj < 2; ++bj) { const int col = col0 + bj * 128; const u32x4 h = hw[m][bj];
                    const f32x4 v0 = acc[ai][bj][m][0] + bs[bj][0], v1 = acc[ai][bj][m][1] + bs[bj][1];
                    u32x4 w;
                    w.x = pk2(bflo(h.x) * sigmoidf_(v0[0]), bfhi(h.x) * sigmoidf_(v0[1]));
                    w.y = pk2(bflo(h.y) * sigmoidf_(v0[2]), bfhi(h.y) * sigmoidf_(v0[3]));
                    w.z = pk2(bflo(h.z) * sigmoidf_(v1[0]), bfhi(h.z) * sigmoidf_(v1[1]));
                    w.w = pk2(bflo(h.w) * sigmoidf_(v1[2]), bfhi(h.w) * sigmoidf_(v1[3]));
                    *(u32x4*)(AS + (size_t)row * DM + 1024 + col) = w; } }
        }
    }
};

DI void tconv(const float* __restrict__ src, int K, int N, int Npad, bf16_t* __restrict__ dst, int mode, float* tile, const float* __restrict__ gk = nullptr) {
    const int tid = threadIdx.x, ntk = K >> 6, ntn = Npad >> 7, ntile = ntk * ntn;
    f32x4 v[4];
    float gv[4];
#define TC_LOAD(tt) do { const int tk_ = (tt) % ntk, tn_ = (tt) / ntk; \
        _Pragma("unroll") for (int e = 0; e < 4; ++e) { const int i = tid + 512 * e, r = i >> 5, n = tn_ * 128 + (i & 31) * 4, nn = n < N ? n : N - 4; \
            v[e] = __builtin_nontemporal_load((const f32x4*)(src + (size_t)(tk_ * 64 + r) * N + nn)); gv[e] = gk ? gk[tk_ * 64 + r] : 1.0f; } } while (0)
    int t = blockIdx.x;
    if (t < ntile) TC_LOAD(t);
    for (; t < ntile; t += gridDim.x) {
#pragma unroll
        for (int e = 0; e < 4; ++e) { const int i = tid + 512 * e, r = i >> 5, c = (i & 31) * 4; const bool ok = (t / ntk) * 128 + c < N;
            const f32x4 x = ok ? v[e] * gv[e] : (f32x4){0.f, 0.f, 0.f, 0.f};
            tile[r * 129 + c] = x[0]; tile[r * 129 + c + 1] = x[1]; tile[r * 129 + c + 2] = x[2]; tile[r * 129 + c + 3] = x[3]; }
        __syncthreads();
        const int tk = t % ntk, tn = t / ntk;
        if (t + (int)gridDim.x < ntile) TC_LOAD(t + (int)gridDim.x);
        { const int nl = tid >> 2, kg = tid & 3, n = tn * 128 + nl;
          float x[16];
#pragma unroll
          for (int j = 0; j < 16; ++j) x[j] = tile[(kg * 16 + j) * 129 + nl];
          const int drow = mode == 0 ? n : (tn * 256 + nl + (mode == 2 ? 128 : 0));
          u32x4 w0, w1; w0.x = pk2(x[0], x[1]); w0.y = pk2(x[2], x[3]); w0.z = pk2(x[4], x[5]); w0.w = pk2(x[6], x[7]);
          w1.x = pk2(x[8], x[9]); w1.y = pk2(x[10], x[11]); w1.z = pk2(x[12], x[13]); w1.w = pk2(x[14], x[15]);
          u32x4* dp = (u32x4*)(dst + (size_t)drow * K + tk * 64 + kg * 16); dp[0] = w0; dp[1] = w1; }
        __syncthreads();
    }
#undef TC_LOAD
}

DI void norm_rows(const float* src, const float* __restrict__ g, bf16_t* dstb, float* dstf) {
    const int wid = threadIdx.x >> 6, lane = threadIdx.x & 63, stride = gridDim.x * 8;
    for (int row = blockIdx.x * 8 + wid; row < MTOK; row += 2 * stride) {
        const int row2 = row + stride; const bool has2 = row2 < MTOK;
        const f32x4* p = (const f32x4*)(src + (size_t)row * DM); const f32x4* p2 = (const f32x4*)(src + (size_t)(has2 ? row2 : row) * DM);
        f32x4 v[8], w[8]; float ss = 0.f, ss2 = 0.f;
#pragma unroll
        for (int i = 0; i < 8; ++i) { v[i] = __builtin_nontemporal_load(p + lane + 64 * i); w[i] = __builtin_nontemporal_load(p2 + lane + 64 * i); }
#pragma unroll
        for (int i = 0; i < 8; ++i) { ss += v[i][0] * v[i][0] + v[i][1] * v[i][1] + v[i][2] * v[i][2] + v[i][3] * v[i][3]; ss2 += w[i][0] * w[i][0] + w[i][1] * w[i][1] + w[i][2] * w[i][2] + w[i][3] * w[i][3]; }
#pragma unroll
        for (int o = 32; o >= 1; o >>= 1) { ss += __shfl_xor(ss, o); ss2 += __shfl_xor(ss2, o); }
        const float rstd = 1.0f / sqrtf(ss * (1.0f / DM) + EPSN), rstd2 = 1.0f / sqrtf(ss2 * (1.0f / DM) + EPSN);
#pragma unroll
        for (int i = 0; i < 8; ++i) { const f32x4 gg = ((const f32x4*)g)[lane + 64 * i]; const f32x4 y = v[i] * rstd * gg, y2 = w[i] * rstd2 * gg;
            if (dstb) { u32x2 o; o.x = pk2(y[0], y[1]); o.y = pk2(y[2], y[3]); *(u32x2*)(dstb + (size_t)row * DM + (lane + 64 * i) * 4) = o;
                        if (has2) { u32x2 o2; o2.x = pk2(y2[0], y2[1]); o2.y = pk2(y2[2], y2[3]); *(u32x2*)(dstb + (size_t)row2 * DM + (lane + 64 * i) * 4) = o2; } }
            else { __builtin_nontemporal_store(y, (f32x4*)(dstf + (size_t)row * DM) + lane + 64 * i); if (has2) __builtin_nontemporal_store(y2, (f32x4*)(dstf + (size_t)row2 * DM) + lane + 64 * i); } }
    }
}

DI void phase_prep(const Params& P, unsigned char* smem) {
    unsigned char* ws = P.ws; float* tile = (float*)smem; const int tid = threadIdx.x;
    float* sm = (float*)(ws + WS_SMALL);
    if (blockIdx.x < 8) { const int idx = blockIdx.x * 512 + tid, grp = idx >> 6;
        const float step = expf(P.in[18][grp]), lre = P.in[16][idx], lim = P.in[17][idx];
        const float mag = expf(lre * step), ar = mag * cosf(lim * step), ai = mag * sinf(lim * step);
        const float nr = ar - 1.0f, ni = ai, den = lre * lre + lim * lim, fre = (nr * lre + ni * lim) / den, fim = (ni * lre - nr * lim) / den;
        f32x4 brv[4], biv[4];
#pragma unroll
        for (int k = 0; k < 4; ++k) { brv[k] = *(const f32x4*)(P.in[19] + idx * 16 + 4 * k); biv[k] = *(const f32x4*)(P.in[20] + idx * 16 + 4 * k); }
        bf16_t* tb = (bf16_t*)(sm + SM_BB); const int p = idx & 63;
        unsigned hre[16], lre_[16], him[16], lim_[16];
#pragma unroll
        for (int h = 0; h < 16; ++h) { const float br = brv[h >> 2][h & 3], bi = biv[h >> 2][h & 3];
            const float vre = fre * br - fim * bi, vim = fre * bi + fim * br;
            hre[h] = pk2(vre, 0.f) & 0xffffu; lre_[h] = pk2(vre - bf2f(hre[h]), 0.f) & 0xffffu;
            him[h] = pk2(vim, 0.f) & 0xffffu; lim_[h] = pk2(vim - bf2f(him[h]), 0.f) & 0xffffu; }
        { u32x4* d = (u32x4*)(tb + (grp * 128 + p) * 32);
          d[0] = (u32x4){hre[0] | (hre[1] << 16), hre[2] | (hre[3] << 16), hre[4] | (hre[5] << 16), hre[6] | (hre[7] << 16)};
          d[1] = (u32x4){hre[8] | (hre[9] << 16), hre[10] | (hre[11] << 16), hre[12] | (hre[13] << 16), hre[14] | (hre[15] << 16)};
          d[2] = (u32x4){lre_[0] | (lre_[1] << 16), lre_[2] | (lre_[3] << 16), lre_[4] | (lre_[5] << 16), lre_[6] | (lre_[7] << 16)};
          d[3] = (u32x4){lre_[8] | (lre_[9] << 16), lre_[10] | (lre_[11] << 16), lre_[12] | (lre_[13] << 16), lre_[14] | (lre_[15] << 16)};
          u32x4* e = (u32x4*)(tb + (grp * 128 + 64 + p) * 32);
          e[0] = (u32x4){him[0] | (him[1] << 16), him[2] | (him[3] << 16), him[4] | (him[5] << 16), him[6] | (him[7] << 16)};
          e[1] = (u32x4){him[8] | (him[9] << 16), him[10] | (him[11] << 16), him[12] | (him[13] << 16), him[14] | (him[15] << 16)};
          e[2] = (u32x4){lim_[0] | (lim_[1] << 16), lim_[2] | (lim_[3] << 16), lim_[4] | (lim_[5] << 16), lim_[6] | (lim_[7] << 16)};
          e[3] = (u32x4){lim_[8] | (lim_[9] << 16), lim_[10] | (lim_[11] << 16), lim_[12] | (lim_[13] << 16), lim_[14] | (lim_[15] << 16)}; }
        float pr = ar, pi = ai;
        for (int s = 0; s < 6; ++s) { const float nr2 = pr * pr - pi * pi, ni2 = 2.0f * pr * pi; pr = nr2; pi = ni2; }
        sm[SM_AB + idx * 4 + 0] = ar; sm[SM_AB + idx * 4 + 1] = ai; sm[SM_AB + idx * 4 + 2] = pr; sm[SM_AB + idx * 4 + 3] = pi; }
    { const int which = blockIdx.x >> 7, chunk = blockIdx.x & 127; const float* pe = P.in[which ? 11 : 7]; const float* w1 = P.in[which ? 12 : 8];
      if (blockIdx.x < 256) {
        const int n = tid & 127, sub = tid >> 7; float s = 0.f;
#pragma unroll
        for (int j = 0; j < 8; ++j) { const int k = chunk * 32 + sub * 8 + j; s += pe[k] * w1[(size_t)k * 128 + n]; }
        tile[tid] = s; __syncthreads();
        if (tid < 128) sm[SM_CBP + (which * 128 + chunk) * 128 + tid] = (tile[tid] + tile[tid + 128]) + (tile[tid + 256] + tile[tid + 384]);
        __syncthreads(); } }
    if (blockIdx.x == 10 && tid == 0) { ((int*)(sm + SM_CTR))[0] = 0; ((int*)(sm + SM_CTR))[1] = 0; }
    for (int i = blockIdx.x * 512 + tid; i < 32768; i += gridDim.x * 512) sm[SM_SS + i] = 0.f;
    { u32x4* z = (u32x4*)(ws + WS_KCB); const u32x4 zero = {0u, 0u, 0u, 0u};
      for (int i = blockIdx.x * 512 + tid; i < 65536; i += gridDim.x * 512) z[i] = zero; }
    norm_rows(P.in[0], P.in[1], (bf16_t*)(ws + WS_XN), nullptr);
    tconv(P.in[2], DM, DFF, DFF, (bf16_t*)(ws + WS_W13A), 1, tile);
    tconv(P.in[3], DM, DFF, DFF, (bf16_t*)(ws + WS_W13A), 2, tile);
    tconv(P.in[4], DFF, DM, DM, (bf16_t*)(ws + WS_W2A), 0, tile);
    tconv(P.in[6], DM, 3608, NPROJ, (bf16_t*)(ws + WS_WIN), 0, tile, P.in[5]);
    tconv(P.in[8], 4096, 128, 128, (bf16_t*)(ws + WS_CW1K), 0, tile);
    tconv(P.in[12], 4096, 128, 128, (bf16_t*)(ws + WS_CW1V), 0, tile);
    tconv(P.in[10], 128, 128, 128, (bf16_t*)(ws + WS_CW2K), 0, tile);
    tconv(P.in[14], 128, 128, 128, (bf16_t*)(ws + WS_CW2V), 0, tile);
    tconv(P.in[24], 1024, 1024, 1024, (bf16_t*)(ws + WS_GLUW), 0, tile);
    tconv(P.in[26], DM, DM, DM, (bf16_t*)(ws + WS_WOUT), 0, tile);
    tconv(P.in[28], DM, DFF, DFF, (bf16_t*)(ws + WS_W13B), 1, tile, P.in[27]);
    tconv(P.in[29], DM, DFF, DFF, (bf16_t*)(ws + WS_W13B), 2, tile, P.in[27]);
    tconv(P.in[30], DFF, DM, DM, (bf16_t*)(ws + WS_W2B), 0, tile);
}

DI void compress_item(const Params& P, int item, unsigned char* smem) {
    unsigned char* ws = P.ws; const int tid = threadIdx.x, wid = tid >> 6, lane = tid & 63, r = lane & 15, q = lane >> 4;
    const int which = item / 127, rt = item % 127;
    const bf16_t* proj = (const bf16_t*)(ws + WS_PROJ);
    const bf16_t* w1t = (const bf16_t*)(ws + (which ? WS_CW1V : WS_CW1K));
    const bf16_t* w2t = (const bf16_t*)(ws + (which ? WS_CW2V : WS_CW2K));
    const float* cb1 = (const float*)(ws + WS_SMALL) + SM_CB1 + which * 128;
    float* part = (float*)smem;
    bf16_t* hid = (bf16_t*)(smem + 65536);
    const int grow = rt * 16 + r, bg = grow / 127, c = grow % 127, b = bg >> 1, g = bg & 1;
    const bf16_t* arow = proj + (size_t)(b * TT + 16 * c) * NPROJ + (which ? C_VC : C_KC) + g * 128;
    f32x4 acc[8];
#pragma unroll
    for (int ct = 0; ct < 8; ++ct) acc[ct] = (f32x4){0.f, 0.f, 0.f, 0.f};
    bf16x8 fa[2], fb[2][8];
#define CP_LOAD(buf, s_) do { const int kabs_ = 512 * wid + 32 * (s_) + 8 * q; fa[buf] = *(const bf16x8*)(arow + (size_t)(kabs_ >> 7) * NPROJ + (kabs_ & 127)); \
        _Pragma("unroll") for (int ct = 0; ct < 8; ++ct) fb[buf][ct] = *(const bf16x8*)(w1t + (size_t)(ct * 16 + r) * 4096 + kabs_); } while (0)
    CP_LOAD(0, 0);
#pragma unroll
    for (int s = 0; s < 16; ++s) {
        if (s + 1 < 16) CP_LOAD((s + 1) & 1, s + 1);
        __builtin_amdgcn_sched_barrier(0);
#pragma unroll
        for (int ct = 0; ct < 8; ++ct) acc[ct] = __builtin_amdgcn_mfma_f32_16x16x32_bf16(fa[s & 1], fb[s & 1][ct], acc[ct], 0, 0, 0);
        __builtin_amdgcn_sched_barrier(0);
    }
#undef CP_LOAD
#pragma unroll
    for (int ct = 0; ct < 8; ++ct)
#pragma unroll
        for (int j = 0; j < 4; ++j) part[(wid * 16 + 4 * q + j) * 128 + ct * 16 + r] = acc[ct][j];
    __syncthreads();
    { const int row = tid >> 5, c4 = (tid & 31) * 4; f32x4 s = *(const f32x4*)(cb1 + c4);
#pragma unroll
      for (int w = 0; w < 8; ++w) s += *(const f32x4*)(part + (w * 16 + row) * 128 + c4);
      u32x2 o; o.x = pk2(gelu_tanh(s[0]), gelu_tanh(s[1])); o.y = pk2(gelu_tanh(s[2]), gelu_tanh(s[3]));
      *(u32x2*)(hid + row * 136 + c4) = o; }
    __syncthreads();
    { f32x4 a2 = {0.f, 0.f, 0.f, 0.f};
#pragma unroll
      for (int s = 0; s < 4; ++s) { const bf16x8 a = *(const bf16x8*)(hid + r * 136 + 32 * s + 8 * q);
          const bf16x8 bb = *(const bf16x8*)(w2t + (size_t)(16 * wid + r) * 128 + 32 * s + 8 * q);
          a2 = __builtin_amdgcn_mfma_f32_16x16x32_bf16(a, bb, a2, 0, 0, 0); }
      bf16_t* kcb = (bf16_t*)(ws + WS_KCB); bf16_t* vcbt = (bf16_t*)(ws + WS_VCBT);
#pragma unroll
      for (int j = 0; j < 4; ++j) { const int gr = rt * 16 + 4 * q + j, bg2 = gr / 127, c2 = gr % 127, col = 16 * wid + r;
          const bf16_t v = (bf16_t)(pk2(a2[j], 0.f) & 0xffffu);
          if (which == 0) kcb[(size_t)(bg2 * 128 + c2) * 128 + col] = v; else vcbt[(size_t)(bg2 * 128 + col) * 128 + c2] = v; } }
    __syncthreads();
}

DI void s5_bu16(const bf16x8 ub, const bf16x8 (&af)[8], float* buf, int r, int q) {
#pragma unroll
    for (int pt = 0; pt < 8; ++pt) { f32x4 d = {0.f, 0.f, 0.f, 0.f}; d = __builtin_amdgcn_mfma_f32_16x16x32_bf16(af[pt], ub, d, 0, 0, 0);
#pragma unroll
        for (int j = 0; j < 4; ++j) buf[(16 * pt + 4 * q + j) * 17 + r] = d[j]; }
}
DI void s5_pass1_item(const Params& P, int bitem, unsigned char* smem) {
    int tid_ = threadIdx.x; asm volatile("" : "+v"(tid_));
    unsigned char* ws = P.ws; const int tid = tid_, wid = tid >> 6, lane = tid & 63, r = lane & 15, q = lane >> 4;
    const int item = bitem * 8 + wid, ch = item & 31, grp = (item >> 5) & 63, b = item >> 11;
    const bf16_t* proj = (const bf16_t*)(ws + WS_PROJ); const float* sm = (const float*)(ws + WS_SMALL);
    float* buf = (float*)smem + wid * 2176;
    const bf16_t* tb = (const bf16_t*)(sm + SM_BB);
    bf16x8 af[8];
#pragma unroll
    for (int pt = 0; pt < 8; ++pt) af[pt] = *(const bf16x8*)(tb + (grp * 128 + 16 * pt + r) * 32 + 8 * q);
    const f32x4 ab = *(const f32x4*)(sm + SM_AB + (grp * 64 + lane) * 4);
    const bf16_t* ubase = proj + (size_t)(b * TT + ch * 64) * NPROJ + C_SSM + grp * 16;
    float xr = 0.f, xi = 0.f;
    bf16x8 ubs[4];
#pragma unroll
    for (int sub = 0; sub < 4; ++sub) ubs[sub] = *(const bf16x8*)(ubase + (size_t)(sub * 16 + r) * NPROJ + 8 * (q & 1));
#pragma unroll
    for (int sub = 0; sub < 4; ++sub) {
        s5_bu16(ubs[sub], af, buf, r, q);
        asm volatile("s_waitcnt lgkmcnt(0)" ::: "memory");
#pragma unroll
        for (int tt = 0; tt < 16; ++tt) { const float bur = buf[lane * 17 + tt], bui = buf[(64 + lane) * 17 + tt];
            const float nxr = ab[0] * xr - ab[1] * xi + bur, nxi = ab[0] * xi + ab[1] * xr + bui; xr = nxr; xi = nxi; }
        asm volatile("s_waitcnt lgkmcnt(0)" ::: "memory");
    }
    f32x2_t e = {xr, xi};
    *(f32x2_t*)(ws + WS_S5END + ((size_t)((b * 64 + grp) * 32 + ch) * 64 + lane) * 8) = e;
}

DI void vtrans_item(const Params& P, int item, unsigned char* smem) {
    unsigned char* ws = P.ws; const int tid = threadIdx.x;
    const int tokblk = item >> 3, cseg = item & 7, tok0 = tokblk * 64, b = tok0 >> 11, t0 = tok0 & 2047;
    const int col = (cseg < 4 ? C_VS + cseg * 64 : C_VW + (cseg - 4) * 64), g = (cseg & 3) >> 1, d0 = (cseg & 1) * 64;
    const bf16_t* proj = (const bf16_t*)(ws + WS_PROJ);
    bf16_t* dst = (bf16_t*)(ws + (cseg < 4 ? WS_VTS : WS_VTW)) + (size_t)((b * 2 + g) * 128 + d0) * TT + t0;
    bf16_t* tl = (bf16_t*)smem;
    { const int r = tid >> 3, sg = tid & 7; *(u32x4*)(tl + r * 72 + sg * 8) = *(const u32x4*)(proj + (size_t)(tok0 + r) * NPROJ + col + sg * 8); }
    __syncthreads();
    { const int d = tid >> 3, tsg = tid & 7; unsigned v[8];
#pragma unroll
      for (int j = 0; j < 8; ++j) v[j] = tl[(tsg * 8 + j) * 72 + d];
      u32x4 w; w.x = v[0] | (v[1] << 16); w.y = v[2] | (v[3] << 16); w.z = v[4] | (v[5] << 16); w.w = v[6] | (v[7] << 16);
      *(u32x4*)(dst + (size_t)d * TT + tsg * 8) = w; }
    __syncthreads();
}

DI void s5_pass3_item(const Params& P, int bitem, unsigned char* smem) {
    int tid_ = threadIdx.x; asm volatile("" : "+v"(tid_));
    unsigned char* ws = P.ws; const int tid = tid_, wid = tid >> 6, lane = tid & 63, r = lane & 15, q = lane >> 4;
    const int item = bitem * 8 + wid, ch = item & 31, grp = (item >> 5) & 63, b = item >> 11;
    const bf16_t* proj = (const bf16_t*)(ws + WS_PROJ); const float* sm = (const float*)(ws + WS_SMALL);
    float* xs = (float*)smem + wid * 2176;
    bf16_t* HG = (bf16_t*)(ws + WS_HG);
    const bf16_t* tb = (const bf16_t*)(sm + SM_BB);
    bf16x8 af[8];
#pragma unroll
    for (int pt = 0; pt < 8; ++pt) af[pt] = *(const bf16x8*)(tb + (grp * 128 + 16 * pt + r) * 32 + 8 * q);
    const f32x4 ab = *(const f32x4*)(sm + SM_AB + (grp * 64 + lane) * 4);
    float cB[32];
    { const float* cre = P.in[21] + (size_t)(grp * 16 + r) * 64; const float* cim = P.in[22] + (size_t)(grp * 16 + r) * 64;
#pragma unroll
      for (int i = 0; i < 32; ++i) { const int k = 4 * i + q; cB[i] = (i < 16) ? cre[k] : -cim[k - 64]; } }
    const float dsk = P.in[23][grp * 16 + r];
    const bf16_t* ubase = proj + (size_t)(b * TT + ch * 64) * NPROJ + C_SSM + grp * 16;
    bf16x8 ubs[4]; unsigned short uvs[4][4];
#pragma unroll
    for (int sub = 0; sub < 4; ++sub) { ubs[sub] = *(const bf16x8*)(ubase + (size_t)(sub * 16 + r) * NPROJ + 8 * (q & 1));
#pragma unroll
        for (int j = 0; j < 4; ++j) uvs[sub][j] = ubase[(size_t)(sub * 16 + 4 * q + j) * NPROJ + r]; }
    float xr = 0.f, xi = 0.f;
    {
      const f32x2_t* e = (const f32x2_t*)(ws + WS_S5END) + (size_t)((b * 64 + grp) * 32) * 64 + lane;
      f32x2_t ev[31];
#pragma unroll
      for (int j = 0; j < 31; ++j) ev[j] = e[(j < ch ? j : 0) * 64];
#pragma unroll
      for (int j = 0; j < 31; ++j) { const float ex = j < ch ? ev[j][0] : 0.f, ey = j < ch ? ev[j][1] : 0.f;
          const float ncr = ab[2] * xr - ab[3] * xi + ex, nci = ab[2] * xi + ab[3] * xr + ey; xr = j < ch ? ncr : xr; xi = j < ch ? nci : xi; } }
#pragma unroll
    for (int sub = 0; sub < 4; ++sub) {
        s5_bu16(ubs[sub], af, xs, r, q);
        float uv[4];
#pragma unroll
        for (int j = 0; j < 4; ++j) uv[j] = bf2f(uvs[sub][j]);
        asm volatile("s_waitcnt lgkmcnt(0)" ::: "memory");
#pragma unroll
        for (int tt = 0; tt < 16; ++tt) { const float bur = xs[lane * 17 + tt], bui = xs[(64 + lane) * 17 + tt];
            const float nxr = ab[0] * xr - ab[1] * xi + bur, nxi = ab[0] * xi + ab[1] * xr + bui; xr = nxr; xi = nxi;
            xs[lane * 17 + tt] = xr; xs[(64 + lane) * 17 + tt] = xi; }
        asm volatile("s_waitcnt lgkmcnt(0)" ::: "memory");
        f32x4 ya[4];
#pragma unroll
        for (int j = 0; j < 4; ++j) ya[j] = (f32x4){0.f, 0.f, 0.f, 0.f};
#pragma unroll
        for (int i = 0; i < 32; ++i) { const float a = xs[(4 * i + q) * 17 + r]; ya[i & 3] = __builtin_amdgcn_mfma_f32_16x16x4f32(a, cB[i], ya[i & 3], 0, 0, 0); }
        const f32x4 y = (ya[0] + ya[1]) + (ya[2] + ya[3]);
#pragma unroll
        for (int j = 0; j < 4; ++j) { const int tl = sub * 16 + 4 * q + j; const float v = y[j] + dsk * uv[j];
            HG[(size_t)(b * TT + ch * 64 + tl) * 1024 + grp * 16 + r] = (bf16_t)(pk2(gelu_tanh(v), 0.f) & 0xffffu); }
        asm volatile("s_waitcnt lgkmcnt(0)" ::: "memory");
    }
}

DI float xor32_max(float x) { const auto r_ = __builtin_amdgcn_permlane32_swap(__float_as_uint(x), __float_as_uint(x), false, false); return fmaxf(__uint_as_float(r_[0]), __uint_as_float(r_[1])); }
DI float xor32_sum(float x) { const auto r_ = __builtin_amdgcn_permlane32_swap(__float_as_uint(x), __float_as_uint(x), false, false); return __uint_as_float(r_[0]) + __uint_as_float(r_[1]); }
#define MFMA32(a, b, c) __builtin_amdgcn_mfma_f32_32x32x16_bf16((a), (b), (c), 0, 0, 0)
DI bf16x8 ld2x4(const bf16_t* p0) { const s16x4 a = *(const s16x4*)p0, b = *(const s16x4*)(p0 + 8); return __builtin_shufflevector(a, b, 0, 1, 2, 3, 4, 5, 6, 7); }
DI bf16x8 packp(const f32x16& x, int s) { u32x4 p; p.x = pk2(x[8 * s], x[8 * s + 1]); p.y = pk2(x[8 * s + 2], x[8 * s + 3]); p.z = pk2(x[8 * s + 4], x[8 * s + 5]); p.w = pk2(x[8 * s + 6], x[8 * s + 7]); return __builtin_bit_cast(bf16x8, p); }
DI int crow(int i, int hh) { return (i & 3) + 8 * (i >> 2) + 4 * hh; }

constexpr int A_STG = 0;
constexpr int A_BUF = 34816, A_VOFF = 17408;
constexpr int A_IMPM = 69632, A_IMPS = A_IMPM + 33792, A_IMPV = A_IMPS + 33792, A_LUT = A_IMPV + 8192, A_SELM = A_LUT + 4096;
DI bf16x8 lds2x4(const unsigned char* p) { const s16x4 a = *(const s16x4*)p, b = *(const s16x4*)(p + 16); return __builtin_shufflevector(a, b, 0, 1, 2, 3, 4, 5, 6, 7); }

constexpr float QK_C1 = 0.08838834764831845f * 1.4426950408889634f;
template <int MODE, bool FAR>
DI void attn_tile(const unsigned char* kl  , const unsigned char* vl  ,
                  int k0, int tq, int r, int hh, bool bit, const bf16x8 (&qf)[8], const float* lutH, f32x16 (&o)[4], float& m, float& l) {
    f32x16 s;
#pragma unroll
    for (int i = 0; i < 16; ++i) s[i] = 0.f;
    const unsigned char* kp = kl + r * 272 + 16 * hh;
#pragma unroll
    for (int kk = 0; kk < 8; ++kk) { const bf16x8 a = *(const bf16x8*)(kp + 32 * kk); s = MFMA32(a, qf[kk], s); }
    float tmax = NEGF;
    if (FAR) {
        const float b31 = lutH[255];
#pragma unroll
        for (int i = 0; i < 16; ++i) { const float v = s[i] * QK_C1 + b31; s[i] = (MODE == 0 && !bit) ? NEGF : v; tmax = fmaxf(tmax, s[i]); }
    } else {
#pragma unroll
        for (int i = 0; i < 16; ++i) { const int dist = tq - (k0 + crow(i, hh));
            const bool valid = MODE == 0 ? (bit && dist >= 0) : (dist >= 0 && dist < 512);
            const int di = dist < 0 ? 0 : (dist > 255 ? 255 : dist);
            const float v = s[i] * QK_C1 + lutH[di];
            s[i] = valid ? v : NEGF; tmax = fmaxf(tmax, s[i]); }
    }
    tmax = xor32_max(tmax);
    const float mnew = fmaxf(m, tmax);
    if (__ballot(mnew != m) != 0ull) {
        const float alpha = __builtin_amdgcn_exp2f(m - mnew);
        l *= alpha; m = mnew;
#pragma unroll
        for (int dt = 0; dt < 4; ++dt)
#pragma unroll
            for (int i = 0; i < 16; ++i) o[dt][i] *= alpha;
    }
    float psum = 0.f;
    if (FAR) {
#pragma unroll
        for (int i = 0; i < 16; ++i) { const float p = __builtin_amdgcn_exp2f(s[i] - mnew); s[i] = p; psum += p; }
    } else {
#pragma unroll
        for (int i = 0; i < 16; ++i) { const float p = (s[i] > -1e29f) ? __builtin_amdgcn_exp2f(s[i] - mnew) : 0.f; s[i] = p; psum += p; }
    }
    psum = xor32_sum(psum);
    l += psum;
    const unsigned char* vp = vl + r * 136 + 8 * hh;
#pragma unroll
    for (int s2 = 0; s2 < 2; ++s2) { const bf16x8 pb = packp(s, s2);
#pragma unroll
        for (int dt = 0; dt < 4; ++dt) { const bf16x8 a = lds2x4(vp + dt * (32 * 136) + 32 * s2); o[dt] = MFMA32(a, pb, o[dt]); } }
}

template <int MODE>
DI void attn_tile64_far(const unsigned char* bp  , int r, int hh, bool bit, const bf16x8 (&qf)[8], const float* lutH, f32x16 (&o)[4], float& m, float& l) {
    f32x16 s0, s1;
#pragma unroll
    for (int i = 0; i < 16; ++i) { s0[i] = 0.f; s1[i] = 0.f; }
    const unsigned char* kp = bp + r * 272 + 16 * hh;
#pragma unroll
    for (int kk = 0; kk < 8; ++kk) { const bf16x8 a0 = *(const bf16x8*)(kp + 32 * kk), a1 = *(const bf16x8*)(kp + 32 * 272 + 32 * kk); s0 = MFMA32(a0, qf[kk], s0); s1 = MFMA32(a1, qf[kk], s1); }
    const float b31 = lutH[255];
    float tmax = NEGF;
#pragma unroll
    for (int i = 0; i < 16; ++i) { const float v0 = s0[i] * QK_C1 + b31, v1 = s1[i] * QK_C1 + b31;
        s0[i] = (MODE == 0 && !bit) ? NEGF : v0; s1[i] = (MODE == 0 && !bit) ? NEGF : v1; tmax = fmaxf(tmax, fmaxf(s0[i], s1[i])); }
    tmax = xor32_max(tmax);
    const float mnew = fmaxf(m, tmax);
    if (__ballot(mnew != m) != 0ull) {
        const float alpha = __builtin_amdgcn_exp2f(m - mnew);
        l *= alpha; m = mnew;
#pragma unroll
        for (int dt = 0; dt < 4; ++dt)
#pragma unroll
            for (int i = 0; i < 16; ++i) o[dt][i] *= alpha;
    }
    float psum = 0.f;
#pragma unroll
    for (int i = 0; i < 16; ++i) { const float p0 = __builtin_amdgcn_exp2f(s0[i] - mnew), p1 = __builtin_amdgcn_exp2f(s1[i] - mnew); s0[i] = p0; s1[i] = p1; psum += p0 + p1; }
    l += xor32_sum(psum);
    const unsigned char* vp = bp + A_VOFF + r * 136 + 8 * hh;
#pragma unroll
    for (int s2 = 0; s2 < 2; ++s2) { const bf16x8 pb0 = packp(s0, s2), pb1 = packp(s1, s2);
#pragma unroll
        for (int dt = 0; dt < 4; ++dt) { const bf16x8 a0 = lds2x4(vp + dt * (32 * 136) + 32 * s2), a1 = lds2x4(vp + dt * (32 * 136) + 64 + 32 * s2);
            o[dt] = MFMA32(a0, pb0, o[dt]); o[dt] = MFMA32(a1, pb1, o[dt]); } }
}

template <int MODE>
DI void attn_branch(unsigned char* smem, const bf16_t* kb  , const bf16_t* vt  , unsigned need, unsigned mymask,
                    int t0w, int tq, int r, int hh, const bf16x8 (&qf)[8], const float* lutH, f32x16 (&o)[4], float& m, float& l) {
    int tid = threadIdx.x; asm volatile("" : "+v"(tid));
    if (need == 0u) return;
    u32x4 kreg[2], vreg[2];
    const int krow0 = tid >> 4, kcc = tid & 15, vd0 = tid >> 3, vcc = tid & 7;
#define AB_LOAD(j) do { _Pragma("unroll") for (int e = 0; e < 2; ++e) { \
        kreg[e] = *(const u32x4*)(kb + (size_t)(64 * (j) + krow0 + 32 * e) * NPROJ + kcc * 8); \
        vreg[e] = *(const u32x4*)(vt + (size_t)(vd0 + 64 * e) * TT + 64 * (j) + vcc * 8); } } while (0)
#define AB_STORE(buf) do { unsigned char* bp_ = smem + A_STG + (buf) * A_BUF; _Pragma("unroll") for (int e = 0; e < 2; ++e) { \
        *(u32x4*)(bp_ + (krow0 + 32 * e) * 272 + kcc * 16) = kreg[e]; \
        unsigned char* vp_ = bp_ + A_VOFF + (vd0 + 64 * e) * 136 + vcc * 16; \
        *(u32x2*)vp_ = (u32x2){vreg[e].x, vreg[e].y}; *(u32x2*)(vp_ + 8) = (u32x2){vreg[e].z, vreg[e].w}; } } while (0)
    int j = __builtin_ctz(need); need &= need - 1u;
    AB_LOAD(j); AB_STORE(0);
    __syncthreads();
    int n = 0;
    for (;;) {
        const bool has_next = need != 0u;
        int jn = 0;
        if (has_next) { jn = __builtin_ctz(need); need &= need - 1u; AB_LOAD(jn); }
        const unsigned char* bp = smem + A_STG + (n & 1) * A_BUF;
        const bool bit = MODE == 0 ? ((mymask >> j) & 1u) : true;
        const bool any = MODE == 0 ? (__ballot(bit) != 0ull) : true;
        const bool far64 = any && (64 * j + 63 + 128 <= t0w) && (MODE == 0 || 64 * j >= t0w + 31 - 511);
        if (far64) attn_tile64_far<MODE>(bp, r, hh, bit, qf, lutH, o, m, l);
        else {
#pragma unroll 1
        for (int half = 0; half < 2; ++half) { const int k0 = 64 * j + 32 * half;
            bool act = any && (k0 <= t0w + 31);
            if (MODE == 1) act = act && (k0 + 31 + 511 >= t0w);
            const bool far = (k0 + 31 + 128 <= t0w) && (MODE == 0 || k0 >= t0w + 31 - 511);
            if (act) { if (far) attn_tile<MODE, true>(bp + half * (32 * 272), bp + A_VOFF + half * 64, k0, tq, r, hh, bit, qf, lutH, o, m, l);
                       else attn_tile<MODE, false>(bp + half * (32 * 272), bp + A_VOFF + half * 64, k0, tq, r, hh, bit, qf, lutH, o, m, l); } }
        }
        if (has_next) AB_STORE((n + 1) & 1);
        __syncthreads();
        if (!has_next) break;
        j = jn; ++n;
    }
#undef AB_LOAD
#undef AB_STORE
}

DI void attn_item(const Params& P, int item, unsigned char* smem) {
    int tid_ = threadIdx.x; asm volatile("" : "+v"(tid_));
    unsigned char* ws = P.ws; const int tid = tid_, wid = tid >> 6, lane = tid & 63, r = lane & 31, hh = lane >> 5;
    const int bg = item & 15, qt = 31 - (item >> 4), b = bg >> 1, g = bg & 1, t0 = qt * 64;
    const int hg = wid >> 1, t0w = t0 + 32 * (wid & 1), tq = t0w + r, head = g * 4 + hg, qloc = 32 * (wid & 1) + r;
    const bf16_t* proj = (const bf16_t*)(ws + WS_PROJ);
    float* outs = (float*)(ws + WS_OUTS) + ((size_t)blockIdx.x * 8 + wid) * 4096;
    float* impM = (float*)(smem + A_IMPM); float* impS = (float*)(smem + A_IMPS); float* impv = (float*)(smem + A_IMPV);
    float* lut = (float*)(smem + A_LUT); unsigned* selm = (unsigned*)(smem + A_SELM);
    for (int i = tid; i < 1024; i += 512) { const int h4 = i >> 8, n = i & 255; int bk;
        if (n < 16) bk = n; else { bk = 16 + (int)(logf((float)n / 16.0f) / 2.0794415416798357f * 16.0f); bk = bk > 31 ? 31 : bk; }
        lut[i] = P.in[15][bk * 8 + g * 4 + h4] * 1.4426950408889634f; }
    { const bf16_t* kcb = (const bf16_t*)(ws + WS_KCB) + (size_t)bg * 16384; const bf16_t* vcbt = (const bf16_t*)(ws + WS_VCBT) + (size_t)bg * 16384;
#pragma unroll
      for (int e = 0; e < 4; ++e) { const int id = tid + 512 * e, row = id >> 4, cc = id & 15;
          *(u32x4*)(smem + A_STG + row * 272 + cc * 16) = *(const u32x4*)(kcb + row * 128 + cc * 8);
          *(u32x4*)(smem + A_STG + A_BUF + row * 272 + cc * 16) = *(const u32x4*)(vcbt + row * 128 + cc * 8); } }
    bf16x8 qf[8];
    { const bf16_t* qrow = proj + (size_t)(b * TT + tq) * NPROJ + head * 128 + 8 * hh;
#pragma unroll
      for (int kk = 0; kk < 8; ++kk) qf[kk] = *(const bf16x8*)(qrow + 16 * kk); }
    __syncthreads();
    const float* lutH = lut + hg * 256;
    f32x16 oc[4];
    {
        const unsigned char* kl = smem + A_STG + r * 272 + 16 * hh;
        const unsigned char* vl = smem + A_STG + A_BUF + r * 272 + 8 * hh;
        float mx = NEGF, sum = 0.f;
#pragma unroll 1
        for (int kt = 0; kt < 4; ++kt) {
            f32x16 sc;
#pragma unroll
            for (int i = 0; i < 16; ++i) sc[i] = 0.f;
#pragma unroll
            for (int kk = 0; kk < 8; ++kk) { const bf16x8 a = *(const bf16x8*)(kl + kt * (32 * 272) + 32 * kk); sc = MFMA32(a, qf[kk], sc); }
            float tmax = NEGF;
#pragma unroll
            for (int i = 0; i < 16; ++i) { const int c = 32 * kt + crow(i, hh), dist = tq - (16 * c + 31);
                const int di = dist < 0 ? 0 : (dist > 255 ? 255 : dist);
                const float v = sc[i] * QK_C1 + lutH[di];
                sc[i] = (dist >= 0 && c < 127) ? v : NEGF; tmax = fmaxf(tmax, sc[i]); }
            tmax = xor32_max(tmax);
            const float mnew = fmaxf(mx, tmax); float ps = 0.f;
#pragma unroll
            for (int i = 0; i < 16; ++i) ps += (sc[i] > -1e29f) ? __builtin_amdgcn_exp2f(sc[i] - mnew) : 0.f;
            ps = xor32_sum(ps);
            sum = sum * __builtin_amdgcn_exp2f(mx - mnew) + ps; mx = mnew;
        }
        const float inv = 1.0f / fmaxf(sum, 1e-30f);
#pragma unroll
        for (int dt = 0; dt < 4; ++dt)
#pragma unroll
            for (int i = 0; i < 16; ++i) oc[dt][i] = 0.f;
#pragma unroll 1
        for (int kt = 0; kt < 4; ++kt) {
            f32x16 sc;
#pragma unroll
            for (int i = 0; i < 16; ++i) sc[i] = 0.f;
#pragma unroll
            for (int kk = 0; kk < 8; ++kk) { const bf16x8 a = *(const bf16x8*)(kl + kt * (32 * 272) + 32 * kk); sc = MFMA32(a, qf[kk], sc); }
#pragma unroll
            for (int i = 0; i < 16; ++i) { const int c = 32 * kt + crow(i, hh), dist = tq - (16 * c + 31);
                const int di = dist < 0 ? 0 : (dist > 255 ? 255 : dist);
                const float v = sc[i] * QK_C1 + lutH[di];
                sc[i] = (dist >= 0 && c < 127) ? __builtin_amdgcn_exp2f(v - mx) * inv : 0.f; }
#pragma unroll
            for (int gi = 0; gi < 4; ++gi) { const int jb = 8 * kt + 2 * gi + hh; const float p3 = 0.5f * sc[4 * gi + 3];
                impM[(hg * 64 + qloc) * 33 + jb] = sc[4 * gi] + sc[4 * gi + 1] + sc[4 * gi + 2] + p3;
                impS[(hg * 64 + qloc) * 33 + jb] = p3; }
#pragma unroll
            for (int s2 = 0; s2 < 2; ++s2) { const bf16x8 pb = packp(sc, s2);
#pragma unroll
                for (int dt = 0; dt < 4; ++dt) { const bf16x8 a = lds2x4(vl + dt * (32 * 272) + 64 * kt + 32 * s2); oc[dt] = MFMA32(a, pb, oc[dt]); } }
        }
    }
    __syncthreads();
#pragma unroll 1
    for (int e = 0; e < 4; ++e) { const int idx = tid + 512 * e, qq = idx >> 5, j = idx & 31, t = t0 + qq, cur = t >> 6;
        float v = 0.f;
#pragma unroll
        for (int h = 0; h < 4; ++h) { v += impM[(h * 64 + qq) * 33 + j]; if (j > 0) v += impS[(h * 64 + qq) * 33 + j - 1]; }
        const bool forced = (j == 0) || (j == cur) || (j == cur - 1);
        impv[idx] = forced ? 1e6f : (j <= cur ? v : -1e9f); }
    __syncthreads();
#pragma unroll 1
    for (int e = 0; e < 4; ++e) { const int idx = tid + 512 * e, qq = idx >> 5, j = idx & 31;
        const float my = impv[idx]; int rank = 0;
#pragma unroll 8
        for (int j2 = 0; j2 < 32; ++j2) { const float o2 = impv[qq * 32 + j2]; rank += (o2 > my || (o2 == my && j2 < j)) ? 1 : 0; }
        const unsigned long long bal = __ballot(rank < 16);
        if (lane == 0) selm[qq] = (unsigned)bal; if (lane == 32) selm[qq] = (unsigned)(bal >> 32); }
    __syncthreads();
    float gc, gs, gw;
    { const bf16_t* gp = proj + (size_t)(b * TT + tq) * NPROJ + C_GATE + head * 3;
      gc = sigmoidf_(bf2f(gp[0])); gs = sigmoidf_(bf2f(gp[1])); gw = sigmoidf_(bf2f(gp[2])); }
    { float* outs1_ = outs + lane; asm volatile("" : "+v"(outs1_)); GAS float* outs1 = (GAS float*)outs1_;
#pragma unroll
    for (int dt = 0; dt < 4; ++dt)
#pragma unroll
        for (int i = 0; i < 16; ++i) outs1[(dt * 16 + i) * 64] = gc * oc[dt][i]; }
    const unsigned mymask = selm[qloc];
    unsigned uni = selm[lane];
#pragma unroll
    for (int o_ = 32; o_ >= 1; o_ >>= 1) uni |= (unsigned)__shfl_xor((int)uni, o_);
    uni = __builtin_amdgcn_readfirstlane(uni);
    f32x16 o[4]; float m, l;
    {
#pragma unroll
        for (int dt = 0; dt < 4; ++dt)
#pragma unroll
            for (int i = 0; i < 16; ++i) o[dt][i] = 0.f;
        m = NEGF; l = 0.f;
        const bf16_t* kb = proj + (size_t)(b * TT) * NPROJ + C_KS + g * 128;
        const bf16_t* vt = (const bf16_t*)(ws + WS_VTS) + (size_t)bg * 128 * TT;
        const unsigned need = uni & (qt == 31 ? 0xffffffffu : ((1u << (qt + 1)) - 1u));
        attn_branch<0>(smem, kb, vt, need, mymask, t0w, tq, r, hh, qf, lutH, o, m, l);
        const float sc = gs / fmaxf(l, 1e-30f);
        float* outs2_ = outs + lane; asm volatile("" : "+v"(outs2_)); GAS float* outs2 = (GAS float*)outs2_;
        f32x16 pv[4];
#pragma unroll
        for (int dt = 0; dt < 4; ++dt)
#pragma unroll
            for (int i = 0; i < 16; ++i) pv[dt][i] = outs2[(dt * 16 + i) * 64];
        __builtin_amdgcn_sched_barrier(0);
#pragma unroll
        for (int dt = 0; dt < 4; ++dt)
#pragma unroll
            for (int i = 0; i < 16; ++i) outs2[(dt * 16 + i) * 64] = pv[dt][i] + sc * o[dt][i];
    }
    {
#pragma unroll
        for (int dt = 0; dt < 4; ++dt)
#pragma unroll
            for (int i = 0; i < 16; ++i) o[dt][i] = 0.f;
        m = NEGF; l = 0.f;
        const bf16_t* kb = proj + (size_t)(b * TT) * NPROJ + C_KW + g * 128;
        const bf16_t* vt = (const bf16_t*)(ws + WS_VTW) + (size_t)bg * 128 * TT;
        const int jlo = qt >= 8 ? qt - 8 : 0;
        const unsigned need = (qt == 31 ? 0xffffffffu : ((1u << (qt + 1)) - 1u)) & ~((1u << jlo) - 1u);
        attn_branch<1>(smem, kb, vt, need, 0u, t0w, tq, r, hh, qf, lutH, o, m, l);
        const float sc = gw / fmaxf(l, 1e-30f);
        float* outs3_ = outs + lane; asm volatile("" : "+v"(outs3_)); GAS float* outs3 = (GAS float*)outs3_;
        bf16_t* as = (bf16_t*)(ws + WS_AS) + (size_t)(b * TT + tq) * DM + head * 128;
        f32x16 pv[4];
#pragma unroll
        for (int dt = 0; dt < 4; ++dt)
#pragma unroll
            for (int i = 0; i < 16; ++i) pv[dt][i] = outs3[(dt * 16 + i) * 64];
        __builtin_amdgcn_sched_barrier(0);
#pragma unroll
        for (int dt = 0; dt < 4; ++dt)
#pragma unroll
            for (int gi = 0; gi < 4; ++gi) { float v[4];
#pragma unroll
                for (int j = 0; j < 4; ++j) { const int i = 4 * gi + j; v[j] = pv[dt][i] + sc * o[dt][i]; }
                u32x2 w; w.x = pk2(v[0], v[1]); w.y = pk2(v[2], v[3]);
                *(u32x2*)(as + 32 * dt + 8 * gi + 4 * hh) = w; }
    }
}

DI void fill_rstd(const pg8::StaticOrder& S, const float* ss, unsigned char* smem) {
    float* rl = (float*)(smem + 131072);
    for (int i = 0; i < 16; ++i) { pg8::Unit u; if (!S.next(i, u)) break;
        if (threadIdx.x < 256) rl[i * 256 + threadIdx.x] = 1.0f / sqrtf(ss[u.pm * 256 + threadIdx.x] * (1.0f / DM) + EPSN); }
    __syncthreads();
}

#define XB_TMO      128
#define XB_XCNT(j)  (256  + 64 * (j))
#define XB_XSUB(j)  (1280 + 64 * (j))
#define XB_XGEN(j)  (2304 + 64 * (j))
#define XB_TOP      3328
#define XB_TOPGEN   3392
#define XCD_BAR_WORDS 3456
#define XB_SPIN_CAP (1u << 18)
DI unsigned xb_ld(unsigned* p)              { return __hip_atomic_load(p, __ATOMIC_RELAXED, __HIP_MEMORY_SCOPE_AGENT); }
DI unsigned xb_add(unsigned* p, unsigned v) { return __hip_atomic_fetch_add(p, v, __ATOMIC_RELAXED, __HIP_MEMORY_SCOPE_AGENT); }
DI unsigned xb_xcc_id() { return (unsigned)__builtin_amdgcn_s_getreg((3 << 11) | 20) & 0xFu; }
#define XB_SPIN(cond, bar) do { unsigned _sp = 0; while (cond) { __builtin_amdgcn_s_sleep(1); \
    if ((++_sp & 255u) == 0u) { if (xb_ld(&(bar)[XB_TMO])) break; if (_sp > XB_SPIN_CAP) { atomicAdd(&(bar)[XB_TMO], 1u); break; } } } } while (0)
struct XcdBarrier { unsigned* bar; unsigned x; volatile LAS unsigned* st; };
DI XcdBarrier xcd_barrier_post(unsigned* bar, volatile LAS unsigned* st) {
    XcdBarrier b; b.bar = bar; b.x = xb_xcc_id(); b.st = st;
    if (threadIdx.x == 0) (void)xb_add(&bar[XB_XCNT(b.x)], 1u);
    return b;
}
DI void xcd_barrier_complete(unsigned* bar, unsigned x, unsigned& nloc, unsigned& nx) {
    const unsigned G = gridDim.x * gridDim.y * gridDim.z;
    unsigned sum, cnt, mine, sp = 0u;
    for (;;) {
        sum = 0u; cnt = 0u; mine = 0u;
#pragma unroll
        for (unsigned j = 0; j < 16; ++j) { const unsigned c = xb_ld(&bar[XB_XCNT(j)]); sum += c; cnt += (c > 0u) ? 1u : 0u; mine = (j == x) ? c : mine; }
        if (sum == G) break;
        __builtin_amdgcn_s_sleep(1);
        if ((++sp & 255u) == 0u) { if (xb_ld(&bar[XB_TMO])) break; if (sp > XB_SPIN_CAP) { atomicAdd(&bar[XB_TMO], 1u); break; } }
    }
    nloc = mine > 0u ? mine : 1u; nx = cnt > 0u ? cnt : 1u;
}
DI void xcd_barrier(const XcdBarrier& b) {
    asm volatile("s_waitcnt vmcnt(0)" ::: "memory");
    __syncthreads();
    if (threadIdx.x == 0) {
        unsigned* bar = b.bar;
        __builtin_amdgcn_s_waitcnt(0);
        unsigned nloc = b.st[0], nx = b.st[1];
        if (nloc == 0u) { xcd_barrier_complete(bar, b.x, nloc, nx); b.st[0] = nloc; b.st[1] = nx; }
        const unsigned old = xb_add(&bar[XB_XSUB(b.x)], 1u);
        const unsigned gen = old / nloc;
        if (old + 1u == (gen + 1u) * nloc) {
            __builtin_amdgcn_fence(__ATOMIC_RELEASE, "agent");
            asm volatile("s_waitcnt vmcnt(0)" ::: "memory");
            const unsigned og = xb_add(&bar[XB_TOP], 1u);
            const unsigned tg = og / nx;
            if (og + 1u == (tg + 1u) * nx) xb_add(&bar[XB_TOPGEN], 1u);
            else XB_SPIN(xb_ld(&bar[XB_TOPGEN]) == tg, bar);
            __builtin_amdgcn_fence(__ATOMIC_ACQUIRE, "agent");
            xb_add(&bar[XB_XGEN(b.x)], 1u);
            asm volatile("s_waitcnt vmcnt(0)" ::: "memory");
        } else {
            XB_SPIN(xb_ld(&bar[XB_XGEN(b.x)]) == gen, bar);
            __builtin_amdgcn_fence(__ATOMIC_ACQUIRE, "agent");
            asm volatile("s_waitcnt vmcnt(0)" ::: "memory");
        }
    }
    __syncthreads();
}

__global__ void __launch_bounds__(512, 2) hymba_fwd(Params P) {
    extern __shared__ __attribute__((aligned(16))) unsigned char shm[];
    cg::grid_group grid = cg::this_grid();
    unsigned char* ws = P.ws;
    LAS unsigned char* lds = (LAS unsigned char*)shm;
    const int tid = threadIdx.x, G = gridDim.x;
    float* hres = P.out;
    const int lo = P.ph_lo, hi = P.ph_hi;
    volatile LAS unsigned* xbst = (volatile LAS unsigned*)(lds + L_CUR + 16);
    if (tid == 0) { xbst[0] = 0u; xbst[1] = 0u; }
    __syncthreads();
    const XcdBarrier xbar = xcd_barrier_post((unsigned*)((float*)(ws + WS_SMALL) + SM_BAR), xbst);
#define IN(k) (lo <= (k) && (k) < hi)
#define SYNC(k) do { if (IN(k) && IN((k) + 1)) { if ((k) == 0) grid.sync(); else xcd_barrier(xbar); } } while (0)
#ifndef DUP_PH
#define DUP_PH -1
#endif
#define REP(k) for (int rep_ = 0; rep_ < ((k) == DUP_PH ? 2 : 1); ++rep_, (((k) == DUP_PH && rep_ == 1) ? grid.sync() : (void)0))
    if (IN(0)) REP(0) phase_prep(P, shm);
    SYNC(0);
    if (IN(1)) REP(1) { pg8::Gemm g{(const bf16_t*)(ws + WS_XN), (const bf16_t*)(ws + WS_W13A), MTOK, 2 * DFF, DM};
        pg8::StaticOrder S; S.init(MTOK, 2 * DFF, G, (int)blockIdx.x); EpiSwiGLU E{(bf16_t*)(ws + WS_H), nullptr};
        pg8::gemm_phase<EpiSwiGLU, pg8::StaticOrder>(lds, g, S, E); }
    SYNC(1);
    if (IN(2)) REP(2) { pg8::Gemm g{(const bf16_t*)(ws + WS_H), (const bf16_t*)(ws + WS_W2A), MTOK, DM, DFF};
        pg8::StaticOrder S; S.init(MTOK, DM, G, (int)blockIdx.x); EpiResid<0> E{P.in[0], nullptr, nullptr, (bf16_t*)hres, (float*)(ws + WS_SMALL) + SM_SS, 0.5f};
        pg8::gemm_phase<EpiResid<0>, pg8::StaticOrder>(lds, g, S, E); }
    if (IN(2) && hi > 3) xcd_barrier(xbar);
    if (IN(4)) REP(4) {
        if (blockIdx.x == 0 && tid < 256) { float* sm = (float*)(ws + WS_SMALL); const int which = tid >> 7, n = tid & 127; float s = P.in[which ? 13 : 9][n];
            for (int c = 0; c < 128; ++c) s += sm[SM_CBP + (which * 128 + c) * 128 + n];
            sm[SM_CB1 + which * 128 + n] = s; }
        pg8::Gemm g{(const bf16_t*)hres, (const bf16_t*)(ws + WS_WIN), MTOK, NPROJ, DM};
        pg8::StaticOrder S; S.init(MTOK, NPROJ, G, (int)blockIdx.x); EpiProj E{(bf16_t*)(ws + WS_PROJ), (const float*)(ws + WS_SMALL) + SM_SS, (bf16_t*)(ws + WS_VTS), (bf16_t*)(ws + WS_VTW)}; fill_rstd(S, E.ss, shm);
        pg8::gemm_phase<EpiProj, pg8::StaticOrder>(lds, g, S, E); }
    SYNC(4);
    if (IN(5)) REP(5) {
        for (int it = blockIdx.x; it < 254 + 2048; it += G) {
            if (it < 254) compress_item(P, it, shm);
            else { s5_pass1_item(P, it - 254, shm); __syncthreads(); }
        } }
    SYNC(5);
    if (IN(6)) REP(6) {
        int* ctr = (int*)((float*)(ws + WS_SMALL) + SM_CTR) + rep_;
        volatile int* curw = (volatile int*)(shm + L_CUR);
        for (int it = blockIdx.x; it < 2048; it += G) { s5_pass3_item(P, it, shm); __syncthreads(); }
        for (;;) {
            __syncthreads();
            if (tid == 0) *curw = atomicAdd(ctr, 1);
            __syncthreads();
            const int it = *curw;
            if (it >= 512) break;
            attn_item(P, it, shm);
        } }
    SYNC(6);
    if (IN(7)) REP(7) { pg8::Gemm g{(const bf16_t*)(ws + WS_HG), (const bf16_t*)(ws + WS_GLUW), MTOK, 1024, 1024};
        pg8::StaticOrder S; S.init(MTOK, 1024, G, (int)blockIdx.x); EpiGLU E{(const bf16_t*)(ws + WS_HG), P.in[25], (bf16_t*)(ws + WS_AS)};
        pg8::gemm_phase<EpiGLU, pg8::StaticOrder>(lds, g, S, E); }
    SYNC(7);
    if (IN(8)) REP(8) { pg8::Gemm g{(const bf16_t*)(ws + WS_AS), (const bf16_t*)(ws + WS_WOUT), MTOK, DM, DM};
        pg8::StaticOrder S; S.init(MTOK, DM, G, (int)blockIdx.x); EpiResid<1> E{nullptr, (const bf16_t*)hres, nullptr, (bf16_t*)(ws + WS_XN), (float*)(ws + WS_SMALL) + SM_SS + 16384, 1.0f};
        pg8::gemm_phase<EpiResid<1>, pg8::StaticOrder>(lds, g, S, E); }
    if (IN(8) && hi > 9) xcd_barrier(xbar);
    if (IN(10)) REP(10) { pg8::Gemm g{(const bf16_t*)(ws + WS_XN), (const bf16_t*)(ws + WS_W13B), MTOK, 2 * DFF, DM};
        pg8::StaticOrder S; S.init(MTOK, 2 * DFF, G, (int)blockIdx.x); EpiSwiGLU E{(bf16_t*)(ws + WS_H), (const float*)(ws + WS_SMALL) + SM_SS + 16384}; fill_rstd(S, E.ss, shm);
        pg8::gemm_phase<EpiSwiGLU, pg8::StaticOrder>(lds, g, S, E); }
    SYNC(10);
    if (IN(11)) REP(11) { pg8::Gemm g{(const bf16_t*)(ws + WS_H), (const bf16_t*)(ws + WS_W2B), MTOK, DM, DFF};
        pg8::StaticOrder S; S.init(MTOK, DM, G, (int)blockIdx.x); EpiResid<2> E{nullptr, (const bf16_t*)(ws + WS_XN), hres, nullptr, nullptr, 0.5f};
        pg8::gemm_phase<EpiResid<2>, pg8::StaticOrder>(lds, g, S, E); }
    SYNC(11);
    if (IN(12)) REP(12) norm_rows(hres, P.in[31], nullptr, hres);
}

#ifndef N_LAUNCH_MODE
#define N_LAUNCH_MODE 0
#endif

extern "C" void kernel_launch(void* const* d_in, const int* in_sizes, int n_in, void* d_out, int out_size, void* d_ws, size_t ws_size, hipStream_t stream) {
    static int grid = 0;
    if (grid == 0) {
        int dev = 0, cus = 0, per_cu = 0;
        hipGetDevice(&dev);
        hipDeviceGetAttribute(&cus, hipDeviceAttributeMultiprocessorCount, dev);
        hipFuncSetAttribute((const void*)hymba_fwd, hipFuncAttributeMaxDynamicSharedMemorySize, LDS_BYTES);
        hipOccupancyMaxActiveBlocksPerMultiprocessor(&per_cu, (const void*)hymba_fwd, 512, LDS_BYTES);
        if (per_cu < 1) { fprintf(stderr, "occupancy query says %d blocks/CU\n", per_cu); per_cu = 1; }
        (void)hipGetLastError();
        grid = cus * 1;
        if (n_in != 32 || ws_size < WS_END) fprintf(stderr, "kernel_launch: unexpected n_in %d / ws %zu\n", n_in, ws_size);
    }
    Params p{};
    for (int i = 0; i < 32; ++i) p.in[i] = (const float*)d_in[i];
    p.out = (float*)d_out; p.ws = (unsigned char*)d_ws;
    (void)hipMemsetAsync((unsigned char*)d_ws + WS_SMALL + (size_t)SM_BAR * 4, 0, XCD_BAR_WORDS * 4, stream);
#if N_LAUNCH_MODE == 0
    p.ph_lo = 0; p.ph_hi = NPH;
    { void* args[] = {&p};
      hipError_t e = hipLaunchCooperativeKernel((const void*)hymba_fwd, dim3(grid), dim3(512), args, LDS_BYTES, stream);
      if (e != hipSuccess) fprintf(stderr, "cooperative launch failed: %s (grid %d)\n", hipGetErrorString(e), grid); }
#else
    for (int ph = 0; ph < NPH; ++ph) { p.ph_lo = ph; p.ph_hi = ph + 1;
        void* args[] = {&p};
        hipError_t e = hipLaunchCooperativeKernel((const void*)hymba_fwd, dim3(grid), dim3(512), args, LDS_BYTES, stream);
        if (e != hipSuccess) fprintf(stderr, "launch %d failed: %s (grid %d)\n", ph, hipGetErrorString(e), grid); }
#endif
}
```

```cpp
#include <hip/hip_runtime.h>
#include <hip/hip_cooperative_groups.h>
#include <cstdio>
namespace cg = cooperative_groups;

#define DI __device__ __forceinline__
#define LAS __attribute__((address_space(3)))
#define GAS __attribute__((address_space(1)))
typedef unsigned short bf16_t;
typedef short bf16x8 __attribute__((ext_vector_type(8)));
typedef short s16x4 __attribute__((ext_vector_type(4)));
typedef float f32x4 __attribute__((ext_vector_type(4)));
typedef float f32x16 __attribute__((ext_vector_type(16)));
typedef unsigned u32x4 __attribute__((ext_vector_type(4)));
typedef unsigned u32x2 __attribute__((ext_vector_type(2)));
typedef __bf16 bf16x2_t __attribute__((ext_vector_type(2)));
typedef float f32x2_t __attribute__((ext_vector_type(2)));

constexpr int MTOK = 16384, DM = 2048, DFF = 5632, TT = 2048;
constexpr int NPROJ = 3840;
constexpr int C_KC = 1024, C_VC = 1280, C_KS = 1536, C_VS = 1792, C_KW = 2048, C_VW = 2304, C_GATE = 2560, C_SSM = 2584;
constexpr float EPSN = 1e-6f;
constexpr float NEGF = -1e30f;

constexpr size_t WS_W13A = 0;
constexpr size_t WS_W2A = WS_W13A + 46137344;
constexpr size_t WS_W13B = WS_W2A + 23068672;
constexpr size_t WS_W2B = WS_W13B + 46137344;
constexpr size_t WS_WIN = WS_W2B + 23068672;
constexpr size_t WS_WOUT = WS_WIN + 15728640;
constexpr size_t WS_GLUW = WS_WOUT + 8388608;
constexpr size_t WS_CW1K = WS_GLUW + 2097152;
constexpr size_t WS_CW1V = WS_CW1K + 1048576;
constexpr size_t WS_CW2K = WS_CW1V + 1048576;
constexpr size_t WS_CW2V = WS_CW2K + 32768;
constexpr size_t WS_SMALL = WS_CW2V + 32768;
constexpr size_t WS_KCB = WS_SMALL + 1048576;
constexpr size_t WS_VCBT = WS_KCB + 524288;
constexpr size_t WS_S5END = WS_VCBT + 524288;
constexpr size_t WS_VTS = WS_S5END + 8388608;
constexpr size_t WS_VTW = WS_VTS + 8388608;
constexpr size_t WS_XN = WS_VTW + 8388608;
constexpr size_t WS_H = WS_XN + 67108864;
constexpr size_t WS_PROJ = WS_H;
constexpr size_t WS_AS = WS_H + 125829120;
constexpr size_t WS_HG = WS_XN;
constexpr size_t WS_OUTS = WS_H + 184549376 + 8388608;
constexpr size_t WS_END = WS_OUTS + 33554432;
constexpr int SM_CB1 = 0;
constexpr int SM_AB = 256;
constexpr int SM_BB = 256 + 16384;
constexpr int SM_CTR = 256 + 16384 + 131072;
constexpr int SM_CBP = SM_CTR + 64;
constexpr int SM_SS = SM_CBP + 32768;
constexpr int SM_BAR = 213504;

constexpr int LDS_BYTES = 151552;
constexpr int L_CUR = 149776;
constexpr int NPH = 13;

struct Params { const float* in[32]; float* out; unsigned char* ws; int ph_lo, ph_hi; };

DI unsigned pk2(float a, float b) { f32x2_t v = {a, b}; return __builtin_bit_cast(unsigned, __builtin_convertvector(v, bf16x2_t)); }
DI float bf2f(unsigned x) { return __uint_as_float(x << 16); }
DI float bflo(unsigned w) { return __uint_as_float(w << 16); }
DI float bfhi(unsigned w) { return __uint_as_float(w & 0xffff0000u); }
DI float sigmoidf_(float x) { return __builtin_amdgcn_rcpf(1.0f + __builtin_amdgcn_exp2f(-1.4426950408889634f * x)); }
DI float gelu_tanh(float v) { const float z = 0.7978845608028654f * (v + 0.044715f * v * v * v); const float th = 1.0f - 2.0f * __builtin_amdgcn_rcpf(__builtin_amdgcn_exp2f(2.8853900817779268f * z) + 1.0f); return 0.5f * v * (1.0f + th); }

namespace pg8 {
constexpr int BM = 256, BK = 64, HALF = 128, HTB = HALF * BK * 2, STAGE_BYTES = 8 * HTB, NXCD = 8, WGM = 8;
__host__ __device__ __forceinline__ int lds_byte(int r, int c) { const int st = (r >> 4) * 2 + (c >> 5), rr = r & 15, cc = c & 31, ob = rr * 64 + cc * 2; return st * 1024 + (ob ^ (((ob >> 9) & 1) << 5)); }
__host__ __device__ __forceinline__ void stage_rc(int b, int& R, int& C) { const int st = b / 1024, sb = b % 1024, swz = sb ^ (((sb >> 9) & 1) << 5); R = (st >> 1) * 16 + swz / 64; C = (st & 1) * 32 + (swz % 64) / 2; }
__host__ __device__ __forceinline__ int perm32(int rho) { const int n = rho >> 4, i = rho & 15; return 8 * (i >> 2) + 4 * n + (i & 3); }
struct Unit { int pm, pn; };
struct Gemm { const bf16_t* A; const bf16_t* Bt; int M, N, K; };
struct StaticOrder {
    int nM, nN, nwg, G, c;
    __host__ __device__ void init(int M, int N, int G_, int c_) { nM = M / BM; nN = N / BM; nwg = nM * nN; G = G_; c = c_; }
    __host__ __device__ bool next(int i, Unit& u) const {
        const long L = (long)i * G + c; if (L >= nwg) return false;
        int wgid = (int)L; { const int q = nwg / NXCD, r = nwg % NXCD, xcd = wgid % NXCD, off = wgid / NXCD; wgid = (xcd < r ? xcd * (q + 1) : r * (q + 1) + (xcd - r) * q) + off; }
        const int nig = WGM * nN, gid = wgid / nig, fm = gid * WGM, gsz = (nM - fm) < WGM ? (nM - fm) : WGM;
        u.pm = fm + ((wgid % nig) % gsz); u.pn = (wgid % nig) / gsz; return true;
    }
    __device__ __forceinline__ void a_ready(const Unit&) const {}
    __device__ __forceinline__ void done(const Unit&) const {}
};

template <class Epi, class Sched>
__device__ __forceinline__ void gemm_phase(LAS unsigned char* lds, const Gemm g, const Sched& S, const Epi& E) {
    const int tid = threadIdx.x, wid = __builtin_amdgcn_readfirstlane(tid >> 6), lane = tid & 63, wr = wid >> 2, wc = wid & 3, fr = lane & 15, fq = lane >> 4;
    const int K = g.K, nt = K / BK;
    unsigned voffA[2], voffB[2];
#pragma unroll
    for (int i = 0; i < 2; ++i) { int R, C; stage_rc(tid * 16 + i * 8192, R, C); const int Rb = Epi::PERM ? ((R & ~31) + perm32(R & 31)) : R;
        voffA[i] = (unsigned)(R * K + C) * 2u; voffB[i] = (unsigned)(Rb * K + C) * 2u; }
    const size_t kstep = (size_t)(BK * 2);
    const size_t hstep = (size_t)HALF * K * 2;
    const size_t tstep = 2 * hstep;
    const unsigned ldsw = (unsigned)wid * 1024u;
    const int aoff = lds_byte(wr * 64 + fr, fq * 8), boff = lds_byte(wc * 32 + fr, fq * 8);
#define PG8_SA(b, h) (((b) * 2 + (h)) * HTB)
#define PG8_SB(b, h) ((4 + (b) * 2 + (h)) * HTB)
#define PG8_STAGE(bufoff, gbase, voff) do { _Pragma("unroll") for (int _i = 0; _i < 2; ++_i) \
        __builtin_amdgcn_global_load_lds((const unsigned*)((const char*)(gbase) + (voff)[_i]), (LAS unsigned*)(lds + (bufoff) + ldsw + _i * 8192), 16, 0, 0); } while (0)
#define PG8_LDA(dst, b, h) do { _Pragma("unroll") for (int m = 0; m < 4; ++m) _Pragma("unroll") for (int k = 0; k < 2; ++k) dst[m][k] = *(const LAS bf16x8*)(lds + PG8_SA(b, h) + aoff + m * 2048 + k * 1024); } while (0)
#define PG8_LDB(dst, b, h) do { _Pragma("unroll") for (int n = 0; n < 2; ++n) _Pragma("unroll") for (int k = 0; k < 2; ++k) dst[n][k] = *(const LAS bf16x8*)(lds + PG8_SB(b, h) + boff + n * 2048 + k * 1024); } while (0)
#define PG8_MMA(ai, bj, At, Bt) do { __builtin_amdgcn_s_setprio(1); _Pragma("unroll") for (int m = 0; m < 4; ++m) _Pragma("unroll") for (int n = 0; n < 2; ++n) _Pragma("unroll") for (int k = 0; k < 2; ++k) \
        acc[ai][bj][m][n] = __builtin_amdgcn_mfma_f32_16x16x32_bf16(Bt[n][k], At[m][k], acc[ai][bj][m][n], 0, 0, 0); __builtin_amdgcn_s_setprio(0); } while (0)
#define PG8_WAIT_V(n) asm volatile("s_waitcnt vmcnt(" #n ")" ::: "memory")
#define PG8_WAIT_L(n) asm volatile("s_waitcnt lgkmcnt(" #n ")" ::: "memory")
#define PG8_BAR __builtin_amdgcn_s_barrier()
#define PG8_SCHED __builtin_amdgcn_sched_barrier(0)
    Unit cur, nxt; int ui = 0;
    if (!S.next(0, cur)) return;
    f32x4 acc[2][2][4][2];
#pragma unroll
    for (int a = 0; a < 2; ++a)
#pragma unroll
        for (int b = 0; b < 2; ++b)
#pragma unroll
            for (int m = 0; m < 4; ++m)
#pragma unroll
                for (int n = 0; n < 2; ++n) acc[a][b][m][n] = (f32x4){0.f, 0.f, 0.f, 0.f};
    bf16x8 At[4][2], B0[2][2], B1[2][2];
    const char* cA = (const char*)g.A + (size_t)cur.pm * tstep; const char* cB = (const char*)g.Bt + (size_t)cur.pn * tstep;
    S.a_ready(cur);
    PG8_STAGE(PG8_SB(0, 0), cB, voffB); PG8_STAGE(PG8_SA(0, 0), cA, voffA); PG8_STAGE(PG8_SB(0, 1), cB + hstep, voffB); PG8_STAGE(PG8_SA(0, 1), cA + hstep, voffA);
    if (wr == 1) PG8_BAR;
    PG8_WAIT_V(4); PG8_BAR;
    PG8_STAGE(PG8_SB(1, 0), cB + kstep, voffB); PG8_STAGE(PG8_SA(1, 0), cA + kstep, voffA); PG8_STAGE(PG8_SB(1, 1), cB + hstep + kstep, voffB);
    PG8_WAIT_V(6); PG8_BAR;
    for (;;) {
        const bool has_next = S.next(ui + 1, nxt);
        const char* nA = has_next ? (const char*)g.A + (size_t)nxt.pm * tstep : cA; const char* nB = has_next ? (const char*)g.Bt + (size_t)nxt.pn * tstep : cB;
        for (int t = 0; t < nt; t += 2) {
            const bool last = (t == nt - 2);
            const char* a1 = cA + (size_t)(t + 1) * kstep;
            const char* a2 = last ? nA : cA + (size_t)(t + 2) * kstep; const char* b2 = last ? nB : cB + (size_t)(t + 2) * kstep;
            const char* a3 = a2 + kstep; const char* b3 = b2 + kstep;
            if (last && has_next) S.a_ready(nxt);
            PG8_LDB(B0, 0, 0); PG8_SCHED; PG8_LDA(At, 0, 0); PG8_STAGE(PG8_SA(1, 1), a1 + hstep, voffA);
            PG8_WAIT_L(8); PG8_BAR; PG8_WAIT_L(0); PG8_MMA(0, 0, At, B0); PG8_BAR; PG8_SCHED;
            PG8_LDB(B1, 0, 1); PG8_STAGE(PG8_SB(0, 0), b2, voffB);
            PG8_BAR; PG8_WAIT_L(0); PG8_MMA(0, 1, At, B1); PG8_BAR;
            PG8_LDA(At, 0, 1); PG8_STAGE(PG8_SA(0, 0), a2, voffA);
            PG8_BAR; PG8_WAIT_L(0); PG8_MMA(1, 0, At, B0); PG8_BAR; PG8_SCHED;
            PG8_STAGE(PG8_SB(0, 1), b2 + hstep, voffB);
            PG8_WAIT_V(6); PG8_BAR; PG8_MMA(1, 1, At, B1); PG8_BAR;
            PG8_LDB(B0, 1, 0); PG8_SCHED; PG8_LDA(At, 1, 0); PG8_STAGE(PG8_SA(0, 1), a2 + hstep, voffA);
            PG8_WAIT_L(8); PG8_BAR; PG8_WAIT_L(0); PG8_MMA(0, 0, At, B0); PG8_BAR; PG8_SCHED;
            PG8_LDB(B1, 1, 1); PG8_STAGE(PG8_SB(1, 0), b3, voffB);
            PG8_BAR; PG8_WAIT_L(0); PG8_MMA(0, 1, At, B1); PG8_BAR;
            PG8_LDA(At, 1, 1); PG8_STAGE(PG8_SA(1, 0), a3, voffA);
            PG8_BAR; PG8_WAIT_L(0); PG8_MMA(1, 0, At, B0); PG8_BAR; PG8_SCHED;
            PG8_STAGE(PG8_SB(1, 1), b3 + hstep, voffB);
            PG8_WAIT_V(6); PG8_BAR; PG8_MMA(1, 1, At, B1); PG8_BAR;
        }
        E(acc, cur, wr, wc, fr, fq, ui, lds); S.done(cur);
        if (!has_next) break;
#pragma unroll
        for (int a = 0; a < 2; ++a)
#pragma unroll
            for (int b = 0; b < 2; ++b)
#pragma unroll
                for (int m = 0; m < 4; ++m)
#pragma unroll
                    for (int n = 0; n < 2; ++n) acc[a][b][m][n] = (f32x4){0.f, 0.f, 0.f, 0.f};
        cur = nxt; cA = nA; cB = nB; ++ui;
    }
    PG8_WAIT_V(0);
    if (wr == 0) PG8_BAR;
    PG8_BAR;
#undef PG8_SA
#undef PG8_SB
#undef PG8_STAGE
#undef PG8_LDA
#undef PG8_LDB
#undef PG8_MMA
#undef PG8_WAIT_V
#undef PG8_WAIT_L
#undef PG8_BAR
#undef PG8_SCHED
}
}

struct EpiSwiGLU {
    static constexpr bool PERM = true;
    bf16_t* H; const float* ss;
    DI void operator()(const f32x4 (&acc)[2][2][4][2], const pg8::Unit& u, int wr, int wc, int fr, int fq, int ui, LAS unsigned char* lds) const {
        const int row0 = u.pm * 256 + wr * 64 + fr, col0 = u.pn * 128 + wc * 32 + 8 * fq;
#pragma unroll
        for (int ai = 0; ai < 2; ++ai)
#pragma unroll
            for (int m = 0; m < 4; ++m) {
                const float rs = ss ? ((const LAS float*)(lds + 131072))[ui * 256 + wr * 64 + fr + ai * 128 + m * 16] : 1.0f;
                float v[8];
#pragma unroll
                for (int n = 0; n < 2; ++n)
#pragma unroll
                    for (int j = 0; j < 4; ++j) { const float gt = acc[ai][0][m][n][j] * rs, up = acc[ai][1][m][n][j] * rs; v[n * 4 + j] = gt * up * __builtin_amdgcn_rcpf(1.0f + __builtin_amdgcn_exp2f(-1.4426950408889634f * gt)); }
                u32x4 w; w.x = pk2(v[0], v[1]); w.y = pk2(v[2], v[3]); w.z = pk2(v[4], v[5]); w.w = pk2(v[6], v[7]);
                *(u32x4*)(H + (size_t)(row0 + ai * 128 + m * 16) * DFF + col0) = w;
            }
    }
};
template <int MODE> struct EpiResid {
    static constexpr bool PERM = true;
    const float* basef; const bf16_t* baseb; float* outf; bf16_t* hb; float* ss; float scale;
    DI void operator()(const f32x4 (&acc)[2][2][4][2], const pg8::Unit& u, int wr, int wc, int fr, int fq, int ui, LAS unsigned char* lds) const {
        const int row0 = u.pm * 256 + wr * 64 + fr, col0 = u.pn * 256 + wc * 32 + 8 * fq;
#pragma unroll
        for (int ai = 0; ai < 2; ++ai) {
            f32x4 bf0[4][2], bf1[4][2]; u32x4 bw[4][2];
#pragma unroll
            for (int m = 0; m < 4; ++m)
#pragma unroll
                for (int bj = 0; bj < 2; ++bj) { const size_t off = (size_t)(row0 + ai * 128 + m * 16) * DM + col0 + bj * 128;
                    if (MODE == 0) { bf0[m][bj] = *(const f32x4*)(basef + off); bf1[m][bj] = *(const f32x4*)(basef + off + 4); }
                    else bw[m][bj] = *(const u32x4*)(baseb + off); }
            __builtin_amdgcn_sched_barrier(0);
#pragma unroll
            for (int m = 0; m < 4; ++m) { const int row = row0 + ai * 128 + m * 16; const size_t off = (size_t)row * DM + col0; float rsum = 0.f;
#pragma unroll
                for (int bj = 0; bj < 2; ++bj) {
                    f32x4 b0, b1;
                    if (MODE == 0) { b0 = bf0[m][bj]; b1 = bf1[m][bj]; }
                    else { const u32x4 w = bw[m][bj]; b0 = (f32x4){bflo(w.x), bfhi(w.x), bflo(w.y), bfhi(w.y)}; b1 = (f32x4){bflo(w.z), bfhi(w.z), bflo(w.w), bfhi(w.w)}; }
                    const f32x4 v0 = b0 + acc[ai][bj][m][0] * scale, v1 = b1 + acc[ai][bj][m][1] * scale;
                    if (MODE == 2) { *(f32x4*)(outf + off + bj * 128) = v0; *(f32x4*)(outf + off + bj * 128 + 4) = v1; }
                    else { rsum += (v0[0] * v0[0] + v0[1] * v0[1]) + (v0[2] * v0[2] + v0[3] * v0[3]) + (v1[0] * v1[0] + v1[1] * v1[1]) + (v1[2] * v1[2] + v1[3] * v1[3]);
                        u32x4 w; w.x = pk2(v0[0], v0[1]); w.y = pk2(v0[2], v0[3]); w.z = pk2(v1[0], v1[1]); w.w = pk2(v1[2], v1[3]);
                        *(u32x4*)(hb + off + bj * 128) = w; } }
                if (MODE != 2) { rsum += __shfl_xor(rsum, 16); rsum += __shfl_xor(rsum, 32); if (fq == 0) atomicAdd(ss + row, rsum); } }
        }
    }
};
struct EpiProj {
    static constexpr bool PERM = true;
    bf16_t* O; const float* ss; bf16_t* vts; bf16_t* vtw;
    DI void operator()(const f32x4 (&acc)[2][2][4][2], const pg8::Unit& u, int wr, int wc, int fr, int fq, int ui, LAS unsigned char* lds) const {
        const int row0 = u.pm * 256 + wr * 64 + fr, col0 = u.pn * 256 + wc * 32 + 8 * fq;
        const bool tr = (u.pn == 7) || (u.pn == 9);
#pragma unroll
        for (int ai = 0; ai < 2; ++ai)
#pragma unroll
            for (int m = 0; m < 4; ++m) { const int row = row0 + ai * 128 + m * 16; bf16_t* rowp = O + (size_t)row * NPROJ + col0;
                const float rs = ((const LAS float*)(lds + 131072))[ui * 256 + wr * 64 + fr + ai * 128 + m * 16];
#pragma unroll
                for (int bj = 0; bj < 2; ++bj) { const f32x4 v0 = acc[ai][bj][m][0] * rs, v1 = acc[ai][bj][m][1] * rs;
                    u32x4 w; w.x = pk2(v0[0], v0[1]); w.y = pk2(v0[2], v0[3]); w.z = pk2(v1[0], v1[1]); w.w = pk2(v1[2], v1[3]);
                    if (!tr) *(u32x4*)(rowp + bj * 128) = w;
                    else { bf16_t* vt = (u.pn == 7 ? vts : vtw) + ((size_t)((row >> 11) * 2 + bj) * 128 + wc * 32 + 8 * fq) * TT + (row & 2047);
                        vt[0 * TT] = (bf16_t)(w.x & 0xffffu); vt[1 * TT] = (bf16_t)(w.x >> 16); vt[2 * TT] = (bf16_t)(w.y & 0xffffu); vt[3 * TT] = (bf16_t)(w.y >> 16);
                        vt[4 * TT] = (bf16_t)(w.z & 0xffffu); vt[5 * TT] = (bf16_t)(w.z >> 16); vt[6 * TT] = (bf16_t)(w.w & 0xffffu); vt[7 * TT] = (bf16_t)(w.w >> 16); } } }
    }
};
struct EpiGLU {
    static constexpr bool PERM = true;
    const bf16_t* HG; const float* bias; bf16_t* AS;
    DI void operator()(const f32x4 (&acc)[2][2][4][2], const pg8::Unit& u, int wr, int wc, int fr, int fq, int ui, LAS unsigned char* lds) const {
        const int row0 = u.pm * 256 + wr * 64 + fr, col0 = u.pn * 256 + wc * 32 + 8 * fq;
        f32x4 bs[2][2];
#pragma unroll
        for (int bj = 0; bj < 2; ++bj) { bs[bj][0] = *(const f32x4*)(bias + col0 + bj * 128); bs[bj][1] = *(const f32x4*)(bias + col0 + bj * 128 + 4); }
#pragma unroll
        for (int ai = 0; ai < 2; ++ai) {
            u32x4 hw[4][2];
#pragma unroll
            for (int m = 0; m < 4; ++m)
#pragma unroll
                for (int bj = 0; bj < 2; ++bj) hw[m][bj] = *(const u32x4*)(HG + (size_t)(row0 + ai * 128 + m * 16) * 1024 + col0 + bj * 128);
            __builtin_amdgcn_sched_barrier(0);
#pragma unroll
            for (int m = 0; m < 4; ++m) { const int row = row0 + ai * 128 + m * 16;
#pragma unroll
                for (int bj = 0; bj < 2; ++bj) { const int col = col0 + bj * 128; const u32x4 h = hw[m][bj];
                    const f32x4 v0 = acc[ai][bj][m][0] + bs[bj][0], v1 = acc[ai][bj][m][1] + bs[bj][1];
                    u32x4 w;
                    w.x = pk2(bflo(h.x) * sigmoidf_(v0[0]), bfhi(h.x) * sigmoidf_(v0[1]));
                    w.y = pk2(bflo(h.y) * sigmoidf_(v0[2]), bfhi(h.y) * sigmoidf_(v0[3]));
                    w.z = pk2(bflo(h.z) * sigmoidf_(v1[0]), bfhi(h.z) * sigmoidf_(v1[1]));
                    w.w = pk2(bflo(h.w) * sigmoidf_(v1[2]), bfhi(h.w) * sigmoidf_(v1[3]));
                    *(u32x4*)(AS + (size_t)row * DM + 1024 + col) = w; } }
        }
    }
};

DI void tconv(const float* __restrict__ src, int K, int N, int Npad, bf16_t* __restrict__ dst, int mode, float* tile, const float* __restrict__ gk = nullptr) {
    const int tid = threadIdx.x, ntk = K >> 6, ntn = Npad >> 7, ntile = ntk * ntn;
    f32x4 v[4];
    float gv[4];
#define TC_LOAD(tt) do { const int tk_ = (tt) % ntk, tn_ = (tt) / ntk; \
        _Pragma("unroll") for (int e = 0; e < 4; ++e) { const int i = tid + 512 * e, r = i >> 5, n = tn_ * 128 + (i & 31) * 4, nn = n < N ? n : N - 4; \
            v[e] = __builtin_nontemporal_load((const f32x4*)(src + (size_t)(tk_ * 64 + r) * N + nn)); gv[e] = gk ? gk[tk_ * 64 + r] : 1.0f; } } while (0)
    int t = blockIdx.x;
    if (t < ntile) TC_LOAD(t);
    for (; t < ntile; t += gridDim.x) {
#pragma unroll
        for (int e = 0; e < 4; ++e) { const int i = tid + 512 * e, r = i >> 5, c = (i & 31) * 4; const bool ok = (t / ntk) * 128 + c < N;
            const f32x4 x = ok ? v[e] * gv[e] : (f32x4){0.f, 0.f, 0.f, 0.f};
            tile[r * 129 + c] = x[0]; tile[r * 129 + c + 1] = x[1]; tile[r * 129 + c + 2] = x[2]; tile[r * 129 + c + 3] = x[3]; }
        __syncthreads();
        const int tk = t % ntk, tn = t / ntk;
        if (t + (int)gridDim.x < ntile) TC_LOAD(t + (int)gridDim.x);
        { const int nl = tid >> 2, kg = tid & 3, n = tn * 128 + nl;
          float x[16];
#pragma unroll
          for (int j = 0; j < 16; ++j) x[j] = tile[(kg * 16 + j) * 129 + nl];
          const int drow = mode == 0 ? n : (tn * 256 + nl + (mode == 2 ? 128 : 0));
          u32x4 w0, w1; w0.x = pk2(x[0], x[1]); w0.y = pk2(x[2], x[3]); w0.z = pk2(x[4], x[5]); w0.w = pk2(x[6], x[7]);
          w1.x = pk2(x[8], x[9]); w1.y = pk2(x[10], x[11]); w1.z = pk2(x[12], x[13]); w1.w = pk2(x[14], x[15]);
          u32x4* dp = (u32x4*)(dst + (size_t)drow * K + tk * 64 + kg * 16); dp[0] = w0; dp[1] = w1; }
        __syncthreads();
    }
#undef TC_LOAD
}

DI void norm_rows(const float* src, const float* __restrict__ g, bf16_t* dstb, float* dstf) {
    const int wid = threadIdx.x >> 6, lane = threadIdx.x & 63, stride = gridDim.x * 8;
    for (int row = blockIdx.x * 8 + wid; row < MTOK; row += 2 * stride) {
        const int row2 = row + stride; const bool has2 = row2 < MTOK;
        const f32x4* p = (const f32x4*)(src + (size_t)row * DM); const f32x4* p2 = (const f32x4*)(src + (size_t)(has2 ? row2 : row) * DM);
        f32x4 v[8], w[8]; float ss = 0.f, ss2 = 0.f;
#pragma unroll
        for (int i = 0; i < 8; ++i) { v[i] = __builtin_nontemporal_load(p + lane + 64 * i); w[i] = __builtin_nontemporal_load(p2 + lane + 64 * i); }
#pragma unroll
        for (int i = 0; i < 8; ++i) { ss += v[i][0] * v[i][0] + v[i][1] * v[i][1] + v[i][2] * v[i][2] + v[i][3] * v[i][3]; ss2 += w[i][0] * w[i][0] + w[i][1] * w[i][1] + w[i][2] * w[i][2] + w[i][3] * w[i][3]; }
#pragma unroll
        for (int o = 32; o >= 1; o >>= 1) { ss += __shfl_xor(ss, o); ss2 += __shfl_xor(ss2, o); }
        const float rstd = 1.0f / sqrtf(ss * (1.0f / DM) + EPSN), rstd2 = 1.0f / sqrtf(ss2 * (1.0f / DM) + EPSN);
#pragma unroll
        for (int i = 0; i < 8; ++i) { const f32x4 gg = ((const f32x4*)g)[lane + 64 * i]; const f32x4 y = v[i] * rstd * gg, y2 = w[i] * rstd2 * gg;
            if (dstb) { u32x2 o; o.x = pk2(y[0], y[1]); o.y = pk2(y[2], y[3]); *(u32x2*)(dstb + (size_t)row * DM + (lane + 64 * i) * 4) = o;
                        if (has2) { u32x2 o2; o2.x = pk2(y2[0], y2[1]); o2.y = pk2(y2[2], y2[3]); *(u32x2*)(dstb + (size_t)row2 * DM + (lane + 64 * i) * 4) = o2; } }
            else { __builtin_nontemporal_store(y, (f32x4*)(dstf + (size_t)row * DM) + lane + 64 * i); if (has2) __builtin_nontemporal_store(y2, (f32x4*)(dstf + (size_t)row2 * DM) + lane + 64 * i); } }
    }
}

DI void phase_prep(const Params& P, unsigned char* smem) {
    unsigned char* ws = P.ws; float* tile = (float*)smem; const int tid = threadIdx.x;
    float* sm = (float*)(ws + WS_SMALL);
    if (blockIdx.x < 8) { const int idx = blockIdx.x * 512 + tid, grp = idx >> 6;
        const float step = expf(P.in[18][grp]), lre = P.in[16][idx], lim = P.in[17][idx];
        const float mag = expf(lre * step), ar = mag * cosf(lim * step), ai = mag * sinf(lim * step);
        const float nr = ar - 1.0f, ni = ai, den = lre * lre + lim * lim, fre = (nr * lre + ni * lim) / den, fim = (ni * lre - nr * lim) / den;
        f32x4 brv[4], biv[4];
#pragma unroll
        for (int k = 0; k < 4; ++k) { brv[k] = *(const f32x4*)(P.in[19] + idx * 16 + 4 * k); biv[k] = *(const f32x4*)(P.in[20] + idx * 16 + 4 * k); }
        bf16_t* tb = (bf16_t*)(sm + SM_BB); const int p = idx & 63;
        unsigned hre[16], lre_[16], him[16], lim_[16];
#pragma unroll
        for (int h = 0; h < 16; ++h) { const float br = brv[h >> 2][h & 3], bi = biv[h >> 2][h & 3];
            const float vre = fre * br - fim * bi, vim = fre * bi + fim * br;
            hre[h] = pk2(vre, 0.f) & 0xffffu; lre_[h] = pk2(vre - bf2f(hre[h]), 0.f) & 0xffffu;
            him[h] = pk2(vim, 0.f) & 0xffffu; lim_[h] = pk2(vim - bf2f(him[h]), 0.f) & 0xffffu; }
        { u32x4* d = (u32x4*)(tb + (grp * 128 + p) * 32);
          d[0] = (u32x4){hre[0] | (hre[1] << 16), hre[2] | (hre[3] << 16), hre[4] | (hre[5] << 16), hre[6] | (hre[7] << 16)};
          d[1] = (u32x4){hre[8] | (hre[9] << 16), hre[10] | (hre[11] << 16), hre[12] | (hre[13] << 16), hre[14] | (hre[15] << 16)};
          d[2] = (u32x4){lre_[0] | (lre_[1] << 16), lre_[2] | (lre_[3] << 16), lre_[4] | (lre_[5] << 16), lre_[6] | (lre_[7] << 16)};
          d[3] = (u32x4){lre_[8] | (lre_[9] << 16), lre_[10] | (lre_[11] << 16), lre_[12] | (lre_[13] << 16), lre_[14] | (lre_[15] << 16)};
          u32x4* e = (u32x4*)(tb + (grp * 128 + 64 + p) * 32);
          e[0] = (u32x4){him[0] | (him[1] << 16), him[2] | (him[3] << 16), him[4] | (him[5] << 16), him[6] | (him[7] << 16)};
          e[1] = (u32x4){him[8] | (him[9] << 16), him[10] | (him[11] << 16), him[12] | (him[13] << 16), him[14] | (him[15] << 16)};
          e[2] = (u32x4){lim_[0] | (lim_[1] << 16), lim_[2] | (lim_[3] << 16), lim_[4] | (lim_[5] << 16), lim_[6] | (lim_[7] << 16)};
          e[3] = (u32x4){lim_[8] | (lim_[9] << 16), lim_[10] | (lim_[11] << 16), lim_[12] | (lim_[13] << 16), lim_[14] | (lim_[15] << 16)}; }
        float pr = ar, pi = ai;
        for (int s = 0; s < 6; ++s) { const float nr2 = pr * pr - pi * pi, ni2 = 2.0f * pr * pi; pr = nr2; pi = ni2; }
        sm[SM_AB + idx * 4 + 0] = ar; sm[SM_AB + idx * 4 + 1] = ai; sm[SM_AB + idx * 4 + 2] = pr; sm[SM_AB + idx * 4 + 3] = pi; }
    { const int which = blockIdx.x >> 7, chunk = blockIdx.x & 127; const float* pe = P.in[which ? 11 : 7]; const float* w1 = P.in[which ? 12 : 8];
      if (blockIdx.x < 256) {
        const int n = tid & 127, sub = tid >> 7; float s = 0.f;
#pragma unroll
        for (int j = 0; j < 8; ++j) { const int k = chunk * 32 + sub * 8 + j; s += pe[k] * w1[(size_t)k * 128 + n]; }
        tile[tid] = s; __syncthreads();
        if (tid < 128) sm[SM_CBP + (which * 128 + chunk) * 128 + tid] = (tile[tid] + tile[tid + 128]) + (tile[tid + 256] + tile[tid + 384]);
        __syncthreads(); } }
    if (blockIdx.x == 10 && tid == 0) { ((int*)(sm + SM_CTR))[0] = 0; ((int*)(sm + SM_CTR))[1] = 0; }
    for (int i = blockIdx.x * 512 + tid; i < 32768; i += gridDim.x * 512) sm[SM_SS + i] = 0.f;
    { u32x4* z = (u32x4*)(ws + WS_KCB); const u32x4 zero = {0u, 0u, 0u, 0u};
      for (int i = blockIdx.x * 512 + tid; i < 65536; i += gridDim.x * 512) z[i] = zero; }
    norm_rows(P.in[0], P.in[1], (bf16_t*)(ws + WS_XN), nullptr);
    tconv(P.in[2], DM, DFF, DFF, (bf16_t*)(ws + WS_W13A), 1, tile);
    tconv(P.in[3], DM, DFF, DFF, (bf16_t*)(ws + WS_W13A), 2, tile);
    tconv(P.in[4], DFF, DM, DM, (bf16_t*)(ws + WS_W2A), 0, tile);
    tconv(P.in[6], DM, 3608, NPROJ, (bf16_t*)(ws + WS_WIN), 0, tile, P.in[5]);
    tconv(P.in[8], 4096, 128, 128, (bf16_t*)(ws + WS_CW1K), 0, tile);
    tconv(P.in[12], 4096, 128, 128, (bf16_t*)(ws + WS_CW1V), 0, tile);
    tconv(P.in[10], 128, 128, 128, (bf16_t*)(ws + WS_CW2K), 0, tile);
    tconv(P.in[14], 128, 128, 128, (bf16_t*)(ws + WS_CW2V), 0, tile);
    tconv(P.in[24], 1024, 1024, 1024, (bf16_t*)(ws + WS_GLUW), 0, tile);
    tconv(P.in[26], DM, DM, DM, (bf16_t*)(ws + WS_WOUT), 0, tile);
    tconv(P.in[28], DM, DFF, DFF, (bf16_t*)(ws + WS_W13B), 1, tile, P.in[27]);
    tconv(P.in[29], DM, DFF, DFF, (bf16_t*)(ws + WS_W13B), 2, tile, P.in[27]);
    tconv(P.in[30], DFF, DM, DM, (bf16_t*)(ws + WS_W2B), 0, tile);
}

DI void compress_item(const Params& P, int item, unsigned char* smem) {
    unsigned char* ws = P.ws; const int tid = threadIdx.x, wid = tid >> 6, lane = tid & 63, r = lane & 15, q = lane >> 4;
    const int which = item / 127, rt = item % 127;
    const bf16_t* proj = (const bf16_t*)(ws + WS_PROJ);
    const bf16_t* w1t = (const bf16_t*)(ws + (which ? WS_CW1V : WS_CW1K));
    const bf16_t* w2t = (const bf16_t*)(ws + (which ? WS_CW2V : WS_CW2K));
    const float* cb1 = (const float*)(ws + WS_SMALL) + SM_CB1 + which * 128;
    float* part = (float*)smem;
    bf16_t* hid = (bf16_t*)(smem + 65536);
    const int grow = rt * 16 + r, bg = grow / 127, c = grow % 127, b = bg >> 1, g = bg & 1;
    const bf16_t* arow = proj + (size_t)(b * TT + 16 * c) * NPROJ + (which ? C_VC : C_KC) + g * 128;
    f32x4 acc[8];
#pragma unroll
    for (int ct = 0; ct < 8; ++ct) acc[ct] = (f32x4){0.f, 0.f, 0.f, 0.f};
    bf16x8 fa[2], fb[2][8];
#define CP_LOAD(buf, s_) do { const int kabs_ = 512 * wid + 32 * (s_) + 8 * q; fa[buf] = *(const bf16x8*)(arow + (size_t)(kabs_ >> 7) * NPROJ + (kabs_ & 127)); \
        _Pragma("unroll") for (int ct = 0; ct < 8; ++ct) fb[buf][ct] = *(const bf16x8*)(w1t + (size_t)(ct * 16 + r) * 4096 + kabs_); } while (0)
    CP_LOAD(0, 0);
#pragma unroll
    for (int s = 0; s < 16; ++s) {
        if (s + 1 < 16) CP_LOAD((s + 1) & 1, s + 1);
        __builtin_amdgcn_sched_barrier(0);
#pragma unroll
        for (int ct = 0; ct < 8; ++ct) acc[ct] = __builtin_amdgcn_mfma_f32_16x16x32_bf16(fa[s & 1], fb[s & 1][ct], acc[ct], 0, 0, 0);
        __builtin_amdgcn_sched_barrier(0);
    }
#undef CP_LOAD
#pragma unroll
    for (int ct = 0; ct < 8; ++ct)
#pragma unroll
        for (int j = 0; j < 4; ++j) part[(wid * 16 + 4 * q + j) * 128 + ct * 16 + r] = acc[ct][j];
    __syncthreads();
    { const int row = tid >> 5, c4 = (tid & 31) * 4; f32x4 s = *(const f32x4*)(cb1 + c4);
#pragma unroll
      for (int w = 0; w < 8; ++w) s += *(const f32x4*)(part + (w * 16 + row) * 128 + c4);
      u32x2 o; o.x = pk2(gelu_tanh(s[0]), gelu_tanh(s[1])); o.y = pk2(gelu_tanh(s[2]), gelu_tanh(s[3]));
      *(u32x2*)(hid + row * 136 + c4) = o; }
    __syncthreads();
    { f32x4 a2 = {0.f, 0.f, 0.f, 0.f};
#pragma unroll
      for (int s = 0; s < 4; ++s) { const bf16x8 a = *(const bf16x8*)(hid + r * 136 + 32 * s + 8 * q);
          const bf16x8 bb = *(const bf16x8*)(w2t + (size_t)(16 * wid + r) * 128 + 32 * s + 8 * q);
          a2 = __builtin_amdgcn_mfma_f32_16x16x32_bf16(a, bb, a2, 0, 0, 0); }
      bf16_t* kcb = (bf16_t*)(ws + WS_KCB); bf16_t* vcbt = (bf16_t*)(ws + WS_VCBT);
#pragma unroll
      for (int j = 0; j < 4; ++j) { const int gr = rt * 16 + 4 * q + j, bg2 = gr / 127, c2 = gr % 127, col = 16 * wid + r;
          const bf16_t v = (bf16_t)(pk2(a2[j], 0.f) & 0xffffu);
          if (which == 0) kcb[(size_t)(bg2 * 128 + c2) * 128 + col] = v; else vcbt[(size_t)(bg2 * 128 + col) * 128 + c2] = v; } }
    __syncthreads();
}

DI void s5_bu16(const bf16x8 ub, const bf16x8 (&af)[8], float* buf, int r, int q) {
#pragma unroll
    for (int pt = 0; pt < 8; ++pt) { f32x4 d = {0.f, 0.f, 0.f, 0.f}; d = __builtin_amdgcn_mfma_f32_16x16x32_bf16(af[pt], ub, d, 0, 0, 0);
#pragma unroll
        for (int j = 0; j < 4; ++j) buf[(16 * pt + 4 * q + j) * 17 + r] = d[j]; }
}
DI void s5_pass1_item(const Params& P, int bitem, unsigned char* smem) {
    int tid_ = threadIdx.x; asm volatile("" : "+v"(tid_));
    unsigned char* ws = P.ws; const int tid = tid_, wid = tid >> 6, lane = tid & 63, r = lane & 15, q = lane >> 4;
    const int item = bitem * 8 + wid, ch = item & 31, grp = (item >> 5) & 63, b = item >> 11;
    const bf16_t* proj = (const bf16_t*)(ws + WS_PROJ); const float* sm = (const float*)(ws + WS_SMALL);
    float* buf = (float*)smem + wid * 2176;
    const bf16_t* tb = (const bf16_t*)(sm + SM_BB);
    bf16x8 af[8];
#pragma unroll
    for (int pt = 0; pt < 8; ++pt) af[pt] = *(const bf16x8*)(tb + (grp * 128 + 16 * pt + r) * 32 + 8 * q);
    const f32x4 ab = *(const f32x4*)(sm + SM_AB + (grp * 64 + lane) * 4);
    const bf16_t* ubase = proj + (size_t)(b * TT + ch * 64) * NPROJ + C_SSM + grp * 16;
    float xr = 0.f, xi = 0.f;
    bf16x8 ubs[4];
#pragma unroll
    for (int sub = 0; sub < 4; ++sub) ubs[sub] = *(const bf16x8*)(ubase + (size_t)(sub * 16 + r) * NPROJ + 8 * (q & 1));
#pragma unroll
    for (int sub = 0; sub < 4; ++sub) {
        s5_bu16(ubs[sub], af, buf, r, q);
        asm volatile("s_waitcnt lgkmcnt(0)" ::: "memory");
#pragma unroll
        for (int tt = 0; tt < 16; ++tt) { const float bur = buf[lane * 17 + tt], bui = buf[(64 + lane) * 17 + tt];
            const float nxr = ab[0] * xr - ab[1] * xi + bur, nxi = ab[0] * xi + ab[1] * xr + bui; xr = nxr; xi = nxi; }
        asm volatile("s_waitcnt lgkmcnt(0)" ::: "memory");
    }
    f32x2_t e = {xr, xi};
    *(f32x2_t*)(ws + WS_S5END + ((size_t)((b * 64 + grp) * 32 + ch) * 64 + lane) * 8) = e;
}

DI void vtrans_item(const Params& P, int item, unsigned char* smem) {
    unsigned char* ws = P.ws; const int tid = threadIdx.x;
    const int tokblk = item >> 3, cseg = item & 7, tok0 = tokblk * 64, b = tok0 >> 11, t0 = tok0 & 2047;
    const int col = (cseg < 4 ? C_VS + cseg * 64 : C_VW + (cseg - 4) * 64), g = (cseg & 3) >> 1, d0 = (cseg & 1) * 64;
    const bf16_t* proj = (const bf16_t*)(ws + WS_PROJ);
    bf16_t* dst = (bf16_t*)(ws + (cseg < 4 ? WS_VTS : WS_VTW)) + (size_t)((b * 2 + g) * 128 + d0) * TT + t0;
    bf16_t* tl = (bf16_t*)smem;
    { const int r = tid >> 3, sg = tid & 7; *(u32x4*)(tl + r * 72 + sg * 8) = *(const u32x4*)(proj + (size_t)(tok0 + r) * NPROJ + col + sg * 8); }
    __syncthreads();
    { const int d = tid >> 3, tsg = tid & 7; unsigned v[8];
#pragma unroll
      for (int j = 0; j < 8; ++j) v[j] = tl[(tsg * 8 + j) * 72 + d];
      u32x4 w; w.x = v[0] | (v[1] << 16); w.y = v[2] | (v[3] << 16); w.z = v[4] | (v[5] << 16); w.w = v[6] | (v[7] << 16);
      *(u32x4*)(dst + (size_t)d * TT + tsg * 8) = w; }
    __syncthreads();
}

DI void s5_pass3_item(const Params& P, int bitem, unsigned char* smem) {
    int tid_ = threadIdx.x; asm volatile("" : "+v"(tid_));
    unsigned char* ws = P.ws; const int tid = tid_, wid = tid >> 6, lane = tid & 63, r = lane & 15, q = lane >> 4;
    const int item = bitem * 8 + wid, ch = item & 31, grp = (item >> 5) & 63, b = item >> 11;
    const bf16_t* proj = (const bf16_t*)(ws + WS_PROJ); const float* sm = (const float*)(ws + WS_SMALL);
    float* xs = (float*)smem + wid * 2176;
    bf16_t* HG = (bf16_t*)(ws + WS_HG);
    const bf16_t* tb = (const bf16_t*)(sm + SM_BB);
    bf16x8 af[8];
#pragma unroll
    for (int pt = 0; pt < 8; ++pt) af[pt] = *(const bf16x8*)(tb + (grp * 128 + 16 * pt + r) * 32 + 8 * q);
    const f32x4 ab = *(const f32x4*)(sm + SM_AB + (grp * 64 + lane) * 4);
    float cB[32];
    { const float* cre = P.in[21] + (size_t)(grp * 16 + r) * 64; const float* cim = P.in[22] + (size_t)(grp * 16 + r) * 64;
#pragma unroll
      for (int i = 0; i < 32; ++i) { const int k = 4 * i + q; cB[i] = (i < 16) ? cre[k] : -cim[k - 64]; } }
    const float dsk = P.in[23][grp * 16 + r];
    const bf16_t* ubase = proj + (size_t)(b * TT + ch * 64) * NPROJ + C_SSM + grp * 16;
    bf16x8 ubs[4]; unsigned short uvs[4][4];
#pragma unroll
    for (int sub = 0; sub < 4; ++sub) { ubs[sub] = *(const bf16x8*)(ubase + (size_t)(sub * 16 + r) * NPROJ + 8 * (q & 1));
#pragma unroll
        for (int j = 0; j < 4; ++j) uvs[sub][j] = ubase[(size_t)(sub * 16 + 4 * q + j) * NPROJ + r]; }
    float xr = 0.f, xi = 0.f;
    {
      const f32x2_t* e = (const f32x2_t*)(ws + WS_S5END) + (size_t)((b * 64 + grp) * 32) * 64 + lane;
      f32x2_t ev[31];
#pragma unroll
      for (int j = 0; j < 31; ++j) ev[j] = e[(j < ch ? j : 0) * 64];
#pragma unroll
      for (int j = 0; j < 31; ++j) { const float ex = j < ch ? ev[j][0] : 0.f, ey = j < ch ? ev[j][1] : 0.f;
          const float ncr = ab[2] * xr - ab[3] * xi + ex, nci = ab[2] * xi + ab[3] * xr + ey; xr = j < ch ? ncr : xr; xi = j < ch ? nci : xi; } }
#pragma unroll
    for (int sub = 0; sub < 4; ++sub) {
        s5_bu16(ubs[sub], af, xs, r, q);
        float uv[4];
#pragma unroll
        for (int j = 0; j < 4; ++j) uv[j] = bf2f(uvs[sub][j]);
        asm volatile("s_waitcnt lgkmcnt(0)" ::: "memory");
#pragma unroll
        for (int tt = 0; tt < 16; ++tt) { const float bur = xs[lane * 17 + tt], bui = xs[(64 + lane) * 17 + tt];
            const float nxr = ab[0] * xr - ab[1] * xi + bur, nxi = ab[0] * xi + ab[1] * xr + bui; xr = nxr; xi = nxi;
            xs[lane * 17 + tt] = xr; xs[(64 + lane) * 17 + tt] = xi; }
        asm volatile("s_waitcnt lgkmcnt(0)" ::: "memory");
        f32x4 ya[4];
#pragma unroll
        for (int j = 0; j < 4; ++j) ya[j] = (f32x4){0.f, 0.f, 0.f, 0.f};
#pragma unroll
        for (int i = 0; i < 32; ++i) { const float a = xs[(4 * i + q) * 17 + r]; ya[i & 3] = __builtin_amdgcn_mfma_f32_16x16x4f32(a, cB[i], ya[i & 3], 0, 0, 0); }
        const f32x4 y = (ya[0] + ya[1]) + (ya[2] + ya[3]);
#pragma unroll
        for (int j = 0; j < 4; ++j) { const int tl = sub * 16 + 4 * q + j; const float v = y[j] + dsk * uv[j];
            HG[(size_t)(b * TT + ch * 64 + tl) * 1024 + grp * 16 + r] = (bf16_t)(pk2(gelu_tanh(v), 0.f) & 0xffffu); }
        asm volatile("s_waitcnt lgkmcnt(0)" ::: "memory");
    }
}

DI float xor32_max(float x) { const auto r_ = __builtin_amdgcn_permlane32_swap(__float_as_uint(x), __float_as_uint(x), false, false); return fmaxf(__uint_as_float(r_[0]), __uint_as_float(r_[1])); }
DI float xor32_sum(float x) { const auto r_ = __builtin_amdgcn_permlane32_swap(__float_as_uint(x), __float_as_uint(x), false, false); return __uint_as_float(r_[0]) + __uint_as_float(r_[1]); }
#define MFMA32(a, b, c) __builtin_amdgcn_mfma_f32_32x32x16_bf16((a), (b), (c), 0, 0, 0)
DI bf16x8 ld2x4(const bf16_t* p0) { const s16x4 a = *(const s16x4*)p0, b = *(const s16x4*)(p0 + 8); return __builtin_shufflevector(a, b, 0, 1, 2, 3, 4, 5, 6, 7); }
DI bf16x8 packp(const f32x16& x, int s) { u32x4 p; p.x = pk2(x[8 * s], x[8 * s + 1]); p.y = pk2(x[8 * s + 2], x[8 * s + 3]); p.z = pk2(x[8 * s + 4], x[8 * s + 5]); p.w = pk2(x[8 * s + 6], x[8 * s + 7]); return __builtin_bit_cast(bf16x8, p); }
DI int crow(int i, int hh) { return (i & 3) + 8 * (i >> 2) + 4 * hh; }

constexpr int A_STG = 0;
constexpr int A_BUF = 34816, A_VOFF = 17408;
constexpr int A_IMPM = 69632, A_IMPS = A_IMPM + 33792, A_IMPV = A_IMPS + 33792, A_LUT = A_IMPV + 8192, A_SELM = A_LUT + 4096;
DI bf16x8 lds2x4(const unsigned char* p) { const s16x4 a = *(const s16x4*)p, b = *(const s16x4*)(p + 16); return __builtin_shufflevector(a, b, 0, 1, 2, 3, 4, 5, 6, 7); }

constexpr float QK_C1 = 0.08838834764831845f * 1.4426950408889634f;
template <int MODE, bool FAR>
DI void attn_tile(const unsigned char* kl  , const unsigned char* vl  ,
                  int k0, int tq, int r, int hh, bool bit, const bf16x8 (&qf)[8], const float* lutH, f32x16 (&o)[4], float& m, float& l) {
    f32x16 s;
#pragma unroll
    for (int i = 0; i < 16; ++i) s[i] = 0.f;
    const unsigned char* kp = kl + r * 272 + 16 * hh;
#pragma unroll
    for (int kk = 0; kk < 8; ++kk) { const bf16x8 a = *(const bf16x8*)(kp + 32 * kk); s = MFMA32(a, qf[kk], s); }
    float tmax = NEGF;
    if (FAR) {
        const float b31 = lutH[255];
#pragma unroll
        for (int i = 0; i < 16; ++i) { const float v = s[i] * QK_C1 + b31; s[i] = (MODE == 0 && !bit) ? NEGF : v; tmax = fmaxf(tmax, s[i]); }
    } else {
#pragma unroll
        for (int i = 0; i < 16; ++i) { const int dist = tq - (k0 + crow(i, hh));
            const bool valid = MODE == 0 ? (bit && dist >= 0) : (dist >= 0 && dist < 512);
            const int di = dist < 0 ? 0 : (dist > 255 ? 255 : dist);
            const float v = s[i] * QK_C1 + lutH[di];
            s[i] = valid ? v : NEGF; tmax = fmaxf(tmax, s[i]); }
    }
    tmax = xor32_max(tmax);
    const float mnew = fmaxf(m, tmax);
    if (__ballot(mnew != m) != 0ull) {
        const float alpha = __builtin_amdgcn_exp2f(m - mnew);
        l *= alpha; m = mnew;
#pragma unroll
        for (int dt = 0; dt < 4; ++dt)
#pragma unroll
            for (int i = 0; i < 16; ++i) o[dt][i] *= alpha;
    }
    float psum = 0.f;
    if (FAR) {
#pragma unroll
        for (int i = 0; i < 16; ++i) { const float p = __builtin_amdgcn_exp2f(s[i] - mnew); s[i] = p; psum += p; }
    } else {
#pragma unroll
        for (int i = 0; i < 16; ++i) { const float p = (s[i] > -1e29f) ? __builtin_amdgcn_exp2f(s[i] - mnew) : 0.f; s[i] = p; psum += p; }
    }
    psum = xor32_sum(psum);
    l += psum;
    const unsigned char* vp = vl + r * 136 + 8 * hh;
#pragma unroll
    for (int s2 = 0; s2 < 2; ++s2) { const bf16x8 pb = packp(s, s2);
#pragma unroll
        for (int dt = 0; dt < 4; ++dt) { const bf16x8 a = lds2x4(vp + dt * (32 * 136) + 32 * s2); o[dt] = MFMA32(a, pb, o[dt]); } }
}

template <int MODE>
DI void attn_tile64_far(const unsigned char* bp  , int r, int hh, bool bit, const bf16x8 (&qf)[8], const float* lutH, f32x16 (&o)[4], float& m, float& l) {
    f32x16 s0, s1;
#pragma unroll
    for (int i = 0; i < 16; ++i) { s0[i] = 0.f; s1[i] = 0.f; }
    const unsigned char* kp = bp + r * 272 + 16 * hh;
#pragma unroll
    for (int kk = 0; kk < 8; ++kk) { const bf16x8 a0 = *(const bf16x8*)(kp + 32 * kk), a1 = *(const bf16x8*)(kp + 32 * 272 + 32 * kk); s0 = MFMA32(a0, qf[kk], s0); s1 = MFMA32(a1, qf[kk], s1); }
    const float b31 = lutH[255];
    float tmax = NEGF;
#pragma unroll
    for (int i = 0; i < 16; ++i) { const float v0 = s0[i] * QK_C1 + b31, v1 = s1[i] * QK_C1 + b31;
        s0[i] = (MODE == 0 && !bit) ? NEGF : v0; s1[i] = (MODE == 0 && !bit) ? NEGF : v1; tmax = fmaxf(tmax, fmaxf(s0[i], s1[i])); }
    tmax = xor32_max(tmax);
    const float mnew = fmaxf(m, tmax);
    if (__ballot(mnew != m) != 0ull) {
        const float alpha = __builtin_amdgcn_exp2f(m - mnew);
        l *= alpha; m = mnew;
#pragma unroll
        for (int dt = 0; dt < 4; ++dt)
#pragma unroll
            for (int i = 0; i < 16; ++i) o[dt][i] *= alpha;
    }
    float psum = 0.f;
#pragma unroll
    for (int i = 0; i < 16; ++i) { const float p0 = __builtin_amdgcn_exp2f(s0[i] - mnew), p1 = __builtin_amdgcn_exp2f(s1[i] - mnew); s0[i] = p0; s1[i] = p1; psum += p0 + p1; }
    l += xor32_sum(psum);
    const unsigned char* vp = bp + A_VOFF + r * 136 + 8 * hh;
#pragma unroll
    for (int s2 = 0; s2 < 2; ++s2) { const bf16x8 pb0 = packp(s0, s2), pb1 = packp(s1, s2);
#pragma unroll
        for (int dt = 0; dt < 4; ++dt) { const bf16x8 a0 = lds2x4(vp + dt * (32 * 136) + 32 * s2), a1 = lds2x4(vp + dt * (32 * 136) + 64 + 32 * s2);
            o[dt] = MFMA32(a0, pb0, o[dt]); o[dt] = MFMA32(a1, pb1, o[dt]); } }
}

template <int MODE>
DI void attn_branch(unsigned char* smem, const bf16_t* kb  , const bf16_t* vt  , unsigned need, unsigned mymask,
                    int t0w, int tq, int r, int hh, const bf16x8 (&qf)[8], const float* lutH, f32x16 (&o)[4], float& m, float& l) {
    int tid = threadIdx.x; asm volatile("" : "+v"(tid));
    if (need == 0u) return;
    u32x4 kreg[2], vreg[2];
    const int krow0 = tid >> 4, kcc = tid & 15, vd0 = tid >> 3, vcc = tid & 7;
#define AB_LOAD(j) do { _Pragma("unroll") for (int e = 0; e < 2; ++e) { \
        kreg[e] = *(const u32x4*)(kb + (size_t)(64 * (j) + krow0 + 32 * e) * NPROJ + kcc * 8); \
        vreg[e] = *(const u32x4*)(vt + (size_t)(vd0 + 64 * e) * TT + 64 * (j) + vcc * 8); } } while (0)
#define AB_STORE(buf) do { unsigned char* bp_ = smem + A_STG + (buf) * A_BUF; _Pragma("unroll") for (int e = 0; e < 2; ++e) { \
        *(u32x4*)(bp_ + (krow0 + 32 * e) * 272 + kcc * 16) = kreg[e]; \
        unsigned char* vp_ = bp_ + A_VOFF + (vd0 + 64 * e) * 136 + vcc * 16; \
        *(u32x2*)vp_ = (u32x2){vreg[e].x, vreg[e].y}; *(u32x2*)(vp_ + 8) = (u32x2){vreg[e].z, vreg[e].w}; } } while (0)
    int j = __builtin_ctz(need); need &= need - 1u;
    AB_LOAD(j); AB_STORE(0);
    __syncthreads();
    int n = 0;
    for (;;) {
        const bool has_next = need != 0u;
        int jn = 0;
        if (has_next) { jn = __builtin_ctz(need); need &= need - 1u; AB_LOAD(jn); }
        const unsigned char* bp = smem + A_STG + (n & 1) * A_BUF;
        const bool bit = MODE == 0 ? ((mymask >> j) & 1u) : true;
        const bool any = MODE == 0 ? (__ballot(bit) != 0ull) : true;
        const bool far64 = any && (64 * j + 63 + 128 <= t0w) && (MODE == 0 || 64 * j >= t0w + 31 - 511);
        if (far64) attn_tile64_far<MODE>(bp, r, hh, bit, qf, lutH, o, m, l);
        else {
#pragma unroll 1
        for (int half = 0; half < 2; ++half) { const int k0 = 64 * j + 32 * half;
            bool act = any && (k0 <= t0w + 31);
            if (MODE == 1) act = act && (k0 + 31 + 511 >= t0w);
            const bool far = (k0 + 31 + 128 <= t0w) && (MODE == 0 || k0 >= t0w + 31 - 511);
            if (act) { if (far) attn_tile<MODE, true>(bp + half * (32 * 272), bp + A_VOFF + half * 64, k0, tq, r, hh, bit, qf, lutH, o, m, l);
                       else attn_tile<MODE, false>(bp + half * (32 * 272), bp + A_VOFF + half * 64, k0, tq, r, hh, bit, qf, lutH, o, m, l); } }
        }
        if (has_next) AB_STORE((n + 1) & 1);
        __syncthreads();
        if (!has_next) break;
        j = jn; ++n;
    }
#undef AB_LOAD
#undef AB_STORE
}

DI void attn_item(const Params& P, int item, unsigned char* smem) {
    int tid_ = threadIdx.x; asm volatile("" : "+v"(tid_));
    unsigned char* ws = P.ws; const int tid = tid_, wid = tid >> 6, lane = tid & 63, r = lane & 31, hh = lane >> 5;
    const int bg = item & 15, qt = 31 - (item >> 4), b = bg >> 1, g = bg & 1, t0 = qt * 64;
    const int hg = wid >> 1, t0w = t0 + 32 * (wid & 1), tq = t0w + r, head = g * 4 + hg, qloc = 32 * (wid & 1) + r;
    if (__builtin_amdgcn_readfirstlane(wid) < 4) __builtin_amdgcn_s_setprio(3); else __builtin_amdgcn_s_setprio(0);
    const bf16_t* proj = (const bf16_t*)(ws + WS_PROJ);
    float* outs = (float*)(ws + WS_OUTS) + ((size_t)blockIdx.x * 8 + wid) * 4096;
    float* impM = (float*)(smem + A_IMPM); float* impS = (float*)(smem + A_IMPS); float* impv = (float*)(smem + A_IMPV);
    float* lut = (float*)(smem + A_LUT); unsigned* selm = (unsigned*)(smem + A_SELM);
    for (int i = tid; i < 1024; i += 512) { const int h4 = i >> 8, n = i & 255; int bk;
        if (n < 16) bk = n; else { bk = 16 + (int)(logf((float)n / 16.0f) / 2.0794415416798357f * 16.0f); bk = bk > 31 ? 31 : bk; }
        lut[i] = P.in[15][bk * 8 + g * 4 + h4] * 1.4426950408889634f; }
    { const bf16_t* kcb = (const bf16_t*)(ws + WS_KCB) + (size_t)bg * 16384; const bf16_t* vcbt = (const bf16_t*)(ws + WS_VCBT) + (size_t)bg * 16384;
#pragma unroll
      for (int e = 0; e < 4; ++e) { const int id = tid + 512 * e, row = id >> 4, cc = id & 15;
          *(u32x4*)(smem + A_STG + row * 272 + cc * 16) = *(const u32x4*)(kcb + row * 128 + cc * 8);
          *(u32x4*)(smem + A_STG + A_BUF + row * 272 + cc * 16) = *(const u32x4*)(vcbt + row * 128 + cc * 8); } }
    bf16x8 qf[8];
    { const bf16_t* qrow = proj + (size_t)(b * TT + tq) * NPROJ + head * 128 + 8 * hh;
#pragma unroll
      for (int kk = 0; kk < 8; ++kk) qf[kk] = *(const bf16x8*)(qrow + 16 * kk); }
    __syncthreads();
    const float* lutH = lut + hg * 256;
    f32x16 oc[4];
    {
        const unsigned char* kl = smem + A_STG + r * 272 + 16 * hh;
        const unsigned char* vl = smem + A_STG + A_BUF + r * 272 + 8 * hh;
        float mx = NEGF, sum = 0.f;
#pragma unroll 1
        for (int kt = 0; kt < 4; ++kt) {
            f32x16 sc;
#pragma unroll
            for (int i = 0; i < 16; ++i) sc[i] = 0.f;
#pragma unroll
            for (int kk = 0; kk < 8; ++kk) { const bf16x8 a = *(const bf16x8*)(kl + kt * (32 * 272) + 32 * kk); sc = MFMA32(a, qf[kk], sc); }
            float tmax = NEGF;
#pragma unroll
            for (int i = 0; i < 16; ++i) { const int c = 32 * kt + crow(i, hh), dist = tq - (16 * c + 31);
                const int di = dist < 0 ? 0 : (dist > 255 ? 255 : dist);
                const float v = sc[i] * QK_C1 + lutH[di];
                sc[i] = (dist >= 0 && c < 127) ? v : NEGF; tmax = fmaxf(tmax, sc[i]); }
            tmax = xor32_max(tmax);
            const float mnew = fmaxf(mx, tmax); float ps = 0.f;
#pragma unroll
            for (int i = 0; i < 16; ++i) ps += (sc[i] > -1e29f) ? __builtin_amdgcn_exp2f(sc[i] - mnew) : 0.f;
            ps = xor32_sum(ps);
            sum = sum * __builtin_amdgcn_exp2f(mx - mnew) + ps; mx = mnew;
        }
        const float inv = 1.0f / fmaxf(sum, 1e-30f);
#pragma unroll
        for (int dt = 0; dt < 4; ++dt)
#pragma unroll
            for (int i = 0; i < 16; ++i) oc[dt][i] = 0.f;
#pragma unroll 1
        for (int kt = 0; kt < 4; ++kt) {
            f32x16 sc;
#pragma unroll
            for (int i = 0; i < 16; ++i) sc[i] = 0.f;
#pragma unroll
            for (int kk = 0; kk < 8; ++kk) { const bf16x8 a = *(const bf16x8*)(kl + kt * (32 * 272) + 32 * kk); sc = MFMA32(a, qf[kk], sc); }
#pragma unroll
            for (int i = 0; i < 16; ++i) { const int c = 32 * kt + crow(i, hh), dist = tq - (16 * c + 31);
                const int di = dist < 0 ? 0 : (dist > 255 ? 255 : dist);
                const float v = sc[i] * QK_C1 + lutH[di];
                sc[i] = (dist >= 0 && c < 127) ? __builtin_amdgcn_exp2f(v - mx) * inv : 0.f; }
#pragma unroll
            for (int gi = 0; gi < 4; ++gi) { const int jb = 8 * kt + 2 * gi + hh; const float p3 = 0.5f * sc[4 * gi + 3];
                impM[(hg * 64 + qloc) * 33 + jb] = sc[4 * gi] + sc[4 * gi + 1] + sc[4 * gi + 2] + p3;
                impS[(hg * 64 + qloc) * 33 + jb] = p3; }
#pragma unroll
            for (int s2 = 0; s2 < 2; ++s2) { const bf16x8 pb = packp(sc, s2);
#pragma unroll
                for (int dt = 0; dt < 4; ++dt) { const bf16x8 a = lds2x4(vl + dt * (32 * 272) + 64 * kt + 32 * s2); oc[dt] = MFMA32(a, pb, oc[dt]); } }
        }
    }
    __syncthreads();
#pragma unroll 1
    for (int e = 0; e < 4; ++e) { const int idx = tid + 512 * e, qq = idx >> 5, j = idx & 31, t = t0 + qq, cur = t >> 6;
        float v = 0.f;
#pragma unroll
        for (int h = 0; h < 4; ++h) { v += impM[(h * 64 + qq) * 33 + j]; if (j > 0) v += impS[(h * 64 + qq) * 33 + j - 1]; }
        const bool forced = (j == 0) || (j == cur) || (j == cur - 1);
        impv[idx] = forced ? 1e6f : (j <= cur ? v : -1e9f); }
    __syncthreads();
#pragma unroll 1
    for (int e = 0; e < 4; ++e) { const int idx = tid + 512 * e, qq = idx >> 5, j = idx & 31;
        const float my = impv[idx]; int rank = 0;
#pragma unroll 8
        for (int j2 = 0; j2 < 32; ++j2) { const float o2 = impv[qq * 32 + j2]; rank += (o2 > my || (o2 == my && j2 < j)) ? 1 : 0; }
        const unsigned long long bal = __ballot(rank < 16);
        if (lane == 0) selm[qq] = (unsigned)bal; if (lane == 32) selm[qq] = (unsigned)(bal >> 32); }
    __syncthreads();
    float gc, gs, gw;
    { const bf16_t* gp = proj + (size_t)(b * TT + tq) * NPROJ + C_GATE + head * 3;
      gc = sigmoidf_(bf2f(gp[0])); gs = sigmoidf_(bf2f(gp[1])); gw = sigmoidf_(bf2f(gp[2])); }
    { float* outs1_ = outs + lane; asm volatile("" : "+v"(outs1_)); GAS float* outs1 = (GAS float*)outs1_;
#pragma unroll
    for (int dt = 0; dt < 4; ++dt)
#pragma unroll
        for (int i = 0; i < 16; ++i) outs1[(dt * 16 + i) * 64] = gc * oc[dt][i]; }
    const unsigned mymask = selm[qloc];
    unsigned uni = selm[lane];
#pragma unroll
    for (int o_ = 32; o_ >= 1; o_ >>= 1) uni |= (unsigned)__shfl_xor((int)uni, o_);
    uni = __builtin_amdgcn_readfirstlane(uni);
    f32x16 o[4]; float m, l;
    {
#pragma unroll
        for (int dt = 0; dt < 4; ++dt)
#pragma unroll
            for (int i = 0; i < 16; ++i) o[dt][i] = 0.f;
        m = NEGF; l = 0.f;
        const bf16_t* kb = proj + (size_t)(b * TT) * NPROJ + C_KS + g * 128;
        const bf16_t* vt = (const bf16_t*)(ws + WS_VTS) + (size_t)bg * 128 * TT;
        const unsigned need = uni & (qt == 31 ? 0xffffffffu : ((1u << (qt + 1)) - 1u));
        attn_branch<0>(smem, kb, vt, need, mymask, t0w, tq, r, hh, qf, lutH, o, m, l);
        const float sc = gs / fmaxf(l, 1e-30f);
        float* outs2_ = outs + lane; asm volatile("" : "+v"(outs2_)); GAS float* outs2 = (GAS float*)outs2_;
        f32x16 pv[4];
#pragma unroll
        for (int dt = 0; dt < 4; ++dt)
#pragma unroll
            for (int i = 0; i < 16; ++i) pv[dt][i] = outs2[(dt * 16 + i) * 64];
        __builtin_amdgcn_sched_barrier(0);
#pragma unroll
        for (int dt = 0; dt < 4; ++dt)
#pragma unroll
            for (int i = 0; i < 16; ++i) outs2[(dt * 16 + i) * 64] = pv[dt][i] + sc * o[dt][i];
    }
    {
#pragma unroll
        for (int dt = 0; dt < 4; ++dt)
#pragma unroll
            for (int i = 0; i < 16; ++i) o[dt][i] = 0.f;
        m = NEGF; l = 0.f;
        const bf16_t* kb = proj + (size_t)(b * TT) * NPROJ + C_KW + g * 128;
        const bf16_t* vt = (const bf16_t*)(ws + WS_VTW) + (size_t)bg * 128 * TT;
        const int jlo = qt >= 8 ? qt - 8 : 0;
        const unsigned need = (qt == 31 ? 0xffffffffu : ((1u << (qt + 1)) - 1u)) & ~((1u << jlo) - 1u);
        attn_branch<1>(smem, kb, vt, need, 0u, t0w, tq, r, hh, qf, lutH, o, m, l);
        const float sc = gw / fmaxf(l, 1e-30f);
        float* outs3_ = outs + lane; asm volatile("" : "+v"(outs3_)); GAS float* outs3 = (GAS float*)outs3_;
        bf16_t* as = (bf16_t*)(ws + WS_AS) + (size_t)(b * TT + tq) * DM + head * 128;
        f32x16 pv[4];
#pragma unroll
        for (int dt = 0; dt < 4; ++dt)
#pragma unroll
            for (int i = 0; i < 16; ++i) pv[dt][i] = outs3[(dt * 16 + i) * 64];
        __builtin_amdgcn_sched_barrier(0);
#pragma unroll
        for (int dt = 0; dt < 4; ++dt)
#pragma unroll
            for (int gi = 0; gi < 4; ++gi) { float v[4];
#pragma unroll
                for (int j = 0; j < 4; ++j) { const int i = 4 * gi + j; v[j] = pv[dt][i] + sc * o[dt][i]; }
                u32x2 w; w.x = pk2(v[0], v[1]); w.y = pk2(v[2], v[3]);
                *(u32x2*)(as + 32 * dt + 8 * gi + 4 * hh) = w; }
    }
    __builtin_amdgcn_s_setprio(0);
}

DI void fill_rstd(const pg8::StaticOrder& S, const float* ss, unsigned char* smem) {
    float* rl = (float*)(smem + 131072);
    for (int i = 0; i < 16; ++i) { pg8::Unit u; if (!S.next(i, u)) break;
        if (threadIdx.x < 256) rl[i * 256 + threadIdx.x] = 1.0f / sqrtf(ss[u.pm * 256 + threadIdx.x] * (1.0f / DM) + EPSN); }
    __syncthreads();
}

#define XB_TMO      128
#define XB_XCNT(j)  (256  + 64 * (j))
#define XB_XSUB(j)  (1280 + 64 * (j))
#define XB_XGEN(j)  (2304 + 64 * (j))
#define XB_TOP      3328
#define XB_TOPGEN   3392
#define XCD_BAR_WORDS 3456
#define XB_SPIN_CAP (1u << 18)
DI unsigned xb_ld(unsigned* p)              { return __hip_atomic_load(p, __ATOMIC_RELAXED, __HIP_MEMORY_SCOPE_AGENT); }
DI unsigned xb_add(unsigned* p, unsigned v) { return __hip_atomic_fetch_add(p, v, __ATOMIC_RELAXED, __HIP_MEMORY_SCOPE_AGENT); }
DI unsigned xb_xcc_id() { return (unsigned)__builtin_amdgcn_s_getreg((3 << 11) | 20) & 0xFu; }
#define XB_SPIN(cond, bar) do { unsigned _sp = 0; while (cond) { __builtin_amdgcn_s_sleep(1); \
    if ((++_sp & 255u) == 0u) { if (xb_ld(&(bar)[XB_TMO])) break; if (_sp > XB_SPIN_CAP) { atomicAdd(&(bar)[XB_TMO], 1u); break; } } } } while (0)
struct XcdBarrier { unsigned* bar; unsigned x; volatile LAS unsigned* st; };
DI XcdBarrier xcd_barrier_post(unsigned* bar, volatile LAS unsigned* st) {
    XcdBarrier b; b.bar = bar; b.x = xb_xcc_id(); b.st = st;
    if (threadIdx.x == 0) (void)xb_add(&bar[XB_XCNT(b.x)], 1u);
    return b;
}
DI void xcd_barrier_complete(unsigned* bar, unsigned x, unsigned& nloc, unsigned& nx) {
    const unsigned G = gridDim.x * gridDim.y * gridDim.z;
    unsigned sum, cnt, mine, sp = 0u;
    for (;;) {
        sum = 0u; cnt = 0u; mine = 0u;
#pragma unroll
        for (unsigned j = 0; j < 16; ++j) { const unsigned c = xb_ld(&bar[XB_XCNT(j)]); sum += c; cnt += (c > 0u) ? 1u : 0u; mine = (j == x) ? c : mine; }
        if (sum == G) break;
        __builtin_amdgcn_s_sleep(1);
        if ((++sp & 255u) == 0u) { if (xb_ld(&bar[XB_TMO])) break; if (sp > XB_SPIN_CAP) { atomicAdd(&bar[XB_TMO], 1u); break; } }
    }
    nloc = mine > 0u ? mine : 1u; nx = cnt > 0u ? cnt : 1u;
}
DI void xcd_barrier(const XcdBarrier& b) {
    asm volatile("s_waitcnt vmcnt(0)" ::: "memory");
    __syncthreads();
    if (threadIdx.x == 0) {
        unsigned* bar = b.bar;
        __builtin_amdgcn_s_waitcnt(0);
        unsigned nloc = b.st[0], nx = b.st[1];
        if (nloc == 0u) { xcd_barrier_complete(bar, b.x, nloc, nx); b.st[0] = nloc; b.st[1] = nx; }
        const unsigned old = xb_add(&bar[XB_XSUB(b.x)], 1u);
        const unsigned gen = old / nloc;
        if (old + 1u == (gen + 1u) * nloc) {
            __builtin_amdgcn_fence(__ATOMIC_RELEASE, "agent");
            asm volatile("s_waitcnt vmcnt(0)" ::: "memory");
            const unsigned og = xb_add(&bar[XB_TOP], 1u);
            const unsigned tg = og / nx;
            if (og + 1u == (tg + 1u) * nx) xb_add(&bar[XB_TOPGEN], 1u);
            else XB_SPIN(xb_ld(&bar[XB_TOPGEN]) == tg, bar);
            __builtin_amdgcn_fence(__ATOMIC_ACQUIRE, "agent");
            xb_add(&bar[XB_XGEN(b.x)], 1u);
            asm volatile("s_waitcnt vmcnt(0)" ::: "memory");
        } else {
            XB_SPIN(xb_ld(&bar[XB_XGEN(b.x)]) == gen, bar);
            __builtin_amdgcn_fence(__ATOMIC_ACQUIRE, "agent");
            asm volatile("s_waitcnt vmcnt(0)" ::: "memory");
        }
    }
    __syncthreads();
}

__global__ void __launch_bounds__(512, 2) hymba_fwd(Params P) {
    extern __shared__ __attribute__((aligned(16))) unsigned char shm[];
    cg::grid_group grid = cg::this_grid();
    unsigned char* ws = P.ws;
    LAS unsigned char* lds = (LAS unsigned char*)shm;
    const int tid = threadIdx.x, G = gridDim.x;
    float* hres = P.out;
    const int lo = P.ph_lo, hi = P.ph_hi;
    volatile LAS unsigned* xbst = (volatile LAS unsigned*)(lds + L_CUR + 16);
    if (tid == 0) { xbst[0] = 0u; xbst[1] = 0u; }
    __syncthreads();
    const XcdBarrier xbar = xcd_barrier_post((unsigned*)((float*)(ws + WS_SMALL) + SM_BAR), xbst);
#define IN(k) (lo <= (k) && (k) < hi)
#define SYNC(k) do { if (IN(k) && IN((k) + 1)) { if ((k) == 0) grid.sync(); else xcd_barrier(xbar); } } while (0)
#ifndef DUP_PH
#define DUP_PH -1
#endif
#define REP(k) for (int rep_ = 0; rep_ < ((k) == DUP_PH ? 2 : 1); ++rep_, (((k) == DUP_PH && rep_ == 1) ? grid.sync() : (void)0))
    if (IN(0)) REP(0) phase_prep(P, shm);
    SYNC(0);
    if (IN(1)) REP(1) { pg8::Gemm g{(const bf16_t*)(ws + WS_XN), (const bf16_t*)(ws + WS_W13A), MTOK, 2 * DFF, DM};
        pg8::StaticOrder S; S.init(MTOK, 2 * DFF, G, (int)blockIdx.x); EpiSwiGLU E{(bf16_t*)(ws + WS_H), nullptr};
        pg8::gemm_phase<EpiSwiGLU, pg8::StaticOrder>(lds, g, S, E); }
    SYNC(1);
    if (IN(2)) REP(2) { pg8::Gemm g{(const bf16_t*)(ws + WS_H), (const bf16_t*)(ws + WS_W2A), MTOK, DM, DFF};
        pg8::StaticOrder S; S.init(MTOK, DM, G, (int)blockIdx.x); EpiResid<0> E{P.in[0], nullptr, nullptr, (bf16_t*)hres, (float*)(ws + WS_SMALL) + SM_SS, 0.5f};
        pg8::gemm_phase<EpiResid<0>, pg8::StaticOrder>(lds, g, S, E); }
    if (IN(2) && hi > 3) xcd_barrier(xbar);
    if (IN(4)) REP(4) {
        if (blockIdx.x == 0 && tid < 256) { float* sm = (float*)(ws + WS_SMALL); const int which = tid >> 7, n = tid & 127; float s = P.in[which ? 13 : 9][n];
            for (int c = 0; c < 128; ++c) s += sm[SM_CBP + (which * 128 + c) * 128 + n];
            sm[SM_CB1 + which * 128 + n] = s; }
        pg8::Gemm g{(const bf16_t*)hres, (const bf16_t*)(ws + WS_WIN), MTOK, NPROJ, DM};
        pg8::StaticOrder S; S.init(MTOK, NPROJ, G, (int)blockIdx.x); EpiProj E{(bf16_t*)(ws + WS_PROJ), (const float*)(ws + WS_SMALL) + SM_SS, (bf16_t*)(ws + WS_VTS), (bf16_t*)(ws + WS_VTW)}; fill_rstd(S, E.ss, shm);
        pg8::gemm_phase<EpiProj, pg8::StaticOrder>(lds, g, S, E); }
    SYNC(4);
    if (IN(5)) REP(5) {
        for (int it = blockIdx.x; it < 254 + 2048; it += G) {
            if (it < 254) compress_item(P, it, shm);
            else { s5_pass1_item(P, it - 254, shm); __syncthreads(); }
        } }
    SYNC(5);
    if (IN(6)) REP(6) {
        int* ctr = (int*)((float*)(ws + WS_SMALL) + SM_CTR) + rep_;
        volatile int* curw = (volatile int*)(shm + L_CUR);
        for (int it = blockIdx.x; it < 2048; it += G) { s5_pass3_item(P, it, shm); __syncthreads(); }
        for (;;) {
            __syncthreads();
            if (tid == 0) *curw = atomicAdd(ctr, 1);
            __syncthreads();
            const int it = *curw;
            if (it >= 512) break;
            attn_item(P, it, shm);
        } }
    SYNC(6);
    if (IN(7)) REP(7) { pg8::Gemm g{(const bf16_t*)(ws + WS_HG), (const bf16_t*)(ws + WS_GLUW), MTOK, 1024, 1024};
        pg8::StaticOrder S; S.init(MTOK, 1024, G, (int)blockIdx.x); EpiGLU E{(const bf16_t*)(ws + WS_HG), P.in[25], (bf16_t*)(ws + WS_AS)};
        pg8::gemm_phase<EpiGLU, pg8::StaticOrder>(lds, g, S, E); }
    SYNC(7);
    if (IN(8)) REP(8) { pg8::Gemm g{(const bf16_t*)(ws + WS_AS), (const bf16_t*)(ws + WS_WOUT), MTOK, DM, DM};
        pg8::StaticOrder S; S.init(MTOK, DM, G, (int)blockIdx.x); EpiResid<1> E{nullptr, (const bf16_t*)hres, nullptr, (bf16_t*)(ws + WS_XN), (float*)(ws + WS_SMALL) + SM_SS + 16384, 1.0f};
        pg8::gemm_phase<EpiResid<1>, pg8::StaticOrder>(lds, g, S, E); }
    if (IN(8) && hi > 9) xcd_barrier(xbar);
    if (IN(10)) REP(10) { pg8::Gemm g{(const bf16_t*)(ws + WS_XN), (const bf16_t*)(ws + WS_W13B), MTOK, 2 * DFF, DM};
        pg8::StaticOrder S; S.init(MTOK, 2 * DFF, G, (int)blockIdx.x); EpiSwiGLU E{(bf16_t*)(ws + WS_H), (const float*)(ws + WS_SMALL) + SM_SS + 16384}; fill_rstd(S, E.ss, shm);
        pg8::gemm_phase<EpiSwiGLU, pg8::StaticOrder>(lds, g, S, E); }
    SYNC(10);
    if (IN(11)) REP(11) { pg8::Gemm g{(const bf16_t*)(ws + WS_H), (const bf16_t*)(ws + WS_W2B), MTOK, DM, DFF};
        pg8::StaticOrder S; S.init(MTOK, DM, G, (int)blockIdx.x); EpiResid<2> E{nullptr, (const bf16_t*)(ws + WS_XN), hres, nullptr, nullptr, 0.5f};
        pg8::gemm_phase<EpiResid<2>, pg8::StaticOrder>(lds, g, S, E); }
    SYNC(11);
    if (IN(12)) REP(12) norm_rows(hres, P.in[31], nullptr, hres);
}

#ifndef N_LAUNCH_MODE
#define N_LAUNCH_MODE 0
#endif

extern "C" void kernel_launch(void* const* d_in, const int* in_sizes, int n_in, void* d_out, int out_size, void* d_ws, size_t ws_size, hipStream_t stream) {
    static int grid = 0;
    if (grid == 0) {
        int dev = 0, cus = 0, per_cu = 0;
        hipGetDevice(&dev);
        hipDeviceGetAttribute(&cus, hipDeviceAttributeMultiprocessorCount, dev);
        hipFuncSetAttribute((const void*)hymba_fwd, hipFuncAttributeMaxDynamicSharedMemorySize, LDS_BYTES);
        hipOccupancyMaxActiveBlocksPerMultiprocessor(&per_cu, (const void*)hymba_fwd, 512, LDS_BYTES);
        if (per_cu < 1) { fprintf(stderr, "occupancy query says %d blocks/CU\n", per_cu); per_cu = 1; }
        (void)hipGetLastError();
        grid = cus * 1;
        if (n_in != 32 || ws_size < WS_END) fprintf(stderr, "kernel_launch: unexpected n_in %d / ws %zu\n", n_in, ws_size);
    }
    Params p{};
    for (int i = 0; i < 32; ++i) p.in[i] = (const float*)d_in[i];
    p.out = (float*)d_out; p.ws = (unsigned char*)d_ws;
    (void)hipMemsetAsync((unsigned char*)d_ws + WS_SMALL + (size_t)SM_BAR * 4, 0, XCD_BAR_WORDS * 4, stream);
#if N_LAUNCH_MODE == 0
    p.ph_lo = 0; p.ph_hi = NPH;
    { void* args[] = {&p};
      hipError_t e = hipLaunchCooperativeKernel((const void*)hymba_fwd, dim3(grid), dim3(512), args, LDS_BYTES, stream);
      if (e != hipSuccess) fprintf(stderr, "cooperative launch failed: %s (grid %d)\n", hipGetErrorString(e), grid); }
#else
    for (int ph = 0; ph < NPH; ++ph) { p.ph_lo = ph; p.ph_hi = ph + 1;
        void* args[] = {&p};
        hipError_t e = hipLaunchCooperativeKernel((const void*)hymba_fwd, dim3(grid), dim3(512), args, LDS_BYTES, stream);
        if (e != hipSuccess) fprintf(stderr, "launch %d failed: %s (grid %d)\n", ph, hipGetErrorString(e), grid); }
#endif
}
```

```cpp
#include <hip/hip_runtime.h>
#include <hip/hip_cooperative_groups.h>
#include <cstdio>
namespace cg = cooperative_groups;

#define DI __device__ __forceinline__
#define LAS __attribute__((address_space(3)))
#define GAS __attribute__((address_space(1)))
typedef unsigned short bf16_t;
typedef short bf16x8 __attribute__((ext_vector_type(8)));
typedef short s16x4 __attribute__((ext_vector_type(4)));
typedef float f32x4 __attribute__((ext_vector_type(4)));
typedef float f32x16 __attribute__((ext_vector_type(16)));
typedef unsigned u32x4 __attribute__((ext_vector_type(4)));
typedef unsigned u32x2 __attribute__((ext_vector_type(2)));
typedef __bf16 bf16x2_t __attribute__((ext_vector_type(2)));
typedef float f32x2_t __attribute__((ext_vector_type(2)));

constexpr int MTOK = 16384, DM = 2048, DFF = 5632, TT = 2048;
constexpr int NPROJ = 3840;
constexpr int C_KC = 1024, C_VC = 1280, C_KS = 1536, C_VS = 1792, C_KW = 2048, C_VW = 2304, C_GATE = 2560, C_SSM = 2584;
constexpr float EPSN = 1e-6f;
constexpr float NEGF = -1e30f;

constexpr size_t WS_W13A = 0;
constexpr size_t WS_W2A = WS_W13A + 46137344;
constexpr size_t WS_W13B = WS_W2A + 23068672;
constexpr size_t WS_W2B = WS_W13B + 46137344;
constexpr size_t WS_WIN = WS_W2B + 23068672;
constexpr size_t WS_WOUT = WS_WIN + 15728640;
constexpr size_t WS_GLUW = WS_WOUT + 8388608;
constexpr size_t WS_CW1K = WS_GLUW + 2097152;
constexpr size_t WS_CW1V = WS_CW1K + 1048576;
constexpr size_t WS_CW2K = WS_CW1V + 1048576;
constexpr size_t WS_CW2V = WS_CW2K + 32768;
constexpr size_t WS_SMALL = WS_CW2V + 32768;
constexpr size_t WS_KCB = WS_SMALL + 1048576;
constexpr size_t WS_VCBT = WS_KCB + 524288;
constexpr size_t WS_S5END = WS_VCBT + 524288;
constexpr size_t WS_VTS = WS_S5END + 8388608;
constexpr size_t WS_VTW = WS_VTS + 8388608;
constexpr size_t WS_XN = WS_VTW + 8388608;
constexpr size_t WS_H = WS_XN + 67108864;
constexpr size_t WS_PROJ = WS_H;
constexpr size_t WS_AS = WS_H + 125829120;
constexpr size_t WS_HG = WS_XN;
constexpr size_t WS_OUTS = WS_H + 184549376 + 8388608;
constexpr size_t WS_END = WS_OUTS + 33554432;
constexpr int SM_CB1 = 0;
constexpr int SM_AB = 256;
constexpr int SM_BB = 256 + 16384;
constexpr int SM_CTR = 256 + 16384 + 131072;
constexpr int SM_CBP = SM_CTR + 64;
constexpr int SM_SS = SM_CBP + 32768;
constexpr int SM_BAR = 213504;

constexpr int LDS_BYTES = 151552;
constexpr int L_CUR = 149776;
constexpr int NPH = 13;

struct Params { const float* in[32]; float* out; unsigned char* ws; int ph_lo, ph_hi; };

DI unsigned pk2(float a, float b) { f32x2_t v = {a, b}; return __builtin_bit_cast(unsigned, __builtin_convertvector(v, bf16x2_t)); }
DI float bf2f(unsigned x) { return __uint_as_float(x << 16); }
DI float bflo(unsigned w) { return __uint_as_float(w << 16); }
DI float bfhi(unsigned w) { return __uint_as_float(w & 0xffff0000u); }
DI float sigmoidf_(float x) { return __builtin_amdgcn_rcpf(1.0f + __builtin_amdgcn_exp2f(-1.4426950408889634f * x)); }
DI float gelu_tanh(float v) { const float z = 0.7978845608028654f * (v + 0.044715f * v * v * v); const float th = 1.0f - 2.0f * __builtin_amdgcn_rcpf(__builtin_amdgcn_exp2f(2.8853900817779268f * z) + 1.0f); return 0.5f * v * (1.0f + th); }

namespace pg8 {
constexpr int BM = 256, BK = 64, HALF = 128, HTB = HALF * BK * 2, STAGE_BYTES = 8 * HTB, NXCD = 8, WGM = 8;
__host__ __device__ __forceinline__ int lds_byte(int r, int c) { const int st = (r >> 4) * 2 + (c >> 5), rr = r & 15, cc = c & 31, ob = rr * 64 + cc * 2; return st * 1024 + (ob ^ (((ob >> 9) & 1) << 5)); }
__host__ __device__ __forceinline__ void stage_rc(int b, int& R, int& C) { const int st = b / 1024, sb = b % 1024, swz = sb ^ (((sb >> 9) & 1) << 5); R = (st >> 1) * 16 + swz / 64; C = (st & 1) * 32 + (swz % 64) / 2; }
__host__ __device__ __forceinline__ int perm32(int rho) { const int n = rho >> 4, i = rho & 15; return 8 * (i >> 2) + 4 * n + (i & 3); }
struct Unit { int pm, pn; };
struct Gemm { const bf16_t* A; const bf16_t* Bt; int M, N, K; };
struct StaticOrder {
    int nM, nN, nwg, G, c;
    __host__ __device__ void init(int M, int N, int G_, int c_) { nM = M / BM; nN = N / BM; nwg = nM * nN; G = G_; c = c_; }
    __host__ __device__ bool next(int i, Unit& u) const {
        const long L = (long)i * G + c; if (L >= nwg) return false;
        int wgid = (int)L; { const int q = nwg / NXCD, r = nwg % NXCD, xcd = wgid % NXCD, off = wgid / NXCD; wgid = (xcd < r ? xcd * (q + 1) : r * (q + 1) + (xcd - r) * q) + off; }
        const int nig = WGM * nN, gid = wgid / nig, fm = gid * WGM, gsz = (nM - fm) < WGM ? (nM - fm) : WGM;
        u.pm = fm + ((wgid % nig) % gsz); u.pn = (wgid % nig) / gsz; return true;
    }
    __device__ __forceinline__ void a_ready(const Unit&) const {}
    __device__ __forceinline__ void done(const Unit&) const {}
};

template <class Epi, class Sched>
__device__ __forceinline__ void gemm_phase(LAS unsigned char* lds, const Gemm g, const Sched& S, const Epi& E) {
    const int tid = threadIdx.x, wid = __builtin_amdgcn_readfirstlane(tid >> 6), lane = tid & 63, wr = wid >> 2, wc = wid & 3, fr = lane & 15, fq = lane >> 4;
    const int K = g.K, nt = K / BK;
    unsigned voffA[2], voffB[2];
#pragma unroll
    for (int i = 0; i < 2; ++i) { int R, C; stage_rc(tid * 16 + i * 8192, R, C); const int Rb = Epi::PERM ? ((R & ~31) + perm32(R & 31)) : R;
        voffA[i] = (unsigned)(R * K + C) * 2u; voffB[i] = (unsigned)(Rb * K + C) * 2u; }
    const size_t kstep = (size_t)(BK * 2);
    const size_t hstep = (size_t)HALF * K * 2;
    const size_t tstep = 2 * hstep;
    const unsigned ldsw = (unsigned)wid * 1024u;
    const int aoff = lds_byte(wr * 64 + fr, fq * 8), boff = lds_byte(wc * 32 + fr, fq * 8);
#define PG8_SA(b, h) (((b) * 2 + (h)) * HTB)
#define PG8_SB(b, h) ((4 + (b) * 2 + (h)) * HTB)
#define PG8_STAGE(bufoff, gbase, voff) do { _Pragma("unroll") for (int _i = 0; _i < 2; ++_i) \
        __builtin_amdgcn_global_load_lds((const unsigned*)((const char*)(gbase) + (voff)[_i]), (LAS unsigned*)(lds + (bufoff) + ldsw + _i * 8192), 16, 0, 0); } while (0)
#define PG8_LDA(dst, b, h) do { _Pragma("unroll") for (int m = 0; m < 4; ++m) _Pragma("unroll") for (int k = 0; k < 2; ++k) dst[m][k] = *(const LAS bf16x8*)(lds + PG8_SA(b, h) + aoff + m * 2048 + k * 1024); } while (0)
#define PG8_LDB(dst, b, h) do { _Pragma("unroll") for (int n = 0; n < 2; ++n) _Pragma("unroll") for (int k = 0; k < 2; ++k) dst[n][k] = *(const LAS bf16x8*)(lds + PG8_SB(b, h) + boff + n * 2048 + k * 1024); } while (0)
#define PG8_MMA(ai, bj, At, Bt) do { __builtin_amdgcn_s_setprio(1); _Pragma("unroll") for (int m = 0; m < 4; ++m) _Pragma("unroll") for (int n = 0; n < 2; ++n) _Pragma("unroll") for (int k = 0; k < 2; ++k) \
        acc[ai][bj][m][n] = __builtin_amdgcn_mfma_f32_16x16x32_bf16(Bt[n][k], At[m][k], acc[ai][bj][m][n], 0, 0, 0); __builtin_amdgcn_s_setprio(0); } while (0)
#define PG8_WAIT_V(n) asm volatile("s_waitcnt vmcnt(" #n ")" ::: "memory")
#define PG8_WAIT_L(n) asm volatile("s_waitcnt lgkmcnt(" #n ")" ::: "memory")
#define PG8_BAR __builtin_amdgcn_s_barrier()
#define PG8_SCHED __builtin_amdgcn_sched_barrier(0)
    Unit cur, nxt; int ui = 0;
    if (!S.next(0, cur)) return;
    f32x4 acc[2][2][4][2];
#pragma unroll
    for (int a = 0; a < 2; ++a)
#pragma unroll
        for (int b = 0; b < 2; ++b)
#pragma unroll
            for (int m = 0; m < 4; ++m)
#pragma unroll
                for (int n = 0; n < 2; ++n) acc[a][b][m][n] = (f32x4){0.f, 0.f, 0.f, 0.f};
    bf16x8 At[4][2], B0[2][2], B1[2][2];
    const char* cA = (const char*)g.A + (size_t)cur.pm * tstep; const char* cB = (const char*)g.Bt + (size_t)cur.pn * tstep;
    S.a_ready(cur);
    PG8_STAGE(PG8_SB(0, 0), cB, voffB); PG8_STAGE(PG8_SA(0, 0), cA, voffA); PG8_STAGE(PG8_SB(0, 1), cB + hstep, voffB); PG8_STAGE(PG8_SA(0, 1), cA + hstep, voffA);
    if (wr == 1) PG8_BAR;
    PG8_WAIT_V(4); PG8_BAR;
    PG8_STAGE(PG8_SB(1, 0), cB + kstep, voffB); PG8_STAGE(PG8_SA(1, 0), cA + kstep, voffA); PG8_STAGE(PG8_SB(1, 1), cB + hstep + kstep, voffB);
    PG8_WAIT_V(6); PG8_BAR;
    for (;;) {
        const bool has_next = S.next(ui + 1, nxt);
        const char* nA = has_next ? (const char*)g.A + (size_t)nxt.pm * tstep : cA; const char* nB = has_next ? (const char*)g.Bt + (size_t)nxt.pn * tstep : cB;
        for (int t = 0; t < nt; t += 2) {
            const bool last = (t == nt - 2);
            const char* a1 = cA + (size_t)(t + 1) * kstep;
            const char* a2 = last ? nA : cA + (size_t)(t + 2) * kstep; const char* b2 = last ? nB : cB + (size_t)(t + 2) * kstep;
            const char* a3 = a2 + kstep; const char* b3 = b2 + kstep;
            if (last && has_next) S.a_ready(nxt);
            PG8_LDB(B0, 0, 0); PG8_SCHED; PG8_LDA(At, 0, 0); PG8_STAGE(PG8_SA(1, 1), a1 + hstep, voffA);
            PG8_WAIT_L(8); PG8_BAR; PG8_WAIT_L(0); PG8_MMA(0, 0, At, B0); PG8_BAR; PG8_SCHED;
            PG8_LDB(B1, 0, 1); PG8_STAGE(PG8_SB(0, 0), b2, voffB);
            PG8_BAR; PG8_WAIT_L(0); PG8_MMA(0, 1, At, B1); PG8_BAR;
            PG8_LDA(At, 0, 1); PG8_STAGE(PG8_SA(0, 0), a2, voffA);
            PG8_BAR; PG8_WAIT_L(0); PG8_MMA(1, 0, At, B0); PG8_BAR; PG8_SCHED;
            PG8_STAGE(PG8_SB(0, 1), b2 + hstep, voffB);
            PG8_WAIT_V(6); PG8_BAR; PG8_MMA(1, 1, At, B1); PG8_BAR;
            PG8_LDB(B0, 1, 0); PG8_SCHED; PG8_LDA(At, 1, 0); PG8_STAGE(PG8_SA(0, 1), a2 + hstep, voffA);
            PG8_WAIT_L(8); PG8_BAR; PG8_WAIT_L(0); PG8_MMA(0, 0, At, B0); PG8_BAR; PG8_SCHED;
            PG8_LDB(B1, 1, 1); PG8_STAGE(PG8_SB(1, 0), b3, voffB);
            PG8_BAR; PG8_WAIT_L(0); PG8_MMA(0, 1, At, B1); PG8_BAR;
            PG8_LDA(At, 1, 1); PG8_STAGE(PG8_SA(1, 0), a3, voffA);
            PG8_BAR; PG8_WAIT_L(0); PG8_MMA(1, 0, At, B0); PG8_BAR; PG8_SCHED;
            PG8_STAGE(PG8_SB(1, 1), b3 + hstep, voffB);
            PG8_WAIT_V(6); PG8_BAR; PG8_MMA(1, 1, At, B1); PG8_BAR;
        }
        E(acc, cur, wr, wc, fr, fq, ui, lds); S.done(cur);
        if (!has_next) break;
#pragma unroll
        for (int a = 0; a < 2; ++a)
#pragma unroll
            for (int b = 0; b < 2; ++b)
#pragma unroll
                for (int m = 0; m < 4; ++m)
#pragma unroll
                    for (int n = 0; n < 2; ++n) acc[a][b][m][n] = (f32x4){0.f, 0.f, 0.f, 0.f};
        cur = nxt; cA = nA; cB = nB; ++ui;
    }
    PG8_WAIT_V(0);
    if (wr == 0) PG8_BAR;
    PG8_BAR;
#undef PG8_SA
#undef PG8_SB
#undef PG8_STAGE
#undef PG8_LDA
#undef PG8_LDB
#undef PG8_MMA
#undef PG8_WAIT_V
#undef PG8_WAIT_L
#undef PG8_BAR
#undef PG8_SCHED
}
}

struct EpiSwiGLU {
    static constexpr bool PERM = true;
    bf16_t* H; const float* ss;
    DI void operator()(const f32x4 (&acc)[2][2][4][2], const pg8::Unit& u, int wr, int wc, int fr, int fq, int ui, LAS unsigned char* lds) const {
        const int row0 = u.pm * 256 + wr * 64 + fr, col0 = u.pn * 128 + wc * 32 + 8 * fq;
#pragma unroll
        for (int ai = 0; ai < 2; ++ai)
#pragma unroll
            for (int m = 0; m < 4; ++m) {
                const float rs = ss ? ((const LAS float*)(lds + 131072))[ui * 256 + wr * 64 + fr + ai * 128 + m * 16] : 1.0f;
                float v[8];
#pragma unroll
                for (int n = 0; n < 2; ++n)
#pragma unroll
                    for (int j = 0; j < 4; ++j) { const float gt = acc[ai][0][m][n][j] * rs, up = acc[ai][1][m][n][j] * rs; v[n * 4 + j] = gt * up * __builtin_amdgcn_rcpf(1.0f + __builtin_amdgcn_exp2f(-1.4426950408889634f * gt)); }
                u32x4 w; w.x = pk2(v[0], v[1]); w.y = pk2(v[2], v[3]); w.z = pk2(v[4], v[5]); w.w = pk2(v[6], v[7]);
                *(u32x4*)(H + (size_t)(row0 + ai * 128 + m * 16) * DFF + col0) = w;
            }
    }
};
template <int MODE> struct EpiResid {
    static constexpr bool PERM = true;
    const float* basef; const bf16_t* baseb; float* outf; bf16_t* hb; float* ss; float scale;
    DI void operator()(const f32x4 (&acc)[2][2][4][2], const pg8::Unit& u, int wr, int wc, int fr, int fq, int ui, LAS unsigned char* lds) const {
        const int row0 = u.pm * 256 + wr * 64 + fr, col0 = u.pn * 256 + wc * 32 + 8 * fq;
#pragma unroll
        for (int ai = 0; ai < 2; ++ai) {
            f32x4 bf0[4][2], bf1[4][2]; u32x4 bw[4][2];
#pragma unroll
            for (int m = 0; m < 4; ++m)
#pragma unroll
                for (int bj = 0; bj < 2; ++bj) { const size_t off = (size_t)(row0 + ai * 128 + m * 16) * DM + col0 + bj * 128;
                    if (MODE == 0) { bf0[m][bj] = *(const f32x4*)(basef + off); bf1[m][bj] = *(const f32x4*)(basef + off + 4); }
                    else bw[m][bj] = *(const u32x4*)(baseb + off); }
            __builtin_amdgcn_sched_barrier(0);
#pragma unroll
            for (int m = 0; m < 4; ++m) { const int row = row0 + ai * 128 + m * 16; const size_t off = (size_t)row * DM + col0; float rsum = 0.f;
#pragma unroll
                for (int bj = 0; bj < 2; ++bj) {
                    f32x4 b0, b1;
                    if (MODE == 0) { b0 = bf0[m][bj]; b1 = bf1[m][bj]; }
                    else { const u32x4 w = bw[m][bj]; b0 = (f32x4){bflo(w.x), bfhi(w.x), bflo(w.y), bfhi(w.y)}; b1 = (f32x4){bflo(w.z), bfhi(w.z), bflo(w.w), bfhi(w.w)}; }
                    const f32x4 v0 = b0 + acc[ai][bj][m][0] * scale, v1 = b1 + acc[ai][bj][m][1] * scale;
                    if (MODE == 2) { *(f32x4*)(outf + off + bj * 128) = v0; *(f32x4*)(outf + off + bj * 128 + 4) = v1; }
                    else { rsum += (v0[0] * v0[0] + v0[1] * v0[1]) + (v0[2] * v0[2] + v0[3] * v0[3]) + (v1[0] * v1[0] + v1[1] * v1[1]) + (v1[2] * v1[2] + v1[3] * v1[3]);
                        u32x4 w; w.x = pk2(v0[0], v0[1]); w.y = pk2(v0[2], v0[3]); w.z = pk2(v1[0], v1[1]); w.w = pk2(v1[2], v1[3]);
                        *(u32x4*)(hb + off + bj * 128) = w; } }
                if (MODE != 2) { rsum += __shfl_xor(rsum, 16); rsum += __shfl_xor(rsum, 32); if (fq == 0) atomicAdd(ss + row, rsum); } }
        }
    }
};
struct EpiProj {
    static constexpr bool PERM = true;
    bf16_t* O; const float* ss; bf16_t* vts; bf16_t* vtw;
    DI void operator()(const f32x4 (&acc)[2][2][4][2], const pg8::Unit& u, int wr, int wc, int fr, int fq, int ui, LAS unsigned char* lds) const {
        const int row0 = u.pm * 256 + wr * 64 + fr, col0 = u.pn * 256 + wc * 32 + 8 * fq;
        const bool tr = (u.pn == 7) || (u.pn == 9);
#pragma unroll
        for (int ai = 0; ai < 2; ++ai)
#pragma unroll
            for (int m = 0; m < 4; ++m) { const int row = row0 + ai * 128 + m * 16; bf16_t* rowp = O + (size_t)row * NPROJ + col0;
                const float rs = ((const LAS float*)(lds + 131072))[ui * 256 + wr * 64 + fr + ai * 128 + m * 16];
#pragma unroll
                for (int bj = 0; bj < 2; ++bj) { const f32x4 v0 = acc[ai][bj][m][0] * rs, v1 = acc[ai][bj][m][1] * rs;
                    u32x4 w; w.x = pk2(v0[0], v0[1]); w.y = pk2(v0[2], v0[3]); w.z = pk2(v1[0], v1[1]); w.w = pk2(v1[2], v1[3]);
                    if (!tr) *(u32x4*)(rowp + bj * 128) = w;
                    else { bf16_t* vt = (u.pn == 7 ? vts : vtw) + ((size_t)((row >> 11) * 2 + bj) * 128 + wc * 32 + 8 * fq) * TT + (row & 2047);
                        vt[0 * TT] = (bf16_t)(w.x & 0xffffu); vt[1 * TT] = (bf16_t)(w.x >> 16); vt[2 * TT] = (bf16_t)(w.y & 0xffffu); vt[3 * TT] = (bf16_t)(w.y >> 16);
                        vt[4 * TT] = (bf16_t)(w.z & 0xffffu); vt[5 * TT] = (bf16_t)(w.z >> 16); vt[6 * TT] = (bf16_t)(w.w & 0xffffu); vt[7 * TT] = (bf16_t)(w.w >> 16); } } }
    }
};
struct EpiGLU {
    static constexpr bool PERM = true;
    const bf16_t* HG; const float* bias; bf16_t* AS;
    DI void operator()(const f32x4 (&acc)[2][2][4][2], const pg8::Unit& u, int wr, int wc, int fr, int fq, int ui, LAS unsigned char* lds) const {
        const int row0 = u.pm * 256 + wr * 64 + fr, col0 = u.pn * 256 + wc * 32 + 8 * fq;
        f32x4 bs[2][2];
#pragma unroll
        for (int bj = 0; bj < 2; ++bj) { bs[bj][0] = *(const f32x4*)(bias + col0 + bj * 128); bs[bj][1] = *(const f32x4*)(bias + col0 + bj * 128 + 4); }
#pragma unroll
        for (int ai = 0; ai < 2; ++ai) {
            u32x4 hw[4][2];
#pragma unroll
            for (int m = 0; m < 4; ++m)
#pragma unroll
                for (int bj = 0; bj < 2; ++bj) hw[m][bj] = *(const u32x4*)(HG + (size_t)(row0 + ai * 128 + m * 16) * 1024 + col0 + bj * 128);
            __builtin_amdgcn_sched_barrier(0);
#pragma unroll
            for (int m = 0; m < 4; ++m) { const int row = row0 + ai * 128 + m * 16;
#pragma unroll
                for (int bj = 0; bj < 2; ++bj) { const int col = col0 + bj * 128; const u32x4 h = hw[m][bj];
                    const f32x4 v0 = acc[ai][bj][m][0] + bs[bj][0], v1 = acc[ai][bj][m][1] + bs[bj][1];
                    u32x4 w;
                    w.x = pk2(bflo(h.x) * sigmoidf_(v0[0]), bfhi(h.x) * sigmoidf_(v0[1]));
                    w.y = pk2(bflo(h.y) * sigmoidf_(v0[2]), bfhi(h.y) * sigmoidf_(v0[3]));
                    w.z = pk2(bflo(h.z) * sigmoidf_(v1[0]), bfhi(h.z) * sigmoidf_(v1[1]));
                    w.w = pk2(bflo(h.w) * sigmoidf_(v1[2]), bfhi(h.w) * sigmoidf_(v1[3]));
                    *(u32x4*)(AS + (size_t)row * DM + 1024 + col) = w; } }
        }
    }
};

DI void tconv(const float* __restrict__ src, int K, int N, int Npad, bf16_t* __restrict__ dst, int mode, float* tile, const float* __restrict__ gk = nullptr) {
    const int tid = threadIdx.x, ntk = K >> 6, ntn = Npad >> 7, ntile = ntk * ntn;
    f32x4 v[4];
    float gv[4];
#define TC_LOAD(tt) do { const int tk_ = (tt) % ntk, tn_ = (tt) / ntk; \
        _Pragma("unroll") for (int e = 0; e < 4; ++e) { const int i = tid + 512 * e, r = i >> 5, n = tn_ * 128 + (i & 31) * 4, nn = n < N ? n : N - 4; \
            v[e] = __builtin_nontemporal_load((const f32x4*)(src + (size_t)(tk_ * 64 + r) * N + nn)); gv[e] = gk ? gk[tk_ * 64 + r] : 1.0f; } } while (0)
    int t = blockIdx.x;
    if (t < ntile) TC_LOAD(t);
    for (; t < ntile; t += gridDim.x) {
#pragma unroll
        for (int e = 0; e < 4; ++e) { const int i = tid + 512 * e, r = i >> 5, c = (i & 31) * 4; const bool ok = (t / ntk) * 128 + c < N;
            const f32x4 x = ok ? v[e] * gv[e] : (f32x4){0.f, 0.f, 0.f, 0.f};
            tile[r * 129 + c] = x[0]; tile[r * 129 + c + 1] = x[1]; tile[r * 129 + c + 2] = x[2]; tile[r * 129 + c + 3] = x[3]; }
        __syncthreads();
        const int tk = t % ntk, tn = t / ntk;
        if (t + (int)gridDim.x < ntile) TC_LOAD(t + (int)gridDim.x);
        { const int nl = tid >> 2, kg = tid & 3, n = tn * 128 + nl;
          float x[16];
#pragma unroll
          for (int j = 0; j < 16; ++j) x[j] = tile[(kg * 16 + j) * 129 + nl];
          const int drow = mode == 0 ? n : (tn * 256 + nl + (mode == 2 ? 128 : 0));
          u32x4 w0, w1; w0.x = pk2(x[0], x[1]); w0.y = pk2(x[2], x[3]); w0.z = pk2(x[4], x[5]); w0.w = pk2(x[6], x[7]);
          w1.x = pk2(x[8], x[9]); w1.y = pk2(x[10], x[11]); w1.z = pk2(x[12], x[13]); w1.w = pk2(x[14], x[15]);
          u32x4* dp = (u32x4*)(dst + (size_t)drow * K + tk * 64 + kg * 16); dp[0] = w0; dp[1] = w1; }
        __syncthreads();
    }
#undef TC_LOAD
}

DI void norm_rows(const float* src, const float* __restrict__ g, bf16_t* dstb, float* dstf) {
    const int wid = threadIdx.x >> 6, lane = threadIdx.x & 63, stride = gridDim.x * 8;
    for (int row = blockIdx.x * 8 + wid; row < MTOK; row += 2 * stride) {
        const int row2 = row + stride; const bool has2 = row2 < MTOK;
        const f32x4* p = (const f32x4*)(src + (size_t)row * DM); const f32x4* p2 = (const f32x4*)(src + (size_t)(has2 ? row2 : row) * DM);
        f32x4 v[8], w[8]; float ss = 0.f, ss2 = 0.f;
#pragma unroll
        for (int i = 0; i < 8; ++i) { v[i] = __builtin_nontemporal_load(p + lane + 64 * i); w[i] = __builtin_nontemporal_load(p2 + lane + 64 * i); }
#pragma unroll
        for (int i = 0; i < 8; ++i) { ss += v[i][0] * v[i][0] + v[i][1] * v[i][1] + v[i][2] * v[i][2] + v[i][3] * v[i][3]; ss2 += w[i][0] * w[i][0] + w[i][1] * w[i][1] + w[i][2] * w[i][2] + w[i][3] * w[i][3]; }
#pragma unroll
        for (int o = 32; o >= 1; o >>= 1) { ss += __shfl_xor(ss, o); ss2 += __shfl_xor(ss2, o); }
        const float rstd = 1.0f / sqrtf(ss * (1.0f / DM) + EPSN), rstd2 = 1.0f / sqrtf(ss2 * (1.0f / DM) + EPSN);
#pragma unroll
        for (int i = 0; i < 8; ++i) { const f32x4 gg = ((const f32x4*)g)[lane + 64 * i]; const f32x4 y = v[i] * rstd * gg, y2 = w[i] * rstd2 * gg;
            if (dstb) { u32x2 o; o.x = pk2(y[0], y[1]); o.y = pk2(y[2], y[3]); *(u32x2*)(dstb + (size_t)row * DM + (lane + 64 * i) * 4) = o;
                        if (has2) { u32x2 o2; o2.x = pk2(y2[0], y2[1]); o2.y = pk2(y2[2], y2[3]); *(u32x2*)(dstb + (size_t)row2 * DM + (lane + 64 * i) * 4) = o2; } }
            else { __builtin_nontemporal_store(y, (f32x4*)(dstf + (size_t)row * DM) + lane + 64 * i); if (has2) __builtin_nontemporal_store(y2, (f32x4*)(dstf + (size_t)row2 * DM) + lane + 64 * i); } }
    }
}

DI void phase_prep(const Params& P, unsigned char* smem) {
    unsigned char* ws = P.ws; float* tile = (float*)smem; const int tid = threadIdx.x;
    float* sm = (float*)(ws + WS_SMALL);
    if (blockIdx.x < 8) { const int idx = blockIdx.x * 512 + tid, grp = idx >> 6;
        const float step = expf(P.in[18][grp]), lre = P.in[16][idx], lim = P.in[17][idx];
        const float mag = expf(lre * step), ar = mag * cosf(lim * step), ai = mag * sinf(lim * step);
        const float nr = ar - 1.0f, ni = ai, den = lre * lre + lim * lim, fre = (nr * lre + ni * lim) / den, fim = (ni * lre - nr * lim) / den;
        f32x4 brv[4], biv[4];
#pragma unroll
        for (int k = 0; k < 4; ++k) { brv[k] = *(const f32x4*)(P.in[19] + idx * 16 + 4 * k); biv[k] = *(const f32x4*)(P.in[20] + idx * 16 + 4 * k); }
        bf16_t* tb = (bf16_t*)(sm + SM_BB); const int p = idx & 63;
        unsigned hre[16], lre_[16], him[16], lim_[16];
#pragma unroll
        for (int h = 0; h < 16; ++h) { const float br = brv[h >> 2][h & 3], bi = biv[h >> 2][h & 3];
            const float vre = fre * br - fim * bi, vim = fre * bi + fim * br;
            hre[h] = pk2(vre, 0.f) & 0xffffu; lre_[h] = pk2(vre - bf2f(hre[h]), 0.f) & 0xffffu;
            him[h] = pk2(vim, 0.f) & 0xffffu; lim_[h] = pk2(vim - bf2f(him[h]), 0.f) & 0xffffu; }
        { u32x4* d = (u32x4*)(tb + (grp * 128 + p) * 32);
          d[0] = (u32x4){hre[0] | (hre[1] << 16), hre[2] | (hre[3] << 16), hre[4] | (hre[5] << 16), hre[6] | (hre[7] << 16)};
          d[1] = (u32x4){hre[8] | (hre[9] << 16), hre[10] | (hre[11] << 16), hre[12] | (hre[13] << 16), hre[14] | (hre[15] << 16)};
          d[2] = (u32x4){lre_[0] | (lre_[1] << 16), lre_[2] | (lre_[3] << 16), lre_[4] | (lre_[5] << 16), lre_[6] | (lre_[7] << 16)};
          d[3] = (u32x4){lre_[8] | (lre_[9] << 16), lre_[10] | (lre_[11] << 16), lre_[12] | (lre_[13] << 16), lre_[14] | (lre_[15] << 16)};
          u32x4* e = (u32x4*)(tb + (grp * 128 + 64 + p) * 32);
          e[0] = (u32x4){him[0] | (him[1] << 16), him[2] | (him[3] << 16), him[4] | (him[5] << 16), him[6] | (him[7] << 16)};
          e[1] = (u32x4){him[8] | (him[9] << 16), him[10] | (him[11] << 16), him[12] | (him[13] << 16), him[14] | (him[15] << 16)};
          e[2] = (u32x4){lim_[0] | (lim_[1] << 16), lim_[2] | (lim_[3] << 16), lim_[4] | (lim_[5] << 16), lim_[6] | (lim_[7] << 16)};
          e[3] = (u32x4){lim_[8] | (lim_[9] << 16), lim_[10] | (lim_[11] << 16), lim_[12] | (lim_[13] << 16), lim_[14] | (lim_[15] << 16)}; }
        float pr = ar, pi = ai;
        for (int s = 0; s < 6; ++s) { const float nr2 = pr * pr - pi * pi, ni2 = 2.0f * pr * pi; pr = nr2; pi = ni2; }
        sm[SM_AB + idx * 4 + 0] = ar; sm[SM_AB + idx * 4 + 1] = ai; sm[SM_AB + idx * 4 + 2] = pr; sm[SM_AB + idx * 4 + 3] = pi; }
    { const int which = blockIdx.x >> 7, chunk = blockIdx.x & 127; const float* pe = P.in[which ? 11 : 7]; const float* w1 = P.in[which ? 12 : 8];
      if (blockIdx.x < 256) {
        const int n = tid & 127, sub = tid >> 7; float s = 0.f;
#pragma unroll
        for (int j = 0; j < 8; ++j) { const int k = chunk * 32 + sub * 8 + j; s += pe[k] * w1[(size_t)k * 128 + n]; }
        tile[tid] = s; __syncthreads();
        if (tid < 128) sm[SM_CBP + (which * 128 + chunk) * 128 + tid] = (tile[tid] + tile[tid + 128]) + (tile[tid + 256] + tile[tid + 384]);
        __syncthreads(); } }
    if (blockIdx.x == 10 && tid == 0) { ((int*)(sm + SM_CTR))[0] = 0; ((int*)(sm + SM_CTR))[1] = 0; }
    for (int i = blockIdx.x * 512 + tid; i < 32768; i += gridDim.x * 512) sm[SM_SS + i] = 0.f;
    { u32x4* z = (u32x4*)(ws + WS_KCB); const u32x4 zero = {0u, 0u, 0u, 0u};
      for (int i = blockIdx.x * 512 + tid; i < 65536; i += gridDim.x * 512) z[i] = zero; }
    norm_rows(P.in[0], P.in[1], (bf16_t*)(ws + WS_XN), nullptr);
    tconv(P.in[2], DM, DFF, DFF, (bf16_t*)(ws + WS_W13A), 1, tile);
    tconv(P.in[3], DM, DFF, DFF, (bf16_t*)(ws + WS_W13A), 2, tile);
    tconv(P.in[4], DFF, DM, DM, (bf16_t*)(ws + WS_W2A), 0, tile);
    tconv(P.in[6], DM, 3608, NPROJ, (bf16_t*)(ws + WS_WIN), 0, tile, P.in[5]);
    tconv(P.in[8], 4096, 128, 128, (bf16_t*)(ws + WS_CW1K), 0, tile);
    tconv(P.in[12], 4096, 128, 128, (bf16_t*)(ws + WS_CW1V), 0, tile);
    tconv(P.in[10], 128, 128, 128, (bf16_t*)(ws + WS_CW2K), 0, tile);
    tconv(P.in[14], 128, 128, 128, (bf16_t*)(ws + WS_CW2V), 0, tile);
    tconv(P.in[24], 1024, 1024, 1024, (bf16_t*)(ws + WS_GLUW), 0, tile);
    tconv(P.in[26], DM, DM, DM, (bf16_t*)(ws + WS_WOUT), 0, tile);
    tconv(P.in[28], DM, DFF, DFF, (bf16_t*)(ws + WS_W13B), 1, tile, P.in[27]);
    tconv(P.in[29], DM, DFF, DFF, (bf16_t*)(ws + WS_W13B), 2, tile, P.in[27]);
    tconv(P.in[30], DFF, DM, DM, (bf16_t*)(ws + WS_W2B), 0, tile);
}

DI void compress_item(const Params& P, int item, unsigned char* smem) {
    unsigned char* ws = P.ws; const int tid = threadIdx.x, wid = tid >> 6, lane = tid & 63, r = lane & 15, q = lane >> 4;
    const int which = item / 127, rt = item % 127;
    const bf16_t* proj = (const bf16_t*)(ws + WS_PROJ);
    const bf16_t* w1t = (const bf16_t*)(ws + (which ? WS_CW1V : WS_CW1K));
    const bf16_t* w2t = (const bf16_t*)(ws + (which ? WS_CW2V : WS_CW2K));
    const float* cb1 = (const float*)(ws + WS_SMALL) + SM_CB1 + which * 128;
    float* part = (float*)smem;
    bf16_t* hid = (bf16_t*)(smem + 65536);
    const int grow = rt * 16 + r, bg = grow / 127, c = grow % 127, b = bg >> 1, g = bg & 1;
    const bf16_t* arow = proj + (size_t)(b * TT + 16 * c) * NPROJ + (which ? C_VC : C_KC) + g * 128;
    f32x4 acc[8];
#pragma unroll
    for (int ct = 0; ct < 8; ++ct) acc[ct] = (f32x4){0.f, 0.f, 0.f, 0.f};
    bf16x8 fa[2], fb[2][8];
#define CP_LOAD(buf, s_) do { const int kabs_ = 512 * wid + 32 * (s_) + 8 * q; fa[buf] = *(const bf16x8*)(arow + (size_t)(kabs_ >> 7) * NPROJ + (kabs_ & 127)); \
        _Pragma("unroll") for (int ct = 0; ct < 8; ++ct) fb[buf][ct] = *(const bf16x8*)(w1t + (size_t)(ct * 16 + r) * 4096 + kabs_); } while (0)
    CP_LOAD(0, 0);
#pragma unroll
    for (int s = 0; s < 16; ++s) {
        if (s + 1 < 16) CP_LOAD((s + 1) & 1, s + 1);
        __builtin_amdgcn_sched_barrier(0);
#pragma unroll
        for (int ct = 0; ct < 8; ++ct) acc[ct] = __builtin_amdgcn_mfma_f32_16x16x32_bf16(fa[s & 1], fb[s & 1][ct], acc[ct], 0, 0, 0);
        __builtin_amdgcn_sched_barrier(0);
    }
#undef CP_LOAD
#pragma unroll
    for (int ct = 0; ct < 8; ++ct)
#pragma unroll
        for (int j = 0; j < 4; ++j) part[(wid * 16 + 4 * q + j) * 128 + ct * 16 + r] = acc[ct][j];
    __syncthreads();
    { const int row = tid >> 5, c4 = (tid & 31) * 4; f32x4 s = *(const f32x4*)(cb1 + c4);
#pragma unroll
      for (int w = 0; w < 8; ++w) s += *(const f32x4*)(part + (w * 16 + row) * 128 + c4);
      u32x2 o; o.x = pk2(gelu_tanh(s[0]), gelu_tanh(s[1])); o.y = pk2(gelu_tanh(s[2]), gelu_tanh(s[3]));
      *(u32x2*)(hid + row * 136 + c4) = o; }
    __syncthreads();
    { f32x4 a2 = {0.f, 0.f, 0.f, 0.f};
#pragma unroll
      for (int s = 0; s < 4; ++s) { const bf16x8 a = *(const bf16x8*)(hid + r * 136 + 32 * s + 8 * q);
          const bf16x8 bb = *(const bf16x8*)(w2t + (size_t)(16 * wid + r) * 128 + 32 * s + 8 * q);
          a2 = __builtin_amdgcn_mfma_f32_16x16x32_bf16(a, bb, a2, 0, 0, 0); }
      bf16_t* kcb = (bf16_t*)(ws + WS_KCB); bf16_t* vcbt = (bf16_t*)(ws + WS_VCBT);
#pragma unroll
      for (int j = 0; j < 4; ++j) { const int gr = rt * 16 + 4 * q + j, bg2 = gr / 127, c2 = gr % 127, col = 16 * wid + r;
          const bf16_t v = (bf16_t)(pk2(a2[j], 0.f) & 0xffffu);
          if (which == 0) kcb[(size_t)(bg2 * 128 + c2) * 128 + col] = v; else vcbt[(size_t)(bg2 * 128 + col) * 128 + c2] = v; } }
    __syncthreads();
}

DI void s5_bu16(const bf16x8 ub, const bf16x8 (&af)[8], float* buf, int r, int q) {
#pragma unroll
    for (int pt = 0; pt < 8; ++pt) { f32x4 d = {0.f, 0.f, 0.f, 0.f}; d = __builtin_amdgcn_mfma_f32_16x16x32_bf16(af[pt], ub, d, 0, 0, 0);
#pragma unroll
        for (int j = 0; j < 4; ++j) buf[(16 * pt + 4 * q + j) * 17 + r] = d[j]; }
}
DI void s5_pass1_item(const Params& P, int bitem, unsigned char* smem) {
    int tid_ = threadIdx.x; asm volatile("" : "+v"(tid_));
    unsigned char* ws = P.ws; const int tid = tid_, wid = tid >> 6, lane = tid & 63, r = lane & 15, q = lane >> 4;
    const int item = bitem * 8 + wid, ch = item & 31, grp = (item >> 5) & 63, b = item >> 11;
    const bf16_t* proj = (const bf16_t*)(ws + WS_PROJ); const float* sm = (const float*)(ws + WS_SMALL);
    float* buf = (float*)smem + wid * 2176;
    const bf16_t* tb = (const bf16_t*)(sm + SM_BB);
    bf16x8 af[8];
#pragma unroll
    for (int pt = 0; pt < 8; ++pt) af[pt] = *(const bf16x8*)(tb + (grp * 128 + 16 * pt + r) * 32 + 8 * q);
    const f32x4 ab = *(const f32x4*)(sm + SM_AB + (grp * 64 + lane) * 4);
    const bf16_t* ubase = proj + (size_t)(b * TT + ch * 64) * NPROJ + C_SSM + grp * 16;
    float xr = 0.f, xi = 0.f;
    bf16x8 ubs[4];
#pragma unroll
    for (int sub = 0; sub < 4; ++sub) ubs[sub] = *(const bf16x8*)(ubase + (size_t)(sub * 16 + r) * NPROJ + 8 * (q & 1));
#pragma unroll
    for (int sub = 0; sub < 4; ++sub) {
        s5_bu16(ubs[sub], af, buf, r, q);
        asm volatile("s_waitcnt lgkmcnt(0)" ::: "memory");
#pragma unroll
        for (int tt = 0; tt < 16; ++tt) { const float bur = buf[lane * 17 + tt], bui = buf[(64 + lane) * 17 + tt];
            const float nxr = ab[0] * xr - ab[1] * xi + bur, nxi = ab[0] * xi + ab[1] * xr + bui; xr = nxr; xi = nxi; }
        asm volatile("s_waitcnt lgkmcnt(0)" ::: "memory");
    }
    f32x2_t e = {xr, xi};
    *(f32x2_t*)(ws + WS_S5END + ((size_t)((b * 64 + grp) * 32 + ch) * 64 + lane) * 8) = e;
}

DI void vtrans_item(const Params& P, int item, unsigned char* smem) {
    unsigned char* ws = P.ws; const int tid = threadIdx.x;
    const int tokblk = item >> 3, cseg = item & 7, tok0 = tokblk * 64, b = tok0 >> 11, t0 = tok0 & 2047;
    const int col = (cseg < 4 ? C_VS + cseg * 64 : C_VW + (cseg - 4) * 64), g = (cseg & 3) >> 1, d0 = (cseg & 1) * 64;
    const bf16_t* proj = (const bf16_t*)(ws + WS_PROJ);
    bf16_t* dst = (bf16_t*)(ws + (cseg < 4 ? WS_VTS : WS_VTW)) + (size_t)((b * 2 + g) * 128 + d0) * TT + t0;
    bf16_t* tl = (bf16_t*)smem;
    { const int r = tid >> 3, sg = tid & 7; *(u32x4*)(tl + r * 72 + sg * 8) = *(const u32x4*)(proj + (size_t)(tok0 + r) * NPROJ + col + sg * 8); }
    __syncthreads();
    { const int d = tid >> 3, tsg = tid & 7; unsigned v[8];
#pragma unroll
      for (int j = 0; j < 8; ++j) v[j] = tl[(tsg * 8 + j) * 72 + d];
      u32x4 w; w.x = v[0] | (v[1] << 16); w.y = v[2] | (v[3] << 16); w.z = v[4] | (v[5] << 16); w.w = v[6] | (v[7] << 16);
      *(u32x4*)(dst + (size_t)d * TT + tsg * 8) = w; }
    __syncthreads();
}

DI void s5_pass3_item(const Params& P, int bitem, unsigned char* smem) {
    int tid_ = threadIdx.x; asm volatile("" : "+v"(tid_));
    unsigned char* ws = P.ws; const int tid = tid_, wid = tid >> 6, lane = tid & 63, r = lane & 15, q = lane >> 4;
    const int item = bitem * 8 + wid, ch = item & 31, grp = (item >> 5) & 63, b = item >> 11;
    const bf16_t* proj = (const bf16_t*)(ws + WS_PROJ); const float* sm = (const float*)(ws + WS_SMALL);
    float* xs = (float*)smem + wid * 2176;
    bf16_t* HG = (bf16_t*)(ws + WS_HG);
    const bf16_t* tb = (const bf16_t*)(sm + SM_BB);
    bf16x8 af[8];
#pragma unroll
    for (int pt = 0; pt < 8; ++pt) af[pt] = *(const bf16x8*)(tb + (grp * 128 + 16 * pt + r) * 32 + 8 * q);
    const f32x4 ab = *(const f32x4*)(sm + SM_AB + (grp * 64 + lane) * 4);
    float cB[32];
    { const float* cre = P.in[21] + (size_t)(grp * 16 + r) * 64; const float* cim = P.in[22] + (size_t)(grp * 16 + r) * 64;
#pragma unroll
      for (int i = 0; i < 32; ++i) { const int k = 4 * i + q; cB[i] = (i < 16) ? cre[k] : -cim[k - 64]; } }
    const float dsk = P.in[23][grp * 16 + r];
    const bf16_t* ubase = proj + (size_t)(b * TT + ch * 64) * NPROJ + C_SSM + grp * 16;
    bf16x8 ubs[4]; unsigned short uvs[4][4];
#pragma unroll
    for (int sub = 0; sub < 4; ++sub) { ubs[sub] = *(const bf16x8*)(ubase + (size_t)(sub * 16 + r) * NPROJ + 8 * (q & 1));
#pragma unroll
        for (int j = 0; j < 4; ++j) uvs[sub][j] = ubase[(size_t)(sub * 16 + 4 * q + j) * NPROJ + r]; }
    float xr = 0.f, xi = 0.f;
    {
      const f32x2_t* e = (const f32x2_t*)(ws + WS_S5END) + (size_t)((b * 64 + grp) * 32) * 64 + lane;
      f32x2_t ev[31];
#pragma unroll
      for (int j = 0; j < 31; ++j) ev[j] = e[(j < ch ? j : 0) * 64];
#pragma unroll
      for (int j = 0; j < 31; ++j) { const float ex = j < ch ? ev[j][0] : 0.f, ey = j < ch ? ev[j][1] : 0.f;
          const float ncr = ab[2] * xr - ab[3] * xi + ex, nci = ab[2] * xi + ab[3] * xr + ey; xr = j < ch ? ncr : xr; xi = j < ch ? nci : xi; } }
#pragma unroll
    for (int sub = 0; sub < 4; ++sub) {
        s5_bu16(ubs[sub], af, xs, r, q);
        float uv[4];
#pragma unroll
        for (int j = 0; j < 4; ++j) uv[j] = bf2f(uvs[sub][j]);
        asm volatile("s_waitcnt lgkmcnt(0)" ::: "memory");
#pragma unroll
        for (int tt = 0; tt < 16; ++tt) { const float bur = xs[lane * 17 + tt], bui = xs[(64 + lane) * 17 + tt];
            const float nxr = ab[0] * xr - ab[1] * xi + bur, nxi = ab[0] * xi + ab[1] * xr + bui; xr = nxr; xi = nxi;
            xs[lane * 17 + tt] = xr; xs[(64 + lane) * 17 + tt] = xi; }
        asm volatile("s_waitcnt lgkmcnt(0)" ::: "memory");
        f32x4 ya[4];
#pragma unroll
        for (int j = 0; j < 4; ++j) ya[j] = (f32x4){0.f, 0.f, 0.f, 0.f};
#pragma unroll
        for (int i = 0; i < 32; ++i) { const float a = xs[(4 * i + q) * 17 + r]; ya[i & 3] = __builtin_amdgcn_mfma_f32_16x16x4f32(a, cB[i], ya[i & 3], 0, 0, 0); }
        const f32x4 y = (ya[0] + ya[1]) + (ya[2] + ya[3]);
#pragma unroll
        for (int j = 0; j < 4; ++j) { const int tl = sub * 16 + 4 * q + j; const float v = y[j] + dsk * uv[j];
            HG[(size_t)(b * TT + ch * 64 + tl) * 1024 + grp * 16 + r] = (bf16_t)(pk2(gelu_tanh(v), 0.f) & 0xffffu); }
        asm volatile("s_waitcnt lgkmcnt(0)" ::: "memory");
    }
}

DI float xor32_max(float x) { const auto r_ = __builtin_amdgcn_permlane32_swap(__float_as_uint(x), __float_as_uint(x), false, false); return fmaxf(__uint_as_float(r_[0]), __uint_as_float(r_[1])); }
DI float xor32_sum(float x) { const auto r_ = __builtin_amdgcn_permlane32_swap(__float_as_uint(x), __float_as_uint(x), false, false); return __uint_as_float(r_[0]) + __uint_as_float(r_[1]); }
#define MFMA32(a, b, c) __builtin_amdgcn_mfma_f32_32x32x16_bf16((a), (b), (c), 0, 0, 0)
DI bf16x8 ld2x4(const bf16_t* p0) { const s16x4 a = *(const s16x4*)p0, b = *(const s16x4*)(p0 + 8); return __builtin_shufflevector(a, b, 0, 1, 2, 3, 4, 5, 6, 7); }
DI bf16x8 packp(const f32x16& x, int s) { u32x4 p; p.x = pk2(x[8 * s], x[8 * s + 1]); p.y = pk2(x[8 * s + 2], x[8 * s + 3]); p.z = pk2(x[8 * s + 4], x[8 * s + 5]); p.w = pk2(x[8 * s + 6], x[8 * s + 7]); return __builtin_bit_cast(bf16x8, p); }
DI int crow(int i, int hh) { return (i & 3) + 8 * (i >> 2) + 4 * hh; }

constexpr int A_STG = 0;
constexpr int A_BUF = 34816, A_VOFF = 17408;
constexpr int A_IMPM = 69632, A_IMPS = A_IMPM + 33792, A_IMPV = A_IMPS + 33792, A_LUT = A_IMPV + 8192, A_SELM = A_LUT + 4096;
DI bf16x8 lds2x4(const unsigned char* p) { const s16x4 a = *(const s16x4*)p, b = *(const s16x4*)(p + 16); return __builtin_shufflevector(a, b, 0, 1, 2, 3, 4, 5, 6, 7); }

constexpr float QK_C1 = 0.08838834764831845f * 1.4426950408889634f;
template <int MODE, bool FAR>
DI void attn_tile(const unsigned char* kl  , const unsigned char* vl  ,
                  int k0, int tq, int r, int hh, bool bit, const bf16x8 (&qf)[8], const float* lutH, f32x16 (&o)[4], float& m, float& l) {
    f32x16 s;
#pragma unroll
    for (int i = 0; i < 16; ++i) s[i] = 0.f;
    const unsigned char* kp = kl + r * 272 + 16 * hh;
#pragma unroll
    for (int kk = 0; kk < 8; ++kk) { const bf16x8 a = *(const bf16x8*)(kp + 32 * kk); s = MFMA32(a, qf[kk], s); }
    float tmax = NEGF;
    if (FAR) {
        const float b31 = lutH[255];
#pragma unroll
        for (int i = 0; i < 16; ++i) { const float v = s[i] * QK_C1 + b31; s[i] = (MODE == 0 && !bit) ? NEGF : v; tmax = fmaxf(tmax, s[i]); }
    } else {
#pragma unroll
        for (int i = 0; i < 16; ++i) { const int dist = tq - (k0 + crow(i, hh));
            const bool valid = MODE == 0 ? (bit && dist >= 0) : (dist >= 0 && dist < 512);
            const int di = dist < 0 ? 0 : (dist > 255 ? 255 : dist);
            const float v = s[i] * QK_C1 + lutH[di];
            s[i] = valid ? v : NEGF; tmax = fmaxf(tmax, s[i]); }
    }
    tmax = xor32_max(tmax);
    const float mnew = fmaxf(m, tmax);
    if (__ballot(mnew != m) != 0ull) {
        const float alpha = __builtin_amdgcn_exp2f(m - mnew);
        l *= alpha; m = mnew;
#pragma unroll
        for (int dt = 0; dt < 4; ++dt)
#pragma unroll
            for (int i = 0; i < 16; ++i) o[dt][i] *= alpha;
    }
    float psum = 0.f;
    if (FAR) {
#pragma unroll
        for (int i = 0; i < 16; ++i) { const float p = __builtin_amdgcn_exp2f(s[i] - mnew); s[i] = p; psum += p; }
    } else {
#pragma unroll
        for (int i = 0; i < 16; ++i) { const float p = (s[i] > -1e29f) ? __builtin_amdgcn_exp2f(s[i] - mnew) : 0.f; s[i] = p; psum += p; }
    }
    psum = xor32_sum(psum);
    l += psum;
    const unsigned char* vp = vl + r * 136 + 8 * hh;
#pragma unroll
    for (int s2 = 0; s2 < 2; ++s2) { const bf16x8 pb = packp(s, s2);
#pragma unroll
        for (int dt = 0; dt < 4; ++dt) { const bf16x8 a = lds2x4(vp + dt * (32 * 136) + 32 * s2); o[dt] = MFMA32(a, pb, o[dt]); } }
}

template <int MODE>
DI void attn_tile64_far(const unsigned char* bp  , int r, int hh, bool bit, const bf16x8 (&qf)[8], const float* lutH, f32x16 (&o)[4], float& m, float& l) {
    f32x16 s0, s1;
#pragma unroll
    for (int i = 0; i < 16; ++i) { s0[i] = 0.f; s1[i] = 0.f; }
    const unsigned char* kp = bp + r * 272 + 16 * hh;
#pragma unroll
    for (int kk = 0; kk < 8; ++kk) { const bf16x8 a0 = *(const bf16x8*)(kp + 32 * kk), a1 = *(const bf16x8*)(kp + 32 * 272 + 32 * kk); s0 = MFMA32(a0, qf[kk], s0); s1 = MFMA32(a1, qf[kk], s1); }
    const float b31 = lutH[255];
    float tmax = NEGF;
#pragma unroll
    for (int i = 0; i < 16; ++i) { const float v0 = s0[i] * QK_C1 + b31, v1 = s1[i] * QK_C1 + b31;
        s0[i] = (MODE == 0 && !bit) ? NEGF : v0; s1[i] = (MODE == 0 && !bit) ? NEGF : v1; tmax = fmaxf(tmax, fmaxf(s0[i], s1[i])); }
    tmax = xor32_max(tmax);
    const float mnew = fmaxf(m, tmax);
    if (__ballot(mnew != m) != 0ull) {
        const float alpha = __builtin_amdgcn_exp2f(m - mnew);
        l *= alpha; m = mnew;
#pragma unroll
        for (int dt = 0; dt < 4; ++dt)
#pragma unroll
            for (int i = 0; i < 16; ++i) o[dt][i] *= alpha;
    }
    float psum = 0.f;
#pragma unroll
    for (int i = 0; i < 16; ++i) { const float p0 = __builtin_amdgcn_exp2f(s0[i] - mnew), p1 = __builtin_amdgcn_exp2f(s1[i] - mnew); s0[i] = p0; s1[i] = p1; psum += p0 + p1; }
    l += xor32_sum(psum);
    const unsigned char* vp = bp + A_VOFF + r * 136 + 8 * hh;
#pragma unroll
    for (int s2 = 0; s2 < 2; ++s2) { const bf16x8 pb0 = packp(s0, s2), pb1 = packp(s1, s2);
#pragma unroll
        for (int dt = 0; dt < 4; ++dt) { const bf16x8 a0 = lds2x4(vp + dt * (32 * 136) + 32 * s2), a1 = lds2x4(vp + dt * (32 * 136) + 64 + 32 * s2);
            o[dt] = MFMA32(a0, pb0, o[dt]); o[dt] = MFMA32(a1, pb1, o[dt]); } }
}

template <int MODE>
DI void attn_branch(unsigned char* smem, const bf16_t* kb  , const bf16_t* vt  , unsigned need, unsigned mymask,
                    int t0w, int tq, int r, int hh, const bf16x8 (&qf)[8], const float* lutH, f32x16 (&o)[4], float& m, float& l) {
    int tid = threadIdx.x; asm volatile("" : "+v"(tid));
    if (need == 0u) return;
    u32x4 kreg[2], vreg[2];
    const int krow0 = tid >> 4, kcc = tid & 15, vd0 = tid >> 3, vcc = tid & 7;
#define AB_LOAD(j) do { _Pragma("unroll") for (int e = 0; e < 2; ++e) { \
        kreg[e] = *(const u32x4*)(kb + (size_t)(64 * (j) + krow0 + 32 * e) * NPROJ + kcc * 8); \
        vreg[e] = *(const u32x4*)(vt + (size_t)(vd0 + 64 * e) * TT + 64 * (j) + vcc * 8); } } while (0)
#define AB_STORE(buf) do { unsigned char* bp_ = smem + A_STG + (buf) * A_BUF; _Pragma("unroll") for (int e = 0; e < 2; ++e) { \
        *(u32x4*)(bp_ + (krow0 + 32 * e) * 272 + kcc * 16) = kreg[e]; \
        unsigned char* vp_ = bp_ + A_VOFF + (vd0 + 64 * e) * 136 + vcc * 16; \
        *(u32x2*)vp_ = (u32x2){vreg[e].x, vreg[e].y}; *(u32x2*)(vp_ + 8) = (u32x2){vreg[e].z, vreg[e].w}; } } while (0)
    int j = __builtin_ctz(need); need &= need - 1u;
    AB_LOAD(j); AB_STORE(0);
    __syncthreads();
    int n = 0;
    for (;;) {
        const bool has_next = need != 0u;
        int jn = 0;
        if (has_next) { jn = __builtin_ctz(need); need &= need - 1u; AB_LOAD(jn); }
        const unsigned char* bp = smem + A_STG + (n & 1) * A_BUF;
        const bool bit = MODE == 0 ? ((mymask >> j) & 1u) : true;
        const bool any = MODE == 0 ? (__ballot(bit) != 0ull) : true;
        const bool far64 = any && (64 * j + 63 + 128 <= t0w) && (MODE == 0 || 64 * j >= t0w + 31 - 511);
        if (far64) attn_tile64_far<MODE>(bp, r, hh, bit, qf, lutH, o, m, l);
        else {
#pragma unroll 1
        for (int half = 0; half < 2; ++half) { const int k0 = 64 * j + 32 * half;
            bool act = any && (k0 <= t0w + 31);
            if (MODE == 1) act = act && (k0 + 31 + 511 >= t0w);
            const bool far = (k0 + 31 + 128 <= t0w) && (MODE == 0 || k0 >= t0w + 31 - 511);
            if (act) { if (far) attn_tile<MODE, true>(bp + half * (32 * 272), bp + A_VOFF + half * 64, k0, tq, r, hh, bit, qf, lutH, o, m, l);
                       else attn_tile<MODE, false>(bp + half * (32 * 272), bp + A_VOFF + half * 64, k0, tq, r, hh, bit, qf, lutH, o, m, l); } }
        }
        if (has_next) AB_STORE((n + 1) & 1);
        __syncthreads();
        if (!has_next) break;
        j = jn; ++n;
    }
#undef AB_LOAD
#undef AB_STORE
}

DI void attn_item(const Params& P, int item, unsigned char* smem) {
    int tid_ = threadIdx.x; asm volatile("" : "+v"(tid_));
    unsigned char* ws = P.ws; const int tid = tid_, wid = tid >> 6, lane = tid & 63, r = lane & 31, hh = lane >> 5;
    const int bg = item & 15, qt = 31 - (item >> 4), b = bg >> 1, g = bg & 1, t0 = qt * 64;
    const int hg = wid >> 1, t0w = t0 + 32 * (wid & 1), tq = t0w + r, head = g * 4 + hg, qloc = 32 * (wid & 1) + r;
    if (__builtin_amdgcn_readfirstlane(wid) < 4) __builtin_amdgcn_s_setprio(3); else __builtin_amdgcn_s_setprio(0);
    const bf16_t* proj = (const bf16_t*)(ws + WS_PROJ);
    float* outs = (float*)(ws + WS_OUTS) + ((size_t)blockIdx.x * 8 + wid) * 4096;
    float* impM = (float*)(smem + A_IMPM); float* impS = (float*)(smem + A_IMPS); float* impv = (float*)(smem + A_IMPV);
    float* lut = (float*)(smem + A_LUT); unsigned* selm = (unsigned*)(smem + A_SELM);
    for (int i = tid; i < 1024; i += 512) { const int h4 = i >> 8, n = i & 255; int bk;
        if (n < 16) bk = n; else { bk = 16 + (int)(logf((float)n / 16.0f) / 2.0794415416798357f * 16.0f); bk = bk > 31 ? 31 : bk; }
        lut[i] = P.in[15][bk * 8 + g * 4 + h4] * 1.4426950408889634f; }
    { const bf16_t* kcb = (const bf16_t*)(ws + WS_KCB) + (size_t)bg * 16384; const bf16_t* vcbt = (const bf16_t*)(ws + WS_VCBT) + (size_t)bg * 16384;
#pragma unroll
      for (int e = 0; e < 4; ++e) { const int id = tid + 512 * e, row = id >> 4, cc = id & 15;
          *(u32x4*)(smem + A_STG + row * 272 + cc * 16) = *(const u32x4*)(kcb + row * 128 + cc * 8);
          *(u32x4*)(smem + A_STG + A_BUF + row * 272 + cc * 16) = *(const u32x4*)(vcbt + row * 128 + cc * 8); } }
    bf16x8 qf[8];
    { const bf16_t* qrow = proj + (size_t)(b * TT + tq) * NPROJ + head * 128 + 8 * hh;
#pragma unroll
      for (int kk = 0; kk < 8; ++kk) qf[kk] = *(const bf16x8*)(qrow + 16 * kk); }
    __syncthreads();
    const float* lutH = lut + hg * 256;
    f32x16 oc[4];
    {
        const unsigned char* kl = smem + A_STG + r * 272 + 16 * hh;
        const unsigned char* vl = smem + A_STG + A_BUF + r * 272 + 8 * hh;
        float mx = NEGF, sum = 0.f;
#pragma unroll 1
        for (int kt = 0; kt < 4; ++kt) {
            f32x16 sc;
#pragma unroll
            for (int i = 0; i < 16; ++i) sc[i] = 0.f;
#pragma unroll
            for (int kk = 0; kk < 8; ++kk) { const bf16x8 a = *(const bf16x8*)(kl + kt * (32 * 272) + 32 * kk); sc = MFMA32(a, qf[kk], sc); }
            float tmax = NEGF;
#pragma unroll
            for (int i = 0; i < 16; ++i) { const int c = 32 * kt + crow(i, hh), dist = tq - (16 * c + 31);
                const int di = dist < 0 ? 0 : (dist > 255 ? 255 : dist);
                const float v = sc[i] * QK_C1 + lutH[di];
                sc[i] = (dist >= 0 && c < 127) ? v : NEGF; tmax = fmaxf(tmax, sc[i]); }
            tmax = xor32_max(tmax);
            const float mnew = fmaxf(mx, tmax); float ps = 0.f;
#pragma unroll
            for (int i = 0; i < 16; ++i) ps += (sc[i] > -1e29f) ? __builtin_amdgcn_exp2f(sc[i] - mnew) : 0.f;
            ps = xor32_sum(ps);
            sum = sum * __builtin_amdgcn_exp2f(mx - mnew) + ps; mx = mnew;
        }
        const float inv = 1.0f / fmaxf(sum, 1e-30f);
#pragma unroll
        for (int dt = 0; dt < 4; ++dt)
#pragma unroll
            for (int i = 0; i < 16; ++i) oc[dt][i] = 0.f;
#pragma unroll 1
        for (int kt = 0; kt < 4; ++kt) {
            f32x16 sc;
#pragma unroll
            for (int i = 0; i < 16; ++i) sc[i] = 0.f;
#pragma unroll
            for (int kk = 0; kk < 8; ++kk) { const bf16x8 a = *(const bf16x8*)(kl + kt * (32 * 272) + 32 * kk); sc = MFMA32(a, qf[kk], sc); }
#pragma unroll
            for (int i = 0; i < 16; ++i) { const int c = 32 * kt + crow(i, hh), dist = tq - (16 * c + 31);
                const int di = dist < 0 ? 0 : (dist > 255 ? 255 : dist);
                const float v = sc[i] * QK_C1 + lutH[di];
                sc[i] = (dist >= 0 && c < 127) ? __builtin_amdgcn_exp2f(v - mx) * inv : 0.f; }
#pragma unroll
            for (int gi = 0; gi < 4; ++gi) { const int jb = 8 * kt + 2 * gi + hh; const float p3 = 0.5f * sc[4 * gi + 3];
                impM[(hg * 64 + qloc) * 33 + jb] = sc[4 * gi] + sc[4 * gi + 1] + sc[4 * gi + 2] + p3;
                impS[(hg * 64 + qloc) * 33 + jb] = p3; }
#pragma unroll
            for (int s2 = 0; s2 < 2; ++s2) { const bf16x8 pb = packp(sc, s2);
#pragma unroll
                for (int dt = 0; dt < 4; ++dt) { const bf16x8 a = lds2x4(vl + dt * (32 * 272) + 64 * kt + 32 * s2); oc[dt] = MFMA32(a, pb, oc[dt]); } }
        }
    }
    __syncthreads();
#pragma unroll 1
    for (int e = 0; e < 4; ++e) { const int idx = tid + 512 * e, qq = idx >> 5, j = idx & 31, t = t0 + qq, cur = t >> 6;
        float v = 0.f;
#pragma unroll
        for (int h = 0; h < 4; ++h) { v += impM[(h * 64 + qq) * 33 + j]; if (j > 0) v += impS[(h * 64 + qq) * 33 + j - 1]; }
        const bool forced = (j == 0) || (j == cur) || (j == cur - 1);
        impv[idx] = forced ? 1e6f : (j <= cur ? v : -1e9f); }
    __syncthreads();
#pragma unroll 1
    for (int e = 0; e < 4; ++e) { const int idx = tid + 512 * e, qq = idx >> 5, j = idx & 31;
        const float my = impv[idx]; int rank = 0;
#pragma unroll 8
        for (int j2 = 0; j2 < 32; ++j2) { const float o2 = impv[qq * 32 + j2]; rank += (o2 > my || (o2 == my && j2 < j)) ? 1 : 0; }
        const unsigned long long bal = __ballot(rank < 16);
        if (lane == 0) selm[qq] = (unsigned)bal; if (lane == 32) selm[qq] = (unsigned)(bal >> 32); }
    __syncthreads();
    float gc, gs, gw;
    { const bf16_t* gp = proj + (size_t)(b * TT + tq) * NPROJ + C_GATE + head * 3;
      gc = sigmoidf_(bf2f(gp[0])); gs = sigmoidf_(bf2f(gp[1])); gw = sigmoidf_(bf2f(gp[2])); }
    { float* outs1_ = outs + lane; asm volatile("" : "+v"(outs1_)); GAS float* outs1 = (GAS float*)outs1_;
#pragma unroll
    for (int dt = 0; dt < 4; ++dt)
#pragma unroll
        for (int i = 0; i < 16; ++i) outs1[(dt * 16 + i) * 64] = gc * oc[dt][i]; }
    const unsigned mymask = selm[qloc];
    unsigned uni = selm[lane];
#pragma unroll
    for (int o_ = 32; o_ >= 1; o_ >>= 1) uni |= (unsigned)__shfl_xor((int)uni, o_);
    uni = __builtin_amdgcn_readfirstlane(uni);
    f32x16 o[4]; float m, l;
    {
#pragma unroll
        for (int dt = 0; dt < 4; ++dt)
#pragma unroll
            for (int i = 0; i < 16; ++i) o[dt][i] = 0.f;
        m = NEGF; l = 0.f;
        const bf16_t* kb = proj + (size_t)(b * TT) * NPROJ + C_KS + g * 128;
        const bf16_t* vt = (const bf16_t*)(ws + WS_VTS) + (size_t)bg * 128 * TT;
        const unsigned need = uni & (qt == 31 ? 0xffffffffu : ((1u << (qt + 1)) - 1u));
        attn_branch<0>(smem, kb, vt, need, mymask, t0w, tq, r, hh, qf, lutH, o, m, l);
        const float sc = gs / fmaxf(l, 1e-30f);
        float* outs2_ = outs + lane; asm volatile("" : "+v"(outs2_)); GAS float* outs2 = (GAS float*)outs2_;
        f32x16 pv[4];
#pragma unroll
        for (int dt = 0; dt < 4; ++dt)
#pragma unroll
            for (int i = 0; i < 16; ++i) pv[dt][i] = outs2[(dt * 16 + i) * 64];
        __builtin_amdgcn_sched_barrier(0);
#pragma unroll
        for (int dt = 0; dt < 4; ++dt)
#pragma unroll
            for (int i = 0; i < 16; ++i) outs2[(dt * 16 + i) * 64] = pv[dt][i] + sc * o[dt][i];
    }
    {
#pragma unroll
        for (int dt = 0; dt < 4; ++dt)
#pragma unroll
            for (int i = 0; i < 16; ++i) o[dt][i] = 0.f;
        m = NEGF; l = 0.f;
        const bf16_t* kb = proj + (size_t)(b * TT) * NPROJ + C_KW + g * 128;
        const bf16_t* vt = (const bf16_t*)(ws + WS_VTW) + (size_t)bg * 128 * TT;
        const int jlo = qt >= 8 ? qt - 8 : 0;
        const unsigned need = (qt == 31 ? 0xffffffffu : ((1u << (qt + 1)) - 1u)) & ~((1u << jlo) - 1u);
        attn_branch<1>(smem, kb, vt, need, 0u, t0w, tq, r, hh, qf, lutH, o, m, l);
        const float sc = gw / fmaxf(l, 1e-30f);
        float* outs3_ = outs + lane; asm volatile("" : "+v"(outs3_)); GAS float* outs3 = (GAS float*)outs3_;
        bf16_t* as = (bf16_t*)(ws + WS_AS) + (size_t)(b * TT + tq) * DM + head * 128;
        f32x16 pv[4];
#pragma unroll
        for (int dt = 0; dt < 4; ++dt)
#pragma unroll
            for (int i = 0; i < 16; ++i) pv[dt][i] = outs3[(dt * 16 + i) * 64];
        __builtin_amdgcn_sched_barrier(0);
#pragma unroll
        for (int dt = 0; dt < 4; ++dt)
#pragma unroll
            for (int gi = 0; gi < 4; ++gi) { float v[4];
#pragma unroll
                for (int j = 0; j < 4; ++j) { const int i = 4 * gi + j; v[j] = pv[dt][i] + sc * o[dt][i]; }
                u32x2 w; w.x = pk2(v[0], v[1]); w.y = pk2(v[2], v[3]);
                *(u32x2*)(as + 32 * dt + 8 * gi + 4 * hh) = w; }
    }
    __builtin_amdgcn_s_setprio(0);
}

DI void fill_rstd(const pg8::StaticOrder& S, const float* ss, unsigned char* smem) {
    float* rl = (float*)(smem + 131072);
    for (int i = 0; i < 16; ++i) { pg8::Unit u; if (!S.next(i, u)) break;
        if (threadIdx.x < 256) rl[i * 256 + threadIdx.x] = 1.0f / sqrtf(ss[u.pm * 256 + threadIdx.x] * (1.0f / DM) + EPSN); }
    __syncthreads();
}

#define XB_TMO      128
#define XB_XCNT(j)  (256  + 64 * (j))
#define XB_XSUB(j)  (1280 + 64 * (j))
#define XB_XGEN(j)  (2304 + 64 * (j))
#define XB_TOP      3328
#define XB_TOPGEN   3392
#define XCD_BAR_WORDS 3456
#define XB_SPIN_CAP (1u << 18)
DI unsigned xb_ld(unsigned* p)              { return __hip_atomic_load(p, __ATOMIC_RELAXED, __HIP_MEMORY_SCOPE_AGENT); }
DI unsigned xb_add(unsigned* p, unsigned v) { return __hip_atomic_fetch_add(p, v, __ATOMIC_RELAXED, __HIP_MEMORY_SCOPE_AGENT); }
DI unsigned xb_xcc_id() { return (unsigned)__builtin_amdgcn_s_getreg((3 << 11) | 20) & 0xFu; }
#define XB_SPIN(cond, bar) do { unsigned _sp = 0; while (cond) { __builtin_amdgcn_s_sleep(1); \
    if ((++_sp & 255u) == 0u) { if (xb_ld(&(bar)[XB_TMO])) break; if (_sp > XB_SPIN_CAP) { atomicAdd(&(bar)[XB_TMO], 1u); break; } } } } while (0)
struct XcdBarrier { unsigned* bar; unsigned x; volatile LAS unsigned* st; };
DI XcdBarrier xcd_barrier_post(unsigned* bar, volatile LAS unsigned* st) {
    XcdBarrier b; b.bar = bar; b.x = xb_xcc_id(); b.st = st;
    if (threadIdx.x == 0) (void)xb_add(&bar[XB_XCNT(b.x)], 1u);
    return b;
}
DI void xcd_barrier_complete(unsigned* bar, unsigned x, unsigned& nloc, unsigned& nx) {
    const unsigned G = gridDim.x * gridDim.y * gridDim.z;
    unsigned sum, cnt, mine, sp = 0u;
    for (;;) {
        sum = 0u; cnt = 0u; mine = 0u;
#pragma unroll
        for (unsigned j = 0; j < 16; ++j) { const unsigned c = xb_ld(&bar[XB_XCNT(j)]); sum += c; cnt += (c > 0u) ? 1u : 0u; mine = (j == x) ? c : mine; }
        if (sum == G) break;
        __builtin_amdgcn_s_sleep(1);
        if ((++sp & 255u) == 0u) { if (xb_ld(&bar[XB_TMO])) break; if (sp > XB_SPIN_CAP) { atomicAdd(&bar[XB_TMO], 1u); break; } }
    }
    nloc = mine > 0u ? mine : 1u; nx = cnt > 0u ? cnt : 1u;
}
DI void xcd_barrier(const XcdBarrier& b) {
    asm volatile("s_waitcnt vmcnt(0)" ::: "memory");
    __syncthreads();
    if (threadIdx.x == 0) {
        unsigned* bar = b.bar;
        __builtin_amdgcn_s_waitcnt(0);
        unsigned nloc = b.st[0], nx = b.st[1];
        if (nloc == 0u) { xcd_barrier_complete(bar, b.x, nloc, nx); b.st[0] = nloc; b.st[1] = nx; }
        const unsigned old = xb_add(&bar[XB_XSUB(b.x)], 1u);
        const unsigned gen = old / nloc;
        if (old + 1u == (gen + 1u) * nloc) {
            __builtin_amdgcn_fence(__ATOMIC_RELEASE, "agent");
            asm volatile("s_waitcnt vmcnt(0)" ::: "memory");
            const unsigned og = xb_add(&bar[XB_TOP], 1u);
            const unsigned tg = og / nx;
            if (og + 1u == (tg + 1u) * nx) xb_add(&bar[XB_TOPGEN], 1u);
            else XB_SPIN(xb_ld(&bar[XB_TOPGEN]) == tg, bar);
            __builtin_amdgcn_fence(__ATOMIC_ACQUIRE, "agent");
            xb_add(&bar[XB_XGEN(b.x)], 1u);
            asm volatile("s_waitcnt vmcnt(0)" ::: "memory");
        } else {
            XB_SPIN(xb_ld(&bar[XB_XGEN(b.x)]) == gen, bar);
            __builtin_amdgcn_fence(__ATOMIC_ACQUIRE, "agent");
            asm volatile("s_waitcnt vmcnt(0)" ::: "memory");
        }
    }
    __syncthreads();
}

__global__ void __launch_bounds__(512, 2) hymba_fwd(Params P) {
    extern __shared__ __attribute__((aligned(16))) unsigned char shm[];
    cg::grid_group grid = cg::this_grid();
    unsigned char* ws = P.ws;
    LAS unsigned char* lds = (LAS unsigned char*)shm;
    const int tid = threadIdx.x, G = gridDim.x;
    float* hres = P.out;
    const int lo = P.ph_lo, hi = P.ph_hi;
    volatile LAS unsigned* xbst = (volatile LAS unsigned*)(lds + L_CUR + 16);
    if (tid == 0) { xbst[0] = 0u; xbst[1] = 0u; }
    __syncthreads();
    const XcdBarrier xbar = xcd_barrier_post((unsigned*)((float*)(ws + WS_SMALL) + SM_BAR), xbst);
#define IN(k) (lo <= (k) && (k) < hi)
#define SYNC(k) do { if (IN(k) && IN((k) + 1)) { if (hi > 1000) grid.sync(); else xcd_barrier(xbar); } } while (0)
#ifndef DUP_PH
#define DUP_PH -1
#endif
#define REP(k) for (int rep_ = 0; rep_ < ((k) == DUP_PH ? 2 : 1); ++rep_, (((k) == DUP_PH && rep_ == 1) ? grid.sync() : (void)0))
    if (IN(0)) REP(0) phase_prep(P, shm);
    SYNC(0);
    if (IN(1)) REP(1) { pg8::Gemm g{(const bf16_t*)(ws + WS_XN), (const bf16_t*)(ws + WS_W13A), MTOK, 2 * DFF, DM};
        pg8::StaticOrder S; S.init(MTOK, 2 * DFF, G, (int)blockIdx.x); EpiSwiGLU E{(bf16_t*)(ws + WS_H), nullptr};
        pg8::gemm_phase<EpiSwiGLU, pg8::StaticOrder>(lds, g, S, E); }
    SYNC(1);
    if (IN(2)) REP(2) { pg8::Gemm g{(const bf16_t*)(ws + WS_H), (const bf16_t*)(ws + WS_W2A), MTOK, DM, DFF};
        pg8::StaticOrder S; S.init(MTOK, DM, G, (int)blockIdx.x); EpiResid<0> E{P.in[0], nullptr, nullptr, (bf16_t*)hres, (float*)(ws + WS_SMALL) + SM_SS, 0.5f};
        pg8::gemm_phase<EpiResid<0>, pg8::StaticOrder>(lds, g, S, E); }
    if (IN(2) && hi > 3) xcd_barrier(xbar);
    if (IN(4)) REP(4) {
        if (blockIdx.x == 0 && tid < 256) { float* sm = (float*)(ws + WS_SMALL); const int which = tid >> 7, n = tid & 127; float s = P.in[which ? 13 : 9][n];
            for (int c = 0; c < 128; ++c) s += sm[SM_CBP + (which * 128 + c) * 128 + n];
            sm[SM_CB1 + which * 128 + n] = s; }
        pg8::Gemm g{(const bf16_t*)hres, (const bf16_t*)(ws + WS_WIN), MTOK, NPROJ, DM};
        pg8::StaticOrder S; S.init(MTOK, NPROJ, G, (int)blockIdx.x); EpiProj E{(bf16_t*)(ws + WS_PROJ), (const float*)(ws + WS_SMALL) + SM_SS, (bf16_t*)(ws + WS_VTS), (bf16_t*)(ws + WS_VTW)}; fill_rstd(S, E.ss, shm);
        pg8::gemm_phase<EpiProj, pg8::StaticOrder>(lds, g, S, E); }
    SYNC(4);
    if (IN(5)) REP(5) {
        for (int it = blockIdx.x; it < 254 + 2048; it += G) {
            if (it < 254) compress_item(P, it, shm);
            else { s5_pass1_item(P, it - 254, shm); __syncthreads(); }
        } }
    SYNC(5);
    if (IN(6)) REP(6) {
        int* ctr = (int*)((float*)(ws + WS_SMALL) + SM_CTR) + rep_;
        volatile int* curw = (volatile int*)(shm + L_CUR);
        for (int it = blockIdx.x; it < 2048; it += G) { s5_pass3_item(P, it, shm); __syncthreads(); }
        for (;;) {
            __syncthreads();
            if (tid == 0) *curw = atomicAdd(ctr, 1);
            __syncthreads();
            const int it = *curw;
            if (it >= 512) break;
            attn_item(P, it, shm);
        } }
    SYNC(6);
    if (IN(7)) REP(7) { pg8::Gemm g{(const bf16_t*)(ws + WS_HG), (const bf16_t*)(ws + WS_GLUW), MTOK, 1024, 1024};
        pg8::StaticOrder S; S.init(MTOK, 1024, G, (int)blockIdx.x); EpiGLU E{(const bf16_t*)(ws + WS_HG), P.in[25], (bf16_t*)(ws + WS_AS)};
        pg8::gemm_phase<EpiGLU, pg8::StaticOrder>(lds, g, S, E); }
    SYNC(7);
    if (IN(8)) REP(8) { pg8::Gemm g{(const bf16_t*)(ws + WS_AS), (const bf16_t*)(ws + WS_WOUT), MTOK, DM, DM};
        pg8::StaticOrder S; S.init(MTOK, DM, G, (int)blockIdx.x); EpiResid<1> E{nullptr, (const bf16_t*)hres, nullptr, (bf16_t*)(ws + WS_XN), (float*)(ws + WS_SMALL) + SM_SS + 16384, 1.0f};
        pg8::gemm_phase<EpiResid<1>, pg8::StaticOrder>(lds, g, S, E); }
    if (IN(8) && hi > 9) xcd_barrier(xbar);
    if (IN(10)) REP(10) { pg8::Gemm g{(const bf16_t*)(ws + WS_XN), (const bf16_t*)(ws + WS_W13B), MTOK, 2 * DFF, DM};
        pg8::StaticOrder S; S.init(MTOK, 2 * DFF, G, (int)blockIdx.x); EpiSwiGLU E{(bf16_t*)(ws + WS_H), (const float*)(ws + WS_SMALL) + SM_SS + 16384}; fill_rstd(S, E.ss, shm);
        pg8::gemm_phase<EpiSwiGLU, pg8::StaticOrder>(lds, g, S, E); }
    SYNC(10);
    if (IN(11)) REP(11) { pg8::Gemm g{(const bf16_t*)(ws + WS_H), (const bf16_t*)(ws + WS_W2B), MTOK, DM, DFF};
        pg8::StaticOrder S; S.init(MTOK, DM, G, (int)blockIdx.x); EpiResid<2> E{nullptr, (const bf16_t*)(ws + WS_XN), hres, nullptr, nullptr, 0.5f};
        pg8::gemm_phase<EpiResid<2>, pg8::StaticOrder>(lds, g, S, E); }
    SYNC(11);
    if (IN(12)) REP(12) norm_rows(hres, P.in[31], nullptr, hres);
}

#ifndef N_LAUNCH_MODE
#define N_LAUNCH_MODE 0
#endif

extern "C" void kernel_launch(void* const* d_in, const int* in_sizes, int n_in, void* d_out, int out_size, void* d_ws, size_t ws_size, hipStream_t stream) {
    static int grid = 0;
    if (grid == 0) {
        int dev = 0, cus = 0, per_cu = 0;
        hipGetDevice(&dev);
        hipDeviceGetAttribute(&cus, hipDeviceAttributeMultiprocessorCount, dev);
        hipFuncSetAttribute((const void*)hymba_fwd, hipFuncAttributeMaxDynamicSharedMemorySize, LDS_BYTES);
        hipOccupancyMaxActiveBlocksPerMultiprocessor(&per_cu, (const void*)hymba_fwd, 512, LDS_BYTES);
        if (per_cu < 1) { fprintf(stderr, "occupancy query says %d blocks/CU\n", per_cu); per_cu = 1; }
        (void)hipGetLastError();
        grid = cus * 1;
        if (n_in != 32 || ws_size < WS_END) fprintf(stderr, "kernel_launch: unexpected n_in %d / ws %zu\n", n_in, ws_size);
    }
    Params p{};
    for (int i = 0; i < 32; ++i) p.in[i] = (const float*)d_in[i];
    p.out = (float*)d_out; p.ws = (unsigned char*)d_ws;
    (void)hipMemsetAsync((unsigned char*)d_ws + WS_SMALL + (size_t)SM_BAR * 4, 0, XCD_BAR_WORDS * 4, stream);
#if N_LAUNCH_MODE == 0
    p.ph_lo = 0; p.ph_hi = NPH;
    { void* args[] = {&p};
      hipError_t e = hipLaunchCooperativeKernel((const void*)hymba_fwd, dim3(grid), dim3(512), args, LDS_BYTES, stream);
      if (e != hipSuccess) fprintf(stderr, "cooperative launch failed: %s (grid %d)\n", hipGetErrorString(e), grid); }
#else
    for (int ph = 0; ph < NPH; ++ph) { p.ph_lo = ph; p.ph_hi = ph + 1;
        void* args[] = {&p};
        hipError_t e = hipLaunchCooperativeKernel((const void*)hymba_fwd, dim3(grid), dim3(512), args, LDS_BYTES, stream);
        if (e != hipSuccess) fprintf(stderr, "launch %d failed: %s (grid %d)\n", ph, hipGetErrorString(e), grid); }
#endif
}
```

```cpp
#include <hip/hip_runtime.h>
#include <hip/hip_cooperative_groups.h>
#include <cstdio>
namespace cg = cooperative_groups;

#define DI __device__ __forceinline__
#define LAS __attribute__((address_space(3)))
#define GAS __attribute__((address_space(1)))
typedef unsigned short bf16_t;
typedef short bf16x8 __attribute__((ext_vector_type(8)));
typedef short s16x4 __attribute__((ext_vector_type(4)));
typedef float f32x4 __attribute__((ext_vector_type(4)));
typedef float f32x16 __attribute__((ext_vector_type(16)));
typedef unsigned u32x4 __attribute__((ext_vector_type(4)));
typedef unsigned u32x2 __attribute__((ext_vector_type(2)));
typedef __bf16 bf16x2_t __attribute__((ext_vector_type(2)));
typedef float f32x2_t __attribute__((ext_vector_type(2)));

constexpr int MTOK = 16384, DM = 2048, DFF = 5632, TT = 2048;
constexpr int NPROJ = 3840;
constexpr int C_KC = 1024, C_VC = 1280, C_KS = 1536, C_VS = 1792, C_KW = 2048, C_VW = 2304, C_GATE = 2560, C_SSM = 2584;
constexpr float EPSN = 1e-6f;
constexpr float NEGF = -1e30f;

constexpr size_t WS_W13A = 0;
constexpr size_t WS_W2A = WS_W13A + 46137344;
constexpr size_t WS_W13B = WS_W2A + 23068672;
constexpr size_t WS_W2B = WS_W13B + 46137344;
constexpr size_t WS_WIN = WS_W2B + 23068672;
constexpr size_t WS_WOUT = WS_WIN + 15728640;
constexpr size_t WS_GLUW = WS_WOUT + 8388608;
constexpr size_t WS_CW1K = WS_GLUW + 2097152;
constexpr size_t WS_CW1V = WS_CW1K + 1048576;
constexpr size_t WS_CW2K = WS_CW1V + 1048576;
constexpr size_t WS_CW2V = WS_CW2K + 32768;
constexpr size_t WS_SMALL = WS_CW2V + 32768;
constexpr size_t WS_KCB = WS_SMALL + 1048576;
constexpr size_t WS_VCBT = WS_KCB + 524288;
constexpr size_t WS_S5END = WS_VCBT + 524288;
constexpr size_t WS_VTS = WS_S5END + 8388608;
constexpr size_t WS_VTW = WS_VTS + 8388608;
constexpr size_t WS_XN = WS_VTW + 8388608;
constexpr size_t WS_H = WS_XN + 67108864;
constexpr size_t WS_PROJ = WS_H;
constexpr size_t WS_AS = WS_H + 125829120;
constexpr size_t WS_HG = WS_XN;
constexpr size_t WS_OUTS = WS_H + 184549376 + 8388608;
constexpr size_t WS_END = WS_OUTS + 33554432;
constexpr int SM_CB1 = 0;
constexpr int SM_AB = 256;
constexpr int SM_BB = 256 + 16384;
constexpr int SM_CTR = 256 + 16384 + 131072;
constexpr int SM_CBP = SM_CTR + 64;
constexpr int SM_SS = SM_CBP + 32768;
constexpr int SM_BAR = 213504;

constexpr int LDS_BYTES = 151552;
constexpr int L_CUR = 149776;
constexpr int NPH = 13;

struct Params { const float* in[32]; float* out; unsigned char* ws; int ph_lo, ph_hi; };

DI unsigned pk2(float a, float b) { f32x2_t v = {a, b}; return __builtin_bit_cast(unsigned, __builtin_convertvector(v, bf16x2_t)); }
DI float bf2f(unsigned x) { return __uint_as_float(x << 16); }
DI float bflo(unsigned w) { return __uint_as_float(w << 16); }
DI float bfhi(unsigned w) { return __uint_as_float(w & 0xffff0000u); }
DI float sigmoidf_(float x) { return __builtin_amdgcn_rcpf(1.0f + __builtin_amdgcn_exp2f(-1.4426950408889634f * x)); }
DI float gelu_tanh(float v) { const float z = 0.7978845608028654f * (v + 0.044715f * v * v * v); const float th = 1.0f - 2.0f * __builtin_amdgcn_rcpf(__builtin_amdgcn_exp2f(2.8853900817779268f * z) + 1.0f); return 0.5f * v * (1.0f + th); }

namespace pg8 {
constexpr int BM = 256, BK = 64, HALF = 128, HTB = HALF * BK * 2, STAGE_BYTES = 8 * HTB, NXCD = 8, WGM = 8;
__host__ __device__ __forceinline__ int lds_byte(int r, int c) { const int st = (r >> 4) * 2 + (c >> 5), rr = r & 15, cc = c & 31, ob = rr * 64 + cc * 2; return st * 1024 + (ob ^ (((ob >> 9) & 1) << 5)); }
__host__ __device__ __forceinline__ void stage_rc(int b, int& R, int& C) { const int st = b / 1024, sb = b % 1024, swz = sb ^ (((sb >> 9) & 1) << 5); R = (st >> 1) * 16 + swz / 64; C = (st & 1) * 32 + (swz % 64) / 2; }
__host__ __device__ __forceinline__ int perm32(int rho) { const int n = rho >> 4, i = rho & 15; return 8 * (i >> 2) + 4 * n + (i & 3); }
struct Unit { int pm, pn; };
struct Gemm { const bf16_t* A; const bf16_t* Bt; int M, N, K; };
struct StaticOrder {
    int nM, nN, nwg, G, c;
    __host__ __device__ void init(int M, int N, int G_, int c_) { nM = M / BM; nN = N / BM; nwg = nM * nN; G = G_; c = c_; }
    __host__ __device__ bool next(int i, Unit& u) const {
        const long L = (long)i * G + c; if (L >= nwg) return false;
        int wgid = (int)L; { const int q = nwg / NXCD, r = nwg % NXCD, xcd = wgid % NXCD, off = wgid / NXCD; wgid = (xcd < r ? xcd * (q + 1) : r * (q + 1) + (xcd - r) * q) + off; }
        const int nig = WGM * nN, gid = wgid / nig, fm = gid * WGM, gsz = (nM - fm) < WGM ? (nM - fm) : WGM;
        u.pm = fm + ((wgid % nig) % gsz); u.pn = (wgid % nig) / gsz; return true;
    }
    __device__ __forceinline__ void a_ready(const Unit&) const {}
    __device__ __forceinline__ void done(const Unit&) const {}
};

template <class Epi, class Sched>
__device__ __forceinline__ void gemm_phase(LAS unsigned char* lds, const Gemm g, const Sched& S, const Epi& E) {
    const int tid = threadIdx.x, wid = __builtin_amdgcn_readfirstlane(tid >> 6), lane = tid & 63, wr = wid >> 2, wc = wid & 3, fr = lane & 15, fq = lane >> 4;
    const int K = g.K, nt = K / BK;
    unsigned voffA[2], voffB[2];
#pragma unroll
    for (int i = 0; i < 2; ++i) { int R, C; stage_rc(tid * 16 + i * 8192, R, C); const int Rb = Epi::PERM ? ((R & ~31) + perm32(R & 31)) : R;
        voffA[i] = (unsigned)(R * K + C) * 2u; voffB[i] = (unsigned)(Rb * K + C) * 2u; }
    const size_t kstep = (size_t)(BK * 2);
    const size_t hstep = (size_t)HALF * K * 2;
    const size_t tstep = 2 * hstep;
    const unsigned ldsw = (unsigned)wid * 1024u;
    const int aoff = lds_byte(wr * 64 + fr, fq * 8), boff = lds_byte(wc * 32 + fr, fq * 8);
#define PG8_SA(b, h) (((b) * 2 + (h)) * HTB)
#define PG8_SB(b, h) ((4 + (b) * 2 + (h)) * HTB)
#define PG8_STAGE(bufoff, gbase, voff) do { _Pragma("unroll") for (int _i = 0; _i < 2; ++_i) \
        __builtin_amdgcn_global_load_lds((const unsigned*)((const char*)(gbase) + (voff)[_i]), (LAS unsigned*)(lds + (bufoff) + ldsw + _i * 8192), 16, 0, 0); } while (0)
#define PG8_LDA(dst, b, h) do { _Pragma("unroll") for (int m = 0; m < 4; ++m) _Pragma("unroll") for (int k = 0; k < 2; ++k) dst[m][k] = *(const LAS bf16x8*)(lds + PG8_SA(b, h) + aoff + m * 2048 + k * 1024); } while (0)
#define PG8_LDB(dst, b, h) do { _Pragma("unroll") for (int n = 0; n < 2; ++n) _Pragma("unroll") for (int k = 0; k < 2; ++k) dst[n][k] = *(const LAS bf16x8*)(lds + PG8_SB(b, h) + boff + n * 2048 + k * 1024); } while (0)
#define PG8_MMA(ai, bj, At, Bt) do { __builtin_amdgcn_s_setprio(1); _Pragma("unroll") for (int m = 0; m < 4; ++m) _Pragma("unroll") for (int n = 0; n < 2; ++n) _Pragma("unroll") for (int k = 0; k < 2; ++k) \
        acc[ai][bj][m][n] = __builtin_amdgcn_mfma_f32_16x16x32_bf16(Bt[n][k], At[m][k], acc[ai][bj][m][n], 0, 0, 0); __builtin_amdgcn_s_setprio(0); } while (0)
#define PG8_WAIT_V(n) asm volatile("s_waitcnt vmcnt(" #n ")" ::: "memory")
#define PG8_WAIT_L(n) asm volatile("s_waitcnt lgkmcnt(" #n ")" ::: "memory")
#define PG8_BAR __builtin_amdgcn_s_barrier()
#define PG8_SCHED __builtin_amdgcn_sched_barrier(0)
    Unit cur, nxt; int ui = 0;
    if (!S.next(0, cur)) return;
    f32x4 acc[2][2][4][2];
#pragma unroll
    for (int a = 0; a < 2; ++a)
#pragma unroll
        for (int b = 0; b < 2; ++b)
#pragma unroll
            for (int m = 0; m < 4; ++m)
#pragma unroll
                for (int n = 0; n < 2; ++n) acc[a][b][m][n] = (f32x4){0.f, 0.f, 0.f, 0.f};
    bf16x8 At[4][2], B0[2][2], B1[2][2];
    const char* cA = (const char*)g.A + (size_t)cur.pm * tstep; const char* cB = (const char*)g.Bt + (size_t)cur.pn * tstep;
    S.a_ready(cur);
    PG8_STAGE(PG8_SB(0, 0), cB, voffB); PG8_STAGE(PG8_SA(0, 0), cA, voffA); PG8_STAGE(PG8_SB(0, 1), cB + hstep, voffB); PG8_STAGE(PG8_SA(0, 1), cA + hstep, voffA);
    if (wr == 1) PG8_BAR;
    PG8_WAIT_V(4); PG8_BAR;
    PG8_STAGE(PG8_SB(1, 0), cB + kstep, voffB); PG8_STAGE(PG8_SA(1, 0), cA + kstep, voffA); PG8_STAGE(PG8_SB(1, 1), cB + hstep + kstep, voffB);
    PG8_WAIT_V(6); PG8_BAR;
    for (;;) {
        const bool has_next = S.next(ui + 1, nxt);
        const char* nA = has_next ? (const char*)g.A + (size_t)nxt.pm * tstep : cA; const char* nB = has_next ? (const char*)g.Bt + (size_t)nxt.pn * tstep : cB;
        for (int t = 0; t < nt; t += 2) {
            const bool last = (t == nt - 2);
            const char* a1 = cA + (size_t)(t + 1) * kstep;
            const char* a2 = last ? nA : cA + (size_t)(t + 2) * kstep; const char* b2 = last ? nB : cB + (size_t)(t + 2) * kstep;
            const char* a3 = a2 + kstep; const char* b3 = b2 + kstep;
            if (last && has_next) S.a_ready(nxt);
            PG8_LDB(B0, 0, 0); PG8_SCHED; PG8_LDA(At, 0, 0); PG8_STAGE(PG8_SA(1, 1), a1 + hstep, voffA);
            PG8_WAIT_L(8); PG8_BAR; PG8_WAIT_L(0); PG8_MMA(0, 0, At, B0); PG8_BAR; PG8_SCHED;
            PG8_LDB(B1, 0, 1); PG8_STAGE(PG8_SB(0, 0), b2, voffB);
            PG8_BAR; PG8_WAIT_L(0); PG8_MMA(0, 1, At, B1); PG8_BAR;
            PG8_LDA(At, 0, 1); PG8_STAGE(PG8_SA(0, 0), a2, voffA);
            PG8_BAR; PG8_WAIT_L(0); PG8_MMA(1, 0, At, B0); PG8_BAR; PG8_SCHED;
            PG8_STAGE(PG8_SB(0, 1), b2 + hstep, voffB);
            PG8_WAIT_V(6); PG8_BAR; PG8_MMA(1, 1, At, B1); PG8_BAR;
            PG8_LDB(B0, 1, 0); PG8_SCHED; PG8_LDA(At, 1, 0); PG8_STAGE(PG8_SA(0, 1), a2 + hstep, voffA);
            PG8_WAIT_L(8); PG8_BAR; PG8_WAIT_L(0); PG8_MMA(0, 0, At, B0); PG8_BAR; PG8_SCHED;
            PG8_LDB(B1, 1, 1); PG8_STAGE(PG8_SB(1, 0), b3, voffB);
            PG8_BAR; PG8_WAIT_L(0); PG8_MMA(0, 1, At, B1); PG8_BAR;
            PG8_LDA(At, 1, 1); PG8_STAGE(PG8_SA(1, 0), a3, voffA);
            PG8_BAR; PG8_WAIT_L(0); PG8_MMA(1, 0, At, B0); PG8_BAR; PG8_SCHED;
            PG8_STAGE(PG8_SB(1, 1), b3 + hstep, voffB);
            PG8_WAIT_V(6); PG8_BAR; PG8_MMA(1, 1, At, B1); PG8_BAR;
        }
        E(acc, cur, wr, wc, fr, fq, ui, lds); S.done(cur);
        if (!has_next) break;
#pragma unroll
        for (int a = 0; a < 2; ++a)
#pragma unroll
            for (int b = 0; b < 2; ++b)
#pragma unroll
                for (int m = 0; m < 4; ++m)
#pragma unroll
                    for (int n = 0; n < 2; ++n) acc[a][b][m][n] = (f32x4){0.f, 0.f, 0.f, 0.f};
        cur = nxt; cA = nA; cB = nB; ++ui;
    }
    PG8_WAIT_V(0);
    if (wr == 0) PG8_BAR;
    PG8_BAR;
#undef PG8_SA
#undef PG8_SB
#undef PG8_STAGE
#undef PG8_LDA
#undef PG8_LDB
#undef PG8_MMA
#undef PG8_WAIT_V
#undef PG8_WAIT_L
#undef PG8_BAR
#undef PG8_SCHED
}
}

struct EpiSwiGLU {
    static constexpr bool PERM = true;
    bf16_t* H; const float* ss;
    DI void operator()(const f32x4 (&acc)[2][2][4][2], const pg8::Unit& u, int wr, int wc, int fr, int fq, int ui, LAS unsigned char* lds) const {
        const int row0 = u.pm * 256 + wr * 64 + fr, col0 = u.pn * 128 + wc * 32 + 8 * fq;
#pragma unroll
        for (int ai = 0; ai < 2; ++ai)
#pragma unroll
            for (int m = 0; m < 4; ++m) {
                const float rs = ss ? ((const LAS float*)(lds + 131072))[ui * 256 + wr * 64 + fr + ai * 128 + m * 16] : 1.0f;
                float v[8];
#pragma unroll
                for (int n = 0; n < 2; ++n)
#pragma unroll
                    for (int j = 0; j < 4; ++j) { const float gt = acc[ai][0][m][n][j] * rs, up = acc[ai][1][m][n][j] * rs; v[n * 4 + j] = gt * up * __builtin_amdgcn_rcpf(1.0f + __builtin_amdgcn_exp2f(-1.4426950408889634f * gt)); }
                u32x4 w; w.x = pk2(v[0], v[1]); w.y = pk2(v[2], v[3]); w.z = pk2(v[4], v[5]); w.w = pk2(v[6], v[7]);
                *(u32x4*)(H + (size_t)(row0 + ai * 128 + m * 16) * DFF + col0) = w;
            }
    }
};
template <int MODE> struct EpiResid {
    static constexpr bool PERM = true;
    const float* basef; const bf16_t* baseb; float* outf; bf16_t* hb; float* ss; float scale;
    DI void operator()(const f32x4 (&acc)[2][2][4][2], const pg8::Unit& u, int wr, int wc, int fr, int fq, int ui, LAS unsigned char* lds) const {
        const int row0 = u.pm * 256 + wr * 64 + fr, col0 = u.pn * 256 + wc * 32 + 8 * fq;
#pragma unroll
        for (int ai = 0; ai < 2; ++ai) {
            f32x4 bf0[4][2], bf1[4][2]; u32x4 bw[4][2];
#pragma unroll
            for (int m = 0; m < 4; ++m)
#pragma unroll
                for (int bj = 0; bj < 2; ++bj) { const size_t off = (size_t)(row0 + ai * 128 + m * 16) * DM + col0 + bj * 128;
                    if (MODE == 0) { bf0[m][bj] = *(const f32x4*)(basef + off); bf1[m][bj] = *(const f32x4*)(basef + off + 4); }
                    else bw[m][bj] = *(const u32x4*)(baseb + off); }
            __builtin_amdgcn_sched_barrier(0);
#pragma unroll
            for (int m = 0; m < 4; ++m) { const int row = row0 + ai * 128 + m * 16; const size_t off = (size_t)row * DM + col0; float rsum = 0.f;
#pragma unroll
                for (int bj = 0; bj < 2; ++bj) {
                    f32x4 b0, b1;
                    if (MODE == 0) { b0 = bf0[m][bj]; b1 = bf1[m][bj]; }
                    else { const u32x4 w = bw[m][bj]; b0 = (f32x4){bflo(w.x), bfhi(w.x), bflo(w.y), bfhi(w.y)}; b1 = (f32x4){bflo(w.z), bfhi(w.z), bflo(w.w), bfhi(w.w)}; }
                    const f32x4 v0 = b0 + acc[ai][bj][m][0] * scale, v1 = b1 + acc[ai][bj][m][1] * scale;
                    if (MODE == 2) { *(f32x4*)(outf + off + bj * 128) = v0; *(f32x4*)(outf + off + bj * 128 + 4) = v1; }
                    else { rsum += (v0[0] * v0[0] + v0[1] * v0[1]) + (v0[2] * v0[2] + v0[3] * v0[3]) + (v1[0] * v1[0] + v1[1] * v1[1]) + (v1[2] * v1[2] + v1[3] * v1[3]);
                        u32x4 w; w.x = pk2(v0[0], v0[1]); w.y = pk2(v0[2], v0[3]); w.z = pk2(v1[0], v1[1]); w.w = pk2(v1[2], v1[3]);
                        *(u32x4*)(hb + off + bj * 128) = w; } }
                if (MODE != 2) { rsum += __shfl_xor(rsum, 16); rsum += __shfl_xor(rsum, 32); if (fq == 0) atomicAdd(ss + row, rsum); } }
        }
    }
};
struct EpiProj {
    static constexpr bool PERM = true;
    bf16_t* O; const float* ss; bf16_t* vts; bf16_t* vtw;
    DI void operator()(const f32x4 (&acc)[2][2][4][2], const pg8::Unit& u, int wr, int wc, int fr, int fq, int ui, LAS unsigned char* lds) const {
        const int row0 = u.pm * 256 + wr * 64 + fr, col0 = u.pn * 256 + wc * 32 + 8 * fq;
        const bool tr = (u.pn == 7) || (u.pn == 9);
#pragma unroll
        for (int ai = 0; ai < 2; ++ai)
#pragma unroll
            for (int m = 0; m < 4; ++m) { const int row = row0 + ai * 128 + m * 16; bf16_t* rowp = O + (size_t)row * NPROJ + col0;
                const float rs = ((const LAS float*)(lds + 131072))[ui * 256 + wr * 64 + fr + ai * 128 + m * 16];
#pragma unroll
                for (int bj = 0; bj < 2; ++bj) { const f32x4 v0 = acc[ai][bj][m][0] * rs, v1 = acc[ai][bj][m][1] * rs;
                    u32x4 w; w.x = pk2(v0[0], v0[1]); w.y = pk2(v0[2], v0[3]); w.z = pk2(v1[0], v1[1]); w.w = pk2(v1[2], v1[3]);
                    if (!tr) *(u32x4*)(rowp + bj * 128) = w;
                    else { bf16_t* vt = (u.pn == 7 ? vts : vtw) + ((size_t)((row >> 11) * 2 + bj) * 128 + wc * 32 + 8 * fq) * TT + (row & 2047);
                        vt[0 * TT] = (bf16_t)(w.x & 0xffffu); vt[1 * TT] = (bf16_t)(w.x >> 16); vt[2 * TT] = (bf16_t)(w.y & 0xffffu); vt[3 * TT] = (bf16_t)(w.y >> 16);
                        vt[4 * TT] = (bf16_t)(w.z & 0xffffu); vt[5 * TT] = (bf16_t)(w.z >> 16); vt[6 * TT] = (bf16_t)(w.w & 0xffffu); vt[7 * TT] = (bf16_t)(w.w >> 16); } } }
    }
};
struct EpiGLU {
    static constexpr bool PERM = true;
    const bf16_t* HG; const float* bias; bf16_t* AS;
    DI void operator()(const f32x4 (&acc)[2][2][4][2], const pg8::Unit& u, int wr, int wc, int fr, int fq, int ui, LAS unsigned char* lds) const {
        const int row0 = u.pm * 256 + wr * 64 + fr, col0 = u.pn * 256 + wc * 32 + 8 * fq;
        f32x4 bs[2][2];
#pragma unroll
        for (int bj = 0; bj < 2; ++bj) { bs[bj][0] = *(const f32x4*)(bias + col0 + bj * 128); bs[bj][1] = *(const f32x4*)(bias + col0 + bj * 128 + 4); }
#pragma unroll
        for (int ai = 0; ai < 2; ++ai) {
            u32x4 hw[4][2];
#pragma unroll
            for (int m = 0; m < 4; ++m)
#pragma unroll
                for (int bj = 0; bj < 2; ++bj) hw[m][bj] = *(const u32x4*)(HG + (size_t)(row0 + ai * 128 + m * 16) * 1024 + col0 + bj * 128);
            __builtin_amdgcn_sched_barrier(0);
#pragma unroll
            for (int m = 0; m < 4; ++m) { const int row = row0 + ai * 128 + m * 16;
#pragma unroll
                for (int bj = 0; bj < 2; ++bj) { const int col = col0 + bj * 128; const u32x4 h = hw[m][bj];
                    const f32x4 v0 = acc[ai][bj][m][0] + bs[bj][0], v1 = acc[ai][bj][m][1] + bs[bj][1];
                    u32x4 w;
                    w.x = pk2(bflo(h.x) * sigmoidf_(v0[0]), bfhi(h.x) * sigmoidf_(v0[1]));
                    w.y = pk2(bflo(h.y) * sigmoidf_(v0[2]), bfhi(h.y) * sigmoidf_(v0[3]));
                    w.z = pk2(bflo(h.z) * sigmoidf_(v1[0]), bfhi(h.z) * sigmoidf_(v1[1]));
                    w.w = pk2(bflo(h.w) * sigmoidf_(v1[2]), bfhi(h.w) * sigmoidf_(v1[3]));
                    *(u32x4*)(AS + (size_t)row * DM + 1024 + col) = w; } }
        }
    }
};

DI void tconv(const float* __restrict__ src, int K, int N, int Npad, bf16_t* __restrict__ dst, int mode, float* tile, const float* __restrict__ gk = nullptr) {
    const int tid = threadIdx.x, ntk = K >> 6, ntn = Npad >> 7, ntile = ntk * ntn;
    f32x4 v[4];
    float gv[4];
#define TC_LOAD(tt) do { const int tk_ = (tt) % ntk, tn_ = (tt) / ntk; \
        _Pragma("unroll") for (int e = 0; e < 4; ++e) { const int i = tid + 512 * e, r = i >> 5, n = tn_ * 128 + (i & 31) * 4, nn = n < N ? n : N - 4; \
            v[e] = __builtin_nontemporal_load((const f32x4*)(src + (size_t)(tk_ * 64 + r) * N + nn)); gv[e] = gk ? gk[tk_ * 64 + r] : 1.0f; } } while (0)
    int t = blockIdx.x;
    if (t < ntile) TC_LOAD(t);
    for (; t < ntile; t += gridDim.x) {
#pragma unroll
        for (int e = 0; e < 4; ++e) { const int i = tid + 512 * e, r = i >> 5, c = (i & 31) * 4; const bool ok = (t / ntk) * 128 + c < N;
            const f32x4 x = ok ? v[e] * gv[e] : (f32x4){0.f, 0.f, 0.f, 0.f};
            tile[r * 129 + c] = x[0]; tile[r * 129 + c + 1] = x[1]; tile[r * 129 + c + 2] = x[2]; tile[r * 129 + c + 3] = x[3]; }
        __syncthreads();
        const int tk = t % ntk, tn = t / ntk;
        if (t + (int)gridDim.x < ntile) TC_LOAD(t + (int)gridDim.x);
        { const int nl = tid >> 2, kg = tid & 3, n = tn * 128 + nl;
          float x[16];
#pragma unroll
          for (int j = 0; j < 16; ++j) x[j] = tile[(kg * 16 + j) * 129 + nl];
          const int drow = mode == 0 ? n : (tn * 256 + nl + (mode == 2 ? 128 : 0));
          u32x4 w0, w1; w0.x = pk2(x[0], x[1]); w0.y = pk2(x[2], x[3]); w0.z = pk2(x[4], x[5]); w0.w = pk2(x[6], x[7]);
          w1.x = pk2(x[8], x[9]); w1.y = pk2(x[10], x[11]); w1.z = pk2(x[12], x[13]); w1.w = pk2(x[14], x[15]);
          u32x4* dp = (u32x4*)(dst + (size_t)drow * K + tk * 64 + kg * 16); dp[0] = w0; dp[1] = w1; }
        __syncthreads();
    }
#undef TC_LOAD
}

DI void norm_rows(const float* src, const float* __restrict__ g, bf16_t* dstb, float* dstf) {
    const int wid = threadIdx.x >> 6, lane = threadIdx.x & 63, stride = gridDim.x * 8;
    for (int row = blockIdx.x * 8 + wid; row < MTOK; row += 2 * stride) {
        const int row2 = row + stride; const bool has2 = row2 < MTOK;
        const f32x4* p = (const f32x4*)(src + (size_t)row * DM); const f32x4* p2 = (const f32x4*)(src + (size_t)(has2 ? row2 : row) * DM);
        f32x4 v[8], w[8]; float ss = 0.f, ss2 = 0.f;
#pragma unroll
        for (int i = 0; i < 8; ++i) { v[i] = __builtin_nontemporal_load(p + lane + 64 * i); w[i] = __builtin_nontemporal_load(p2 + lane + 64 * i); }
#pragma unroll
        for (int i = 0; i < 8; ++i) { ss += v[i][0] * v[i][0] + v[i][1] * v[i][1] + v[i][2] * v[i][2] + v[i][3] * v[i][3]; ss2 += w[i][0] * w[i][0] + w[i][1] * w[i][1] + w[i][2] * w[i][2] + w[i][3] * w[i][3]; }
#pragma unroll
        for (int o = 32; o >= 1; o >>= 1) { ss += __shfl_xor(ss, o); ss2 += __shfl_xor(ss2, o); }
        const float rstd = 1.0f / sqrtf(ss * (1.0f / DM) + EPSN), rstd2 = 1.0f / sqrtf(ss2 * (1.0f / DM) + EPSN);
#pragma unroll
        for (int i = 0; i < 8; ++i) { const f32x4 gg = ((const f32x4*)g)[lane + 64 * i]; const f32x4 y = v[i] * rstd * gg, y2 = w[i] * rstd2 * gg;
            if (dstb) { u32x2 o; o.x = pk2(y[0], y[1]); o.y = pk2(y[2], y[3]); *(u32x2*)(dstb + (size_t)row * DM + (lane + 64 * i) * 4) = o;
                        if (has2) { u32x2 o2; o2.x = pk2(y2[0], y2[1]); o2.y = pk2(y2[2], y2[3]); *(u32x2*)(dstb + (size_t)row2 * DM + (lane + 64 * i) * 4) = o2; } }
            else { __builtin_nontemporal_store(y, (f32x4*)(dstf + (size_t)row * DM) + lane + 64 * i); if (has2) __builtin_nontemporal_store(y2, (f32x4*)(dstf + (size_t)row2 * DM) + lane + 64 * i); } }
    }
}

DI void phase_prep(const Params& P, unsigned char* smem) {
    unsigned char* ws = P.ws; float* tile = (float*)smem; const int tid = threadIdx.x;
    float* sm = (float*)(ws + WS_SMALL);
    if (blockIdx.x < 8) { const int idx = blockIdx.x * 512 + tid, grp = idx >> 6;
        const float step = expf(P.in[18][grp]), lre = P.in[16][idx], lim = P.in[17][idx];
        const float mag = expf(lre * step), ar = mag * cosf(lim * step), ai = mag * sinf(lim * step);
        const float nr = ar - 1.0f, ni = ai, den = lre * lre + lim * lim, fre = (nr * lre + ni * lim) / den, fim = (ni * lre - nr * lim) / den;
        f32x4 brv[4], biv[4];
#pragma unroll
        for (int k = 0; k < 4; ++k) { brv[k] = *(const f32x4*)(P.in[19] + idx * 16 + 4 * k); biv[k] = *(const f32x4*)(P.in[20] + idx * 16 + 4 * k); }
        bf16_t* tb = (bf16_t*)(sm + SM_BB); const int p = idx & 63;
        unsigned hre[16], lre_[16], him[16], lim_[16];
#pragma unroll
        for (int h = 0; h < 16; ++h) { const float br = brv[h >> 2][h & 3], bi = biv[h >> 2][h & 3];
            const float vre = fre * br - fim * bi, vim = fre * bi + fim * br;
            hre[h] = pk2(vre, 0.f) & 0xffffu; lre_[h] = pk2(vre - bf2f(hre[h]), 0.f) & 0xffffu;
            him[h] = pk2(vim, 0.f) & 0xffffu; lim_[h] = pk2(vim - bf2f(him[h]), 0.f) & 0xffffu; }
        { u32x4* d = (u32x4*)(tb + (grp * 128 + p) * 32);
          d[0] = (u32x4){hre[0] | (hre[1] << 16), hre[2] | (hre[3] << 16), hre[4] | (hre[5] << 16), hre[6] | (hre[7] << 16)};
          d[1] = (u32x4){hre[8] | (hre[9] << 16), hre[10] | (hre[11] << 16), hre[12] | (hre[13] << 16), hre[14] | (hre[15] << 16)};
          d[2] = (u32x4){lre_[0] | (lre_[1] << 16), lre_[2] | (lre_[3] << 16), lre_[4] | (lre_[5] << 16), lre_[6] | (lre_[7] << 16)};
          d[3] = (u32x4){lre_[8] | (lre_[9] << 16), lre_[10] | (lre_[11] << 16), lre_[12] | (lre_[13] << 16), lre_[14] | (lre_[15] << 16)};
          u32x4* e = (u32x4*)(tb + (grp * 128 + 64 + p) * 32);
          e[0] = (u32x4){him[0] | (him[1] << 16), him[2] | (him[3] << 16), him[4] | (him[5] << 16), him[6] | (him[7] << 16)};
          e[1] = (u32x4){him[8] | (him[9] << 16), him[10] | (him[11] << 16), him[12] | (him[13] << 16), him[14] | (him[15] << 16)};
          e[2] = (u32x4){lim_[0] | (lim_[1] << 16), lim_[2] | (lim_[3] << 16), lim_[4] | (lim_[5] << 16), lim_[6] | (lim_[7] << 16)};
          e[3] = (u32x4){lim_[8] | (lim_[9] << 16), lim_[10] | (lim_[11] << 16), lim_[12] | (lim_[13] << 16), lim_[14] | (lim_[15] << 16)}; }
        float pr = ar, pi = ai;
        for (int s = 0; s < 6; ++s) { const float nr2 = pr * pr - pi * pi, ni2 = 2.0f * pr * pi; pr = nr2; pi = ni2; }
        sm[SM_AB + idx * 4 + 0] = ar; sm[SM_AB + idx * 4 + 1] = ai; sm[SM_AB + idx * 4 + 2] = pr; sm[SM_AB + idx * 4 + 3] = pi; }
    { const int which = blockIdx.x >> 7, chunk = blockIdx.x & 127; const float* pe = P.in[which ? 11 : 7]; const float* w1 = P.in[which ? 12 : 8];
      if (blockIdx.x < 256) {
        const int n = tid & 127, sub = tid >> 7; float s = 0.f;
#pragma unroll
        for (int j = 0; j < 8; ++j) { const int k = chunk * 32 + sub * 8 + j; s += pe[k] * w1[(size_t)k * 128 + n]; }
        tile[tid] = s; __syncthreads();
        if (tid < 128) sm[SM_CBP + (which * 128 + chunk) * 128 + tid] = (tile[tid] + tile[tid + 128]) + (tile[tid + 256] + tile[tid + 384]);
        __syncthreads(); } }
    if (blockIdx.x == 10 && tid == 0) { ((int*)(sm + SM_CTR))[0] = 0; ((int*)(sm + SM_CTR))[1] = 0; }
    for (int i = blockIdx.x * 512 + tid; i < 32768; i += gridDim.x * 512) sm[SM_SS + i] = 0.f;
    { u32x4* z = (u32x4*)(ws + WS_KCB); const u32x4 zero = {0u, 0u, 0u, 0u};
      for (int i = blockIdx.x * 512 + tid; i < 65536; i += gridDim.x * 512) z[i] = zero; }
    norm_rows(P.in[0], P.in[1], (bf16_t*)(ws + WS_XN), nullptr);
    tconv(P.in[2], DM, DFF, DFF, (bf16_t*)(ws + WS_W13A), 1, tile);
    tconv(P.in[3], DM, DFF, DFF, (bf16_t*)(ws + WS_W13A), 2, tile);
    tconv(P.in[4], DFF, DM, DM, (bf16_t*)(ws + WS_W2A), 0, tile);
    tconv(P.in[6], DM, 3608, NPROJ, (bf16_t*)(ws + WS_WIN), 0, tile, P.in[5]);
    tconv(P.in[8], 4096, 128, 128, (bf16_t*)(ws + WS_CW1K), 0, tile);
    tconv(P.in[12], 4096, 128, 128, (bf16_t*)(ws + WS_CW1V), 0, tile);
    tconv(P.in[10], 128, 128, 128, (bf16_t*)(ws + WS_CW2K), 0, tile);
    tconv(P.in[14], 128, 128, 128, (bf16_t*)(ws + WS_CW2V), 0, tile);
    tconv(P.in[24], 1024, 1024, 1024, (bf16_t*)(ws + WS_GLUW), 0, tile);
    tconv(P.in[26], DM, DM, DM, (bf16_t*)(ws + WS_WOUT), 0, tile);
    tconv(P.in[28], DM, DFF, DFF, (bf16_t*)(ws + WS_W13B), 1, tile, P.in[27]);
    tconv(P.in[29], DM, DFF, DFF, (bf16_t*)(ws + WS_W13B), 2, tile, P.in[27]);
    tconv(P.in[30], DFF, DM, DM, (bf16_t*)(ws + WS_W2B), 0, tile);
}

DI void compress_item(const Params& P, int item, unsigned char* smem) {
    unsigned char* ws = P.ws; const int tid = threadIdx.x, wid = tid >> 6, lane = tid & 63, r = lane & 15, q = lane >> 4;
    const int which = item / 127, rt = item % 127;
    const bf16_t* proj = (const bf16_t*)(ws + WS_PROJ);
    const bf16_t* w1t = (const bf16_t*)(ws + (which ? WS_CW1V : WS_CW1K));
    const bf16_t* w2t = (const bf16_t*)(ws + (which ? WS_CW2V : WS_CW2K));
    const float* cb1 = (const float*)(ws + WS_SMALL) + SM_CB1 + which * 128;
    float* part = (float*)smem;
    bf16_t* hid = (bf16_t*)(smem + 65536);
    const int grow = rt * 16 + r, bg = grow / 127, c = grow % 127, b = bg >> 1, g = bg & 1;
    const bf16_t* arow = proj + (size_t)(b * TT + 16 * c) * NPROJ + (which ? C_VC : C_KC) + g * 128;
    f32x4 acc[8];
#pragma unroll
    for (int ct = 0; ct < 8; ++ct) acc[ct] = (f32x4){0.f, 0.f, 0.f, 0.f};
    bf16x8 fa[2], fb[2][8];
#define CP_LOAD(buf, s_) do { const int kabs_ = 512 * wid + 32 * (s_) + 8 * q; fa[buf] = *(const bf16x8*)(arow + (size_t)(kabs_ >> 7) * NPROJ + (kabs_ & 127)); \
        _Pragma("unroll") for (int ct = 0; ct < 8; ++ct) fb[buf][ct] = *(const bf16x8*)(w1t + (size_t)(ct * 16 + r) * 4096 + kabs_); } while (0)
    CP_LOAD(0, 0);
#pragma unroll
    for (int s = 0; s < 16; ++s) {
        if (s + 1 < 16) CP_LOAD((s + 1) & 1, s + 1);
        __builtin_amdgcn_sched_barrier(0);
#pragma unroll
        for (int ct = 0; ct < 8; ++ct) acc[ct] = __builtin_amdgcn_mfma_f32_16x16x32_bf16(fa[s & 1], fb[s & 1][ct], acc[ct], 0, 0, 0);
        __builtin_amdgcn_sched_barrier(0);
    }
#undef CP_LOAD
#pragma unroll
    for (int ct = 0; ct < 8; ++ct)
#pragma unroll
        for (int j = 0; j < 4; ++j) part[(wid * 16 + 4 * q + j) * 128 + ct * 16 + r] = acc[ct][j];
    __syncthreads();
    { const int row = tid >> 5, c4 = (tid & 31) * 4; f32x4 s = *(const f32x4*)(cb1 + c4);
#pragma unroll
      for (int w = 0; w < 8; ++w) s += *(const f32x4*)(part + (w * 16 + row) * 128 + c4);
      u32x2 o; o.x = pk2(gelu_tanh(s[0]), gelu_tanh(s[1])); o.y = pk2(gelu_tanh(s[2]), gelu_tanh(s[3]));
      *(u32x2*)(hid + row * 136 + c4) = o; }
    __syncthreads();
    { f32x4 a2 = {0.f, 0.f, 0.f, 0.f};
#pragma unroll
      for (int s = 0; s < 4; ++s) { const bf16x8 a = *(const bf16x8*)(hid + r * 136 + 32 * s + 8 * q);
          const bf16x8 bb = *(const bf16x8*)(w2t + (size_t)(16 * wid + r) * 128 + 32 * s + 8 * q);
          a2 = __builtin_amdgcn_mfma_f32_16x16x32_bf16(a, bb, a2, 0, 0, 0); }
      bf16_t* kcb = (bf16_t*)(ws + WS_KCB); bf16_t* vcbt = (bf16_t*)(ws + WS_VCBT);
#pragma unroll
      for (int j = 0; j < 4; ++j) { const int gr = rt * 16 + 4 * q + j, bg2 = gr / 127, c2 = gr % 127, col = 16 * wid + r;
          const bf16_t v = (bf16_t)(pk2(a2[j], 0.f) & 0xffffu);
          if (which == 0) kcb[(size_t)(bg2 * 128 + c2) * 128 + col] = v; else vcbt[(size_t)(bg2 * 128 + col) * 128 + c2] = v; } }
    __syncthreads();
}

DI void s5_bu16(const bf16x8 ub, const bf16x8 (&af)[8], float* buf, int r, int q) {
#pragma unroll
    for (int pt = 0; pt < 8; ++pt) { f32x4 d = {0.f, 0.f, 0.f, 0.f}; d = __builtin_amdgcn_mfma_f32_16x16x32_bf16(af[pt], ub, d, 0, 0, 0);
#pragma unroll
        for (int j = 0; j < 4; ++j) buf[(16 * pt + 4 * q + j) * 17 + r] = d[j]; }
}
DI void s5_pass1_item(const Params& P, int bitem, unsigned char* smem) {
    int tid_ = threadIdx.x; asm volatile("" : "+v"(tid_));
    unsigned char* ws = P.ws; const int tid = tid_, wid = tid >> 6, lane = tid & 63, r = lane & 15, q = lane >> 4;
    const int item = bitem * 8 + wid, ch = item & 31, grp = (item >> 5) & 63, b = item >> 11;
    const bf16_t* proj = (const bf16_t*)(ws + WS_PROJ); const float* sm = (const float*)(ws + WS_SMALL);
    float* buf = (float*)smem + wid * 2176;
    const bf16_t* tb = (const bf16_t*)(sm + SM_BB);
    bf16x8 af[8];
#pragma unroll
    for (int pt = 0; pt < 8; ++pt) af[pt] = *(const bf16x8*)(tb + (grp * 128 + 16 * pt + r) * 32 + 8 * q);
    const f32x4 ab = *(const f32x4*)(sm + SM_AB + (grp * 64 + lane) * 4);
    const bf16_t* ubase = proj + (size_t)(b * TT + ch * 64) * NPROJ + C_SSM + grp * 16;
    float xr = 0.f, xi = 0.f;
    bf16x8 ubs[4];
#pragma unroll
    for (int sub = 0; sub < 4; ++sub) ubs[sub] = *(const bf16x8*)(ubase + (size_t)(sub * 16 + r) * NPROJ + 8 * (q & 1));
#pragma unroll
    for (int sub = 0; sub < 4; ++sub) {
        s5_bu16(ubs[sub], af, buf, r, q);
        asm volatile("s_waitcnt lgkmcnt(0)" ::: "memory");
#pragma unroll
        for (int tt = 0; tt < 16; ++tt) { const float bur = buf[lane * 17 + tt], bui = buf[(64 + lane) * 17 + tt];
            const float nxr = ab[0] * xr - ab[1] * xi + bur, nxi = ab[0] * xi + ab[1] * xr + bui; xr = nxr; xi = nxi; }
        asm volatile("s_waitcnt lgkmcnt(0)" ::: "memory");
    }
    f32x2_t e = {xr, xi};
    *(f32x2_t*)(ws + WS_S5END + ((size_t)((b * 64 + grp) * 32 + ch) * 64 + lane) * 8) = e;
}

DI void vtrans_item(const Params& P, int item, unsigned char* smem) {
    unsigned char* ws = P.ws; const int tid = threadIdx.x;
    const int tokblk = item >> 3, cseg = item & 7, tok0 = tokblk * 64, b = tok0 >> 11, t0 = tok0 & 2047;
    const int col = (cseg < 4 ? C_VS + cseg * 64 : C_VW + (cseg - 4) * 64), g = (cseg & 3) >> 1, d0 = (cseg & 1) * 64;
    const bf16_t* proj = (const bf16_t*)(ws + WS_PROJ);
    bf16_t* dst = (bf16_t*)(ws + (cseg < 4 ? WS_VTS : WS_VTW)) + (size_t)((b * 2 + g) * 128 + d0) * TT + t0;
    bf16_t* tl = (bf16_t*)smem;
    { const int r = tid >> 3, sg = tid & 7; *(u32x4*)(tl + r * 72 + sg * 8) = *(const u32x4*)(proj + (size_t)(tok0 + r) * NPROJ + col + sg * 8); }
    __syncthreads();
    { const int d = tid >> 3, tsg = tid & 7; unsigned v[8];
#pragma unroll
      for (int j = 0; j < 8; ++j) v[j] = tl[(tsg * 8 + j) * 72 + d];
      u32x4 w; w.x = v[0] | (v[1] << 16); w.y = v[2] | (v[3] << 16); w.z = v[4] | (v[5] << 16); w.w = v[6] | (v[7] << 16);
      *(u32x4*)(dst + (size_t)d * TT + tsg * 8) = w; }
    __syncthreads();
}

DI void s5_pass3_item(const Params& P, int bitem, unsigned char* smem) {
    int tid_ = threadIdx.x; asm volatile("" : "+v"(tid_));
    unsigned char* ws = P.ws; const int tid = tid_, wid = tid >> 6, lane = tid & 63, r = lane & 15, q = lane >> 4;
    const int item = bitem * 8 + wid, ch = item & 31, grp = (item >> 5) & 63, b = item >> 11;
    const bf16_t* proj = (const bf16_t*)(ws + WS_PROJ); const float* sm = (const float*)(ws + WS_SMALL);
    float* xs = (float*)smem + wid * 2176;
    bf16_t* HG = (bf16_t*)(ws + WS_HG);
    const bf16_t* tb = (const bf16_t*)(sm + SM_BB);
    bf16x8 af[8];
#pragma unroll
    for (int pt = 0; pt < 8; ++pt) af[pt] = *(const bf16x8*)(tb + (grp * 128 + 16 * pt + r) * 32 + 8 * q);
    const f32x4 ab = *(const f32x4*)(sm + SM_AB + (grp * 64 + lane) * 4);
    float cB[32];
    { const float* cre = P.in[21] + (size_t)(grp * 16 + r) * 64; const float* cim = P.in[22] + (size_t)(grp * 16 + r) * 64;
#pragma unroll
      for (int i = 0; i < 32; ++i) { const int k = 4 * i + q; cB[i] = (i < 16) ? cre[k] : -cim[k - 64]; } }
    const float dsk = P.in[23][grp * 16 + r];
    const bf16_t* ubase = proj + (size_t)(b * TT + ch * 64) * NPROJ + C_SSM + grp * 16;
    bf16x8 ubs[4]; unsigned short uvs[4][4];
#pragma unroll
    for (int sub = 0; sub < 4; ++sub) { ubs[sub] = *(const bf16x8*)(ubase + (size_t)(sub * 16 + r) * NPROJ + 8 * (q & 1));
#pragma unroll
        for (int j = 0; j < 4; ++j) uvs[sub][j] = ubase[(size_t)(sub * 16 + 4 * q + j) * NPROJ + r]; }
    float xr = 0.f, xi = 0.f;
    {
      const f32x2_t* e = (const f32x2_t*)(ws + WS_S5END) + (size_t)((b * 64 + grp) * 32) * 64 + lane;
      f32x2_t ev[31];
#pragma unroll
      for (int j = 0; j < 31; ++j) ev[j] = e[(j < ch ? j : 0) * 64];
#pragma unroll
      for (int j = 0; j < 31; ++j) { const float ex = j < ch ? ev[j][0] : 0.f, ey = j < ch ? ev[j][1] : 0.f;
          const float ncr = ab[2] * xr - ab[3] * xi + ex, nci = ab[2] * xi + ab[3] * xr + ey; xr = j < ch ? ncr : xr; xi = j < ch ? nci : xi; } }
#pragma unroll
    for (int sub = 0; sub < 4; ++sub) {
        s5_bu16(ubs[sub], af, xs, r, q);
        float uv[4];
#pragma unroll
        for (int j = 0; j < 4; ++j) uv[j] = bf2f(uvs[sub][j]);
        asm volatile("s_waitcnt lgkmcnt(0)" ::: "memory");
#pragma unroll
        for (int tt = 0; tt < 16; ++tt) { const float bur = xs[lane * 17 + tt], bui = xs[(64 + lane) * 17 + tt];
            const float nxr = ab[0] * xr - ab[1] * xi + bur, nxi = ab[0] * xi + ab[1] * xr + bui; xr = nxr; xi = nxi;
            xs[lane * 17 + tt] = xr; xs[(64 + lane) * 17 + tt] = xi; }
        asm volatile("s_waitcnt lgkmcnt(0)" ::: "memory");
        f32x4 ya[4];
#pragma unroll
        for (int j = 0; j < 4; ++j) ya[j] = (f32x4){0.f, 0.f, 0.f, 0.f};
#pragma unroll
        for (int i = 0; i < 32; ++i) { const float a = xs[(4 * i + q) * 17 + r]; ya[i & 3] = __builtin_amdgcn_mfma_f32_16x16x4f32(a, cB[i], ya[i & 3], 0, 0, 0); }
        const f32x4 y = (ya[0] + ya[1]) + (ya[2] + ya[3]);
#pragma unroll
        for (int j = 0; j < 4; ++j) { const int tl = sub * 16 + 4 * q + j; const float v = y[j] + dsk * uv[j];
            HG[(size_t)(b * TT + ch * 64 + tl) * 1024 + grp * 16 + r] = (bf16_t)(pk2(gelu_tanh(v), 0.f) & 0xffffu); }
        asm volatile("s_waitcnt lgkmcnt(0)" ::: "memory");
    }
}

DI float xor32_max(float x) { const auto r_ = __builtin_amdgcn_permlane32_swap(__float_as_uint(x), __float_as_uint(x), false, false); return fmaxf(__uint_as_float(r_[0]), __uint_as_float(r_[1])); }
DI float xor32_sum(float x) { const auto r_ = __builtin_amdgcn_permlane32_swap(__float_as_uint(x), __float_as_uint(x), false, false); return __uint_as_float(r_[0]) + __uint_as_float(r_[1]); }
#define MFMA32(a, b, c) __builtin_amdgcn_mfma_f32_32x32x16_bf16((a), (b), (c), 0, 0, 0)
DI bf16x8 ld2x4(const bf16_t* p0) { const s16x4 a = *(const s16x4*)p0, b = *(const s16x4*)(p0 + 8); return __builtin_shufflevector(a, b, 0, 1, 2, 3, 4, 5, 6, 7); }
DI bf16x8 packp(const f32x16& x, int s) { u32x4 p; p.x = pk2(x[8 * s], x[8 * s + 1]); p.y = pk2(x[8 * s + 2], x[8 * s + 3]); p.z = pk2(x[8 * s + 4], x[8 * s + 5]); p.w = pk2(x[8 * s + 6], x[8 * s + 7]); return __builtin_bit_cast(bf16x8, p); }
DI int crow(int i, int hh) { return (i & 3) + 8 * (i >> 2) + 4 * hh; }

constexpr int A_STG = 0;
constexpr int A_BUF = 34816, A_VOFF = 17408;
constexpr int A_IMPM = 69632, A_IMPS = A_IMPM + 33792, A_IMPV = A_IMPS + 33792, A_LUT = A_IMPV + 8192, A_SELM = A_LUT + 4096;
DI bf16x8 lds2x4(const unsigned char* p) { const s16x4 a = *(const s16x4*)p, b = *(const s16x4*)(p + 16); return __builtin_shufflevector(a, b, 0, 1, 2, 3, 4, 5, 6, 7); }

constexpr float QK_C1 = 0.08838834764831845f * 1.4426950408889634f;
template <int MODE, bool FAR>
DI void attn_tile(const unsigned char* kl  , const unsigned char* vl  ,
                  int k0, int tq, int r, int hh, bool bit, const bf16x8 (&qf)[8], const float* lutH, f32x16 (&o)[4], float& m, float& l) {
    f32x16 s;
#pragma unroll
    for (int i = 0; i < 16; ++i) s[i] = 0.f;
    const unsigned char* kp = kl + r * 272 + 16 * hh;
#pragma unroll
    for (int kk = 0; kk < 8; ++kk) { const bf16x8 a = *(const bf16x8*)(kp + 32 * kk); s = MFMA32(a, qf[kk], s); }
    float tmax = NEGF;
    if (FAR) {
        const float b31 = lutH[255];
#pragma unroll
        for (int i = 0; i < 16; ++i) { const float v = s[i] * QK_C1 + b31; s[i] = (MODE == 0 && !bit) ? NEGF : v; tmax = fmaxf(tmax, s[i]); }
    } else {
#pragma unroll
        for (int i = 0; i < 16; ++i) { const int dist = tq - (k0 + crow(i, hh));
            const bool valid = MODE == 0 ? (bit && dist >= 0) : (dist >= 0 && dist < 512);
            const int di = dist < 0 ? 0 : (dist > 255 ? 255 : dist);
            const float v = s[i] * QK_C1 + lutH[di];
            s[i] = valid ? v : NEGF; tmax = fmaxf(tmax, s[i]); }
    }
    tmax = xor32_max(tmax);
    const float mnew = fmaxf(m, tmax);
    if (__ballot(mnew != m) != 0ull) {
        const float alpha = __builtin_amdgcn_exp2f(m - mnew);
        l *= alpha; m = mnew;
#pragma unroll
        for (int dt = 0; dt < 4; ++dt)
#pragma unroll
            for (int i = 0; i < 16; ++i) o[dt][i] *= alpha;
    }
    float psum = 0.f;
    if (FAR) {
#pragma unroll
        for (int i = 0; i < 16; ++i) { const float p = __builtin_amdgcn_exp2f(s[i] - mnew); s[i] = p; psum += p; }
    } else {
#pragma unroll
        for (int i = 0; i < 16; ++i) { const float p = (s[i] > -1e29f) ? __builtin_amdgcn_exp2f(s[i] - mnew) : 0.f; s[i] = p; psum += p; }
    }
    psum = xor32_sum(psum);
    l += psum;
    const unsigned char* vp = vl + r * 136 + 8 * hh;
#pragma unroll
    for (int s2 = 0; s2 < 2; ++s2) { const bf16x8 pb = packp(s, s2);
#pragma unroll
        for (int dt = 0; dt < 4; ++dt) { const bf16x8 a = lds2x4(vp + dt * (32 * 136) + 32 * s2); o[dt] = MFMA32(a, pb, o[dt]); } }
}

template <int MODE>
DI void attn_tile64_far(const unsigned char* bp  , int r, int hh, bool bit, const bf16x8 (&qf)[8], const float* lutH, f32x16 (&o)[4], float& m, float& l) {
    f32x16 s0, s1;
#pragma unroll
    for (int i = 0; i < 16; ++i) { s0[i] = 0.f; s1[i] = 0.f; }
    const unsigned char* kp = bp + r * 272 + 16 * hh;
#pragma unroll
    for (int kk = 0; kk < 8; ++kk) { const bf16x8 a0 = *(const bf16x8*)(kp + 32 * kk), a1 = *(const bf16x8*)(kp + 32 * 272 + 32 * kk); s0 = MFMA32(a0, qf[kk], s0); s1 = MFMA32(a1, qf[kk], s1); }
    const float b31 = lutH[255];
    float tmax = NEGF;
#pragma unroll
    for (int i = 0; i < 16; ++i) { s0[i] = s0[i] * QK_C1 + b31; s1[i] = s1[i] * QK_C1 + b31; tmax = fmaxf(tmax, fmaxf(s0[i], s1[i])); }
    if (MODE == 0 && !bit) tmax = NEGF;
    tmax = xor32_max(tmax);
    const float mnew = fmaxf(m, tmax);
    const float msub = (MODE == 0 && !bit) ? 3.0e38f : mnew;
    if (__ballot(mnew != m) != 0ull) {
        const float alpha = __builtin_amdgcn_exp2f(m - mnew);
        l *= alpha; m = mnew;
#pragma unroll
        for (int dt = 0; dt < 4; ++dt)
#pragma unroll
            for (int i = 0; i < 16; ++i) o[dt][i] *= alpha;
    }
    float psum = 0.f;
#pragma unroll
    for (int i = 0; i < 16; ++i) { const float p0 = __builtin_amdgcn_exp2f(s0[i] - msub), p1 = __builtin_amdgcn_exp2f(s1[i] - msub); s0[i] = p0; s1[i] = p1; psum += p0 + p1; }
    l += xor32_sum(psum);
    const unsigned char* vp = bp + A_VOFF + r * 136 + 8 * hh;
#pragma unroll
    for (int s2 = 0; s2 < 2; ++s2) { const bf16x8 pb0 = packp(s0, s2), pb1 = packp(s1, s2);
#pragma unroll
        for (int dt = 0; dt < 4; ++dt) { const bf16x8 a0 = lds2x4(vp + dt * (32 * 136) + 32 * s2), a1 = lds2x4(vp + dt * (32 * 136) + 64 + 32 * s2);
            o[dt] = MFMA32(a0, pb0, o[dt]); o[dt] = MFMA32(a1, pb1, o[dt]); } }
}

template <int MODE>
DI void attn_branch(unsigned char* smem, const bf16_t* kb  , const bf16_t* vt  , unsigned need, unsigned mymask,
                    int t0w, int tq, int r, int hh, const bf16x8 (&qf)[8], const float* lutH, f32x16 (&o)[4], float& m, float& l) {
    int tid = threadIdx.x; asm volatile("" : "+v"(tid));
    if (need == 0u) return;
    u32x4 kreg[2], vreg[2];
    const int krow0 = tid >> 4, kcc = tid & 15, vd0 = tid >> 3, vcc = tid & 7;
#define AB_LOAD(j) do { _Pragma("unroll") for (int e = 0; e < 2; ++e) { \
        kreg[e] = *(const u32x4*)(kb + (size_t)(64 * (j) + krow0 + 32 * e) * NPROJ + kcc * 8); \
        vreg[e] = *(const u32x4*)(vt + (size_t)(vd0 + 64 * e) * TT + 64 * (j) + vcc * 8); } } while (0)
#define AB_STORE(buf) do { unsigned char* bp_ = smem + A_STG + (buf) * A_BUF; _Pragma("unroll") for (int e = 0; e < 2; ++e) { \
        *(u32x4*)(bp_ + (krow0 + 32 * e) * 272 + kcc * 16) = kreg[e]; \
        unsigned char* vp_ = bp_ + A_VOFF + (vd0 + 64 * e) * 136 + vcc * 16; \
        *(u32x2*)vp_ = (u32x2){vreg[e].x, vreg[e].y}; *(u32x2*)(vp_ + 8) = (u32x2){vreg[e].z, vreg[e].w}; } } while (0)
    int j = __builtin_ctz(need); need &= need - 1u;
    AB_LOAD(j); AB_STORE(0);
    __syncthreads();
    int n = 0;
    for (;;) {
        const bool has_next = need != 0u;
        int jn = 0;
        if (has_next) { jn = __builtin_ctz(need); need &= need - 1u; AB_LOAD(jn); }
        const unsigned char* bp = smem + A_STG + (n & 1) * A_BUF;
        const bool bit = MODE == 0 ? ((mymask >> j) & 1u) : true;
        const bool any = MODE == 0 ? (__ballot(bit) != 0ull) : true;
        const bool far64 = any && (64 * j + 63 + 128 <= t0w) && (MODE == 0 || 64 * j >= t0w + 31 - 511);
        if (far64) attn_tile64_far<MODE>(bp, r, hh, bit, qf, lutH, o, m, l);
        else {
#pragma unroll 1
        for (int half = 0; half < 2; ++half) { const int k0 = 64 * j + 32 * half;
            bool act = any && (k0 <= t0w + 31);
            if (MODE == 1) act = act && (k0 + 31 + 511 >= t0w);
            const bool far = (k0 + 31 + 128 <= t0w) && (MODE == 0 || k0 >= t0w + 31 - 511);
            if (act) { if (far) attn_tile<MODE, true>(bp + half * (32 * 272), bp + A_VOFF + half * 64, k0, tq, r, hh, bit, qf, lutH, o, m, l);
                       else attn_tile<MODE, false>(bp + half * (32 * 272), bp + A_VOFF + half * 64, k0, tq, r, hh, bit, qf, lutH, o, m, l); } }
        }
        if (has_next) AB_STORE((n + 1) & 1);
        __syncthreads();
        if (!has_next) break;
        j = jn; ++n;
    }
#undef AB_LOAD
#undef AB_STORE
}

DI void attn_item(const Params& P, int item, unsigned char* smem) {
    int tid_ = threadIdx.x; asm volatile("" : "+v"(tid_));
    unsigned char* ws = P.ws; const int tid = tid_, wid = tid >> 6, lane = tid & 63, r = lane & 31, hh = lane >> 5;
    const int bg = item & 15, qt = 31 - (item >> 4), b = bg >> 1, g = bg & 1, t0 = qt * 64;
    const int hg = wid >> 1, t0w = t0 + 32 * (wid & 1), tq = t0w + r, head = g * 4 + hg, qloc = 32 * (wid & 1) + r;
    if (__builtin_amdgcn_readfirstlane(wid) < 4) __builtin_amdgcn_s_setprio(3); else __builtin_amdgcn_s_setprio(0);
    const bf16_t* proj = (const bf16_t*)(ws + WS_PROJ);
    float* outs = (float*)(ws + WS_OUTS) + ((size_t)blockIdx.x * 8 + wid) * 4096;
    float* impM = (float*)(smem + A_IMPM); float* impS = (float*)(smem + A_IMPS); float* impv = (float*)(smem + A_IMPV);
    float* lut = (float*)(smem + A_LUT); unsigned* selm = (unsigned*)(smem + A_SELM);
    for (int i = tid; i < 1024; i += 512) { const int h4 = i >> 8, n = i & 255; int bk;
        if (n < 16) bk = n; else { bk = 16 + (int)(logf((float)n / 16.0f) / 2.0794415416798357f * 16.0f); bk = bk > 31 ? 31 : bk; }
        lut[i] = P.in[15][bk * 8 + g * 4 + h4] * 1.4426950408889634f; }
    { const bf16_t* kcb = (const bf16_t*)(ws + WS_KCB) + (size_t)bg * 16384; const bf16_t* vcbt = (const bf16_t*)(ws + WS_VCBT) + (size_t)bg * 16384;
#pragma unroll
      for (int e = 0; e < 4; ++e) { const int id = tid + 512 * e, row = id >> 4, cc = id & 15;
          *(u32x4*)(smem + A_STG + row * 272 + cc * 16) = *(const u32x4*)(kcb + row * 128 + cc * 8);
          *(u32x4*)(smem + A_STG + A_BUF + row * 272 + cc * 16) = *(const u32x4*)(vcbt + row * 128 + cc * 8); } }
    bf16x8 qf[8];
    { const bf16_t* qrow = proj + (size_t)(b * TT + tq) * NPROJ + head * 128 + 8 * hh;
#pragma unroll
      for (int kk = 0; kk < 8; ++kk) qf[kk] = *(const bf16x8*)(qrow + 16 * kk); }
    __syncthreads();
    const float* lutH = lut + hg * 256;
    f32x16 oc[4];
    {
        const unsigned char* kl = smem + A_STG + r * 272 + 16 * hh;
        const unsigned char* vl = smem + A_STG + A_BUF + r * 272 + 8 * hh;
        float mx = NEGF, sum = 0.f;
#pragma unroll 1
        for (int kt = 0; kt < 4; ++kt) {
            f32x16 sc;
#pragma unroll
            for (int i = 0; i < 16; ++i) sc[i] = 0.f;
#pragma unroll
            for (int kk = 0; kk < 8; ++kk) { const bf16x8 a = *(const bf16x8*)(kl + kt * (32 * 272) + 32 * kk); sc = MFMA32(a, qf[kk], sc); }
            float tmax = NEGF;
#pragma unroll
            for (int i = 0; i < 16; ++i) { const int c = 32 * kt + crow(i, hh), dist = tq - (16 * c + 31);
                const int di = dist < 0 ? 0 : (dist > 255 ? 255 : dist);
                const float v = sc[i] * QK_C1 + lutH[di];
                sc[i] = (dist >= 0 && c < 127) ? v : NEGF; tmax = fmaxf(tmax, sc[i]); }
            tmax = xor32_max(tmax);
            const float mnew = fmaxf(mx, tmax); float ps = 0.f;
#pragma unroll
            for (int i = 0; i < 16; ++i) ps += (sc[i] > -1e29f) ? __builtin_amdgcn_exp2f(sc[i] - mnew) : 0.f;
            ps = xor32_sum(ps);
            sum = sum * __builtin_amdgcn_exp2f(mx - mnew) + ps; mx = mnew;
        }
        const float inv = 1.0f / fmaxf(sum, 1e-30f);
#pragma unroll
        for (int dt = 0; dt < 4; ++dt)
#pragma unroll
            for (int i = 0; i < 16; ++i) oc[dt][i] = 0.f;
#pragma unroll 1
        for (int kt = 0; kt < 4; ++kt) {
            f32x16 sc;
#pragma unroll
            for (int i = 0; i < 16; ++i) sc[i] = 0.f;
#pragma unroll
            for (int kk = 0; kk < 8; ++kk) { const bf16x8 a = *(const bf16x8*)(kl + kt * (32 * 272) + 32 * kk); sc = MFMA32(a, qf[kk], sc); }
#pragma unroll
            for (int i = 0; i < 16; ++i) { const int c = 32 * kt + crow(i, hh), dist = tq - (16 * c + 31);
                const int di = dist < 0 ? 0 : (dist > 255 ? 255 : dist);
                const float v = sc[i] * QK_C1 + lutH[di];
                sc[i] = (dist >= 0 && c < 127) ? __builtin_amdgcn_exp2f(v - mx) * inv : 0.f; }
#pragma unroll
            for (int gi = 0; gi < 4; ++gi) { const int jb = 8 * kt + 2 * gi + hh; const float p3 = 0.5f * sc[4 * gi + 3];
                impM[(hg * 64 + qloc) * 33 + jb] = sc[4 * gi] + sc[4 * gi + 1] + sc[4 * gi + 2] + p3;
                impS[(hg * 64 + qloc) * 33 + jb] = p3; }
#pragma unroll
            for (int s2 = 0; s2 < 2; ++s2) { const bf16x8 pb = packp(sc, s2);
#pragma unroll
                for (int dt = 0; dt < 4; ++dt) { const bf16x8 a = lds2x4(vl + dt * (32 * 272) + 64 * kt + 32 * s2); oc[dt] = MFMA32(a, pb, oc[dt]); } }
        }
    }
    __syncthreads();
#pragma unroll 1
    for (int e = 0; e < 4; ++e) { const int idx = tid + 512 * e, qq = idx >> 5, j = idx & 31, t = t0 + qq, cur = t >> 6;
        float v = 0.f;
#pragma unroll
        for (int h = 0; h < 4; ++h) { v += impM[(h * 64 + qq) * 33 + j]; if (j > 0) v += impS[(h * 64 + qq) * 33 + j - 1]; }
        const bool forced = (j == 0) || (j == cur) || (j == cur - 1);
        impv[idx] = forced ? 1e6f : (j <= cur ? v : -1e9f); }
    __syncthreads();
#pragma unroll 1
    for (int e = 0; e < 4; ++e) { const int idx = tid + 512 * e, qq = idx >> 5, j = idx & 31;
        const float my = impv[idx]; int rank = 0;
#pragma unroll 8
        for (int j2 = 0; j2 < 32; ++j2) { const float o2 = impv[qq * 32 + j2]; rank += (o2 > my || (o2 == my && j2 < j)) ? 1 : 0; }
        const unsigned long long bal = __ballot(rank < 16);
        if (lane == 0) selm[qq] = (unsigned)bal; if (lane == 32) selm[qq] = (unsigned)(bal >> 32); }
    __syncthreads();
    float gc, gs, gw;
    { const bf16_t* gp = proj + (size_t)(b * TT + tq) * NPROJ + C_GATE + head * 3;
      gc = sigmoidf_(bf2f(gp[0])); gs = sigmoidf_(bf2f(gp[1])); gw = sigmoidf_(bf2f(gp[2])); }
    { float* outs1_ = outs + lane; asm volatile("" : "+v"(outs1_)); GAS float* outs1 = (GAS float*)outs1_;
#pragma unroll
    for (int dt = 0; dt < 4; ++dt)
#pragma unroll
        for (int i = 0; i < 16; ++i) outs1[(dt * 16 + i) * 64] = gc * oc[dt][i]; }
    const unsigned mymask = selm[qloc];
    unsigned uni = selm[lane];
#pragma unroll
    for (int o_ = 32; o_ >= 1; o_ >>= 1) uni |= (unsigned)__shfl_xor((int)uni, o_);
    uni = __builtin_amdgcn_readfirstlane(uni);
    f32x16 o[4]; float m, l;
    {
#pragma unroll
        for (int dt = 0; dt < 4; ++dt)
#pragma unroll
            for (int i = 0; i < 16; ++i) o[dt][i] = 0.f;
        m = NEGF; l = 0.f;
        const bf16_t* kb = proj + (size_t)(b * TT) * NPROJ + C_KS + g * 128;
        const bf16_t* vt = (const bf16_t*)(ws + WS_VTS) + (size_t)bg * 128 * TT;
        const unsigned need = uni & (qt == 31 ? 0xffffffffu : ((1u << (qt + 1)) - 1u));
        attn_branch<0>(smem, kb, vt, need, mymask, t0w, tq, r, hh, qf, lutH, o, m, l);
        const float sc = gs / fmaxf(l, 1e-30f);
        float* outs2_ = outs + lane; asm volatile("" : "+v"(outs2_)); GAS float* outs2 = (GAS float*)outs2_;
        f32x16 pv[4];
#pragma unroll
        for (int dt = 0; dt < 4; ++dt)
#pragma unroll
            for (int i = 0; i < 16; ++i) pv[dt][i] = outs2[(dt * 16 + i) * 64];
        __builtin_amdgcn_sched_barrier(0);
#pragma unroll
        for (int dt = 0; dt < 4; ++dt)
#pragma unroll
            for (int i = 0; i < 16; ++i) outs2[(dt * 16 + i) * 64] = pv[dt][i] + sc * o[dt][i];
    }
    {
#pragma unroll
        for (int dt = 0; dt < 4; ++dt)
#pragma unroll
            for (int i = 0; i < 16; ++i) o[dt][i] = 0.f;
        m = NEGF; l = 0.f;
        const bf16_t* kb = proj + (size_t)(b * TT) * NPROJ + C_KW + g * 128;
        const bf16_t* vt = (const bf16_t*)(ws + WS_VTW) + (size_t)bg * 128 * TT;
        const int jlo = qt >= 8 ? qt - 8 : 0;
        const unsigned need = (qt == 31 ? 0xffffffffu : ((1u << (qt + 1)) - 1u)) & ~((1u << jlo) - 1u);
        attn_branch<1>(smem, kb, vt, need, 0u, t0w, tq, r, hh, qf, lutH, o, m, l);
        const float sc = gw / fmaxf(l, 1e-30f);
        float* outs3_ = outs + lane; asm volatile("" : "+v"(outs3_)); GAS float* outs3 = (GAS float*)outs3_;
        bf16_t* as = (bf16_t*)(ws + WS_AS) + (size_t)(b * TT + tq) * DM + head * 128;
        f32x16 pv[4];
#pragma unroll
        for (int dt = 0; dt < 4; ++dt)
#pragma unroll
            for (int i = 0; i < 16; ++i) pv[dt][i] = outs3[(dt * 16 + i) * 64];
        __builtin_amdgcn_sched_barrier(0);
#pragma unroll
        for (int dt = 0; dt < 4; ++dt)
#pragma unroll
            for (int gi = 0; gi < 4; ++gi) { float v[4];
#pragma unroll
                for (int j = 0; j < 4; ++j) { const int i = 4 * gi + j; v[j] = pv[dt][i] + sc * o[dt][i]; }
                u32x2 w; w.x = pk2(v[0], v[1]); w.y = pk2(v[2], v[3]);
                *(u32x2*)(as + 32 * dt + 8 * gi + 4 * hh) = w; }
    }
    __builtin_amdgcn_s_setprio(0);
}

DI void fill_rstd(const pg8::StaticOrder& S, const float* ss, unsigned char* smem) {
    float* rl = (float*)(smem + 131072);
    for (int i = 0; i < 16; ++i) { pg8::Unit u; if (!S.next(i, u)) break;
        if (threadIdx.x < 256) rl[i * 256 + threadIdx.x] = 1.0f / sqrtf(ss[u.pm * 256 + threadIdx.x] * (1.0f / DM) + EPSN); }
    __syncthreads();
}

#define XB_TMO      128
#define XB_XCNT(j)  (256  + 64 * (j))
#define XB_XSUB(j)  (1280 + 64 * (j))
#define XB_XGEN(j)  (2304 + 64 * (j))
#define XB_TOP      3328
#define XB_TOPGEN   3392
#define XCD_BAR_WORDS 3456
#define XB_SPIN_CAP (1u << 18)
DI unsigned xb_ld(unsigned* p)              { return __hip_atomic_load(p, __ATOMIC_RELAXED, __HIP_MEMORY_SCOPE_AGENT); }
DI unsigned xb_add(unsigned* p, unsigned v) { return __hip_atomic_fetch_add(p, v, __ATOMIC_RELAXED, __HIP_MEMORY_SCOPE_AGENT); }
DI unsigned xb_xcc_id() { return (unsigned)__builtin_amdgcn_s_getreg((3 << 11) | 20) & 0xFu; }
#define XB_SPIN(cond, bar) do { unsigned _sp = 0; while (cond) { __builtin_amdgcn_s_sleep(1); \
    if ((++_sp & 255u) == 0u) { if (xb_ld(&(bar)[XB_TMO])) break; if (_sp > XB_SPIN_CAP) { atomicAdd(&(bar)[XB_TMO], 1u); break; } } } } while (0)
struct XcdBarrier { unsigned* bar; unsigned x; volatile LAS unsigned* st; };
DI XcdBarrier xcd_barrier_post(unsigned* bar, volatile LAS unsigned* st) {
    XcdBarrier b; b.bar = bar; b.x = xb_xcc_id(); b.st = st;
    if (threadIdx.x == 0) (void)xb_add(&bar[XB_XCNT(b.x)], 1u);
    return b;
}
DI void xcd_barrier_complete(unsigned* bar, unsigned x, unsigned& nloc, unsigned& nx) {
    const unsigned G = gridDim.x * gridDim.y * gridDim.z;
    unsigned sum, cnt, mine, sp = 0u;
    for (;;) {
        sum = 0u; cnt = 0u; mine = 0u;
#pragma unroll
        for (unsigned j = 0; j < 16; ++j) { const unsigned c = xb_ld(&bar[XB_XCNT(j)]); sum += c; cnt += (c > 0u) ? 1u : 0u; mine = (j == x) ? c : mine; }
        if (sum == G) break;
        __builtin_amdgcn_s_sleep(1);
        if ((++sp & 255u) == 0u) { if (xb_ld(&bar[XB_TMO])) break; if (sp > XB_SPIN_CAP) { atomicAdd(&bar[XB_TMO], 1u); break; } }
    }
    nloc = mine > 0u ? mine : 1u; nx = cnt > 0u ? cnt : 1u;
}
DI void xcd_barrier(const XcdBarrier& b) {
    asm volatile("s_waitcnt vmcnt(0)" ::: "memory");
    __syncthreads();
    if (threadIdx.x == 0) {
        unsigned* bar = b.bar;
        __builtin_amdgcn_s_waitcnt(0);
        unsigned nloc = b.st[0], nx = b.st[1];
        if (nloc == 0u) { xcd_barrier_complete(bar, b.x, nloc, nx); b.st[0] = nloc; b.st[1] = nx; }
        const unsigned old = xb_add(&bar[XB_XSUB(b.x)], 1u);
        const unsigned gen = old / nloc;
        if (old + 1u == (gen + 1u) * nloc) {
            __builtin_amdgcn_fence(__ATOMIC_RELEASE, "agent");
            asm volatile("s_waitcnt vmcnt(0)" ::: "memory");
            const unsigned og = xb_add(&bar[XB_TOP], 1u);
            const unsigned tg = og / nx;
            if (og + 1u == (tg + 1u) * nx) xb_add(&bar[XB_TOPGEN], 1u);
            else XB_SPIN(xb_ld(&bar[XB_TOPGEN]) == tg, bar);
            __builtin_amdgcn_fence(__ATOMIC_ACQUIRE, "agent");
            xb_add(&bar[XB_XGEN(b.x)], 1u);
            asm volatile("s_waitcnt vmcnt(0)" ::: "memory");
        } else {
            XB_SPIN(xb_ld(&bar[XB_XGEN(b.x)]) == gen, bar);
            __builtin_amdgcn_fence(__ATOMIC_ACQUIRE, "agent");
            asm volatile("s_waitcnt vmcnt(0)" ::: "memory");
        }
    }
    __syncthreads();
}

__global__ void __launch_bounds__(512, 2) hymba_fwd(Params P) {
    extern __shared__ __attribute__((aligned(16))) unsigned char shm[];
    cg::grid_group grid = cg::this_grid();
    unsigned char* ws = P.ws;
    LAS unsigned char* lds = (LAS unsigned char*)shm;
    const int tid = threadIdx.x, G = gridDim.x;
    float* hres = P.out;
    const int lo = P.ph_lo, hi = P.ph_hi;
    volatile LAS unsigned* xbst = (volatile LAS unsigned*)(lds + L_CUR + 16);
    if (tid == 0) { xbst[0] = 0u; xbst[1] = 0u; }
    __syncthreads();
    const XcdBarrier xbar = xcd_barrier_post((unsigned*)((float*)(ws + WS_SMALL) + SM_BAR), xbst);
#define IN(k) (lo <= (k) && (k) < hi)
#define SYNC(k) do { if (IN(k) && IN((k) + 1)) { if (hi > 1000) grid.sync(); else xcd_barrier(xbar); } } while (0)
#ifndef DUP_PH
#define DUP_PH -1
#endif
#define REP(k) for (int rep_ = 0; rep_ < ((k) == DUP_PH ? 2 : 1); ++rep_, (((k) == DUP_PH && rep_ == 1) ? grid.sync() : (void)0))
    if (IN(0)) REP(0) phase_prep(P, shm);
    SYNC(0);
    if (IN(1)) REP(1) { pg8::Gemm g{(const bf16_t*)(ws + WS_XN), (const bf16_t*)(ws + WS_W13A), MTOK, 2 * DFF, DM};
        pg8::StaticOrder S; S.init(MTOK, 2 * DFF, G, (int)blockIdx.x); EpiSwiGLU E{(bf16_t*)(ws + WS_H), nullptr};
        pg8::gemm_phase<EpiSwiGLU, pg8::StaticOrder>(lds, g, S, E); }
    SYNC(1);
    if (IN(2)) REP(2) { pg8::Gemm g{(const bf16_t*)(ws + WS_H), (const bf16_t*)(ws + WS_W2A), MTOK, DM, DFF};
        pg8::StaticOrder S; S.init(MTOK, DM, G, (int)blockIdx.x); EpiResid<0> E{P.in[0], nullptr, nullptr, (bf16_t*)hres, (float*)(ws + WS_SMALL) + SM_SS, 0.5f};
        pg8::gemm_phase<EpiResid<0>, pg8::StaticOrder>(lds, g, S, E); }
    if (IN(2) && hi > 3) xcd_barrier(xbar);
    if (IN(4)) REP(4) {
        if (blockIdx.x == 0 && tid < 256) { float* sm = (float*)(ws + WS_SMALL); const int which = tid >> 7, n = tid & 127; float s = P.in[which ? 13 : 9][n];
            for (int c = 0; c < 128; ++c) s += sm[SM_CBP + (which * 128 + c) * 128 + n];
            sm[SM_CB1 + which * 128 + n] = s; }
        pg8::Gemm g{(const bf16_t*)hres, (const bf16_t*)(ws + WS_WIN), MTOK, NPROJ, DM};
        pg8::StaticOrder S; S.init(MTOK, NPROJ, G, (int)blockIdx.x); EpiProj E{(bf16_t*)(ws + WS_PROJ), (const float*)(ws + WS_SMALL) + SM_SS, (bf16_t*)(ws + WS_VTS), (bf16_t*)(ws + WS_VTW)}; fill_rstd(S, E.ss, shm);
        pg8::gemm_phase<EpiProj, pg8::StaticOrder>(lds, g, S, E); }
    SYNC(4);
    if (IN(5)) REP(5) {
        for (int it = blockIdx.x; it < 254 + 2048; it += G) {
            if (it < 254) compress_item(P, it, shm);
            else { s5_pass1_item(P, it - 254, shm); __syncthreads(); }
        } }
    SYNC(5);
    if (IN(6)) REP(6) {
        int* ctr = (int*)((float*)(ws + WS_SMALL) + SM_CTR) + rep_;
        volatile int* curw = (volatile int*)(shm + L_CUR);
        for (int it = blockIdx.x; it < 2048; it += G) { s5_pass3_item(P, it, shm); __syncthreads(); }
        for (;;) {
            __syncthreads();
            if (tid == 0) *curw = atomicAdd(ctr, 1);
            __syncthreads();
            const int it = *curw;
            if (it >= 512) break;
            attn_item(P, it, shm);
        } }
    SYNC(6);
    if (IN(7)) REP(7) { pg8::Gemm g{(const bf16_t*)(ws + WS_HG), (const bf16_t*)(ws + WS_GLUW), MTOK, 1024, 1024};
        pg8::StaticOrder S; S.init(MTOK, 1024, G, (int)blockIdx.x); EpiGLU E{(const bf16_t*)(ws + WS_HG), P.in[25], (bf16_t*)(ws + WS_AS)};
        pg8::gemm_phase<EpiGLU, pg8::StaticOrder>(lds, g, S, E); }
    SYNC(7);
    if (IN(8)) REP(8) { pg8::Gemm g{(const bf16_t*)(ws + WS_AS), (const bf16_t*)(ws + WS_WOUT), MTOK, DM, DM};
        pg8::StaticOrder S; S.init(MTOK, DM, G, (int)blockIdx.x); EpiResid<1> E{nullptr, (const bf16_t*)hres, nullptr, (bf16_t*)(ws + WS_XN), (float*)(ws + WS_SMALL) + SM_SS + 16384, 1.0f};
        pg8::gemm_phase<EpiResid<1>, pg8::StaticOrder>(lds, g, S, E); }
    if (IN(8) && hi > 9) xcd_barrier(xbar);
    if (IN(10)) REP(10) { pg8::Gemm g{(const bf16_t*)(ws + WS_XN), (const bf16_t*)(ws + WS_W13B), MTOK, 2 * DFF, DM};
        pg8::StaticOrder S; S.init(MTOK, 2 * DFF, G, (int)blockIdx.x); EpiSwiGLU E{(bf16_t*)(ws + WS_H), (const float*)(ws + WS_SMALL) + SM_SS + 16384}; fill_rstd(S, E.ss, shm);
        pg8::gemm_phase<EpiSwiGLU, pg8::StaticOrder>(lds, g, S, E); }
    SYNC(10);
    if (IN(11)) REP(11) { pg8::Gemm g{(const bf16_t*)(ws + WS_H), (const bf16_t*)(ws + WS_W2B), MTOK, DM, DFF};
        pg8::StaticOrder S; S.init(MTOK, DM, G, (int)blockIdx.x); EpiResid<2> E{nullptr, (const bf16_t*)(ws + WS_XN), hres, nullptr, nullptr, 0.5f};
        pg8::gemm_phase<EpiResid<2>, pg8::StaticOrder>(lds, g, S, E); }
    SYNC(11);
    if (IN(12)) REP(12) norm_rows(hres, P.in[31], nullptr, hres);
}

#ifndef N_LAUNCH_MODE
#define N_LAUNCH_MODE 0
#endif

extern "C" void kernel_launch(void* const* d_in, const int* in_sizes, int n_in, void* d_out, int out_size, void* d_ws, size_t ws_size, hipStream_t stream) {
    static int grid = 0;
    if (grid == 0) {
        int dev = 0, cus = 0, per_cu = 0;
        hipGetDevice(&dev);
        hipDeviceGetAttribute(&cus, hipDeviceAttributeMultiprocessorCount, dev);
        hipFuncSetAttribute((const void*)hymba_fwd, hipFuncAttributeMaxDynamicSharedMemorySize, LDS_BYTES);
        hipOccupancyMaxActiveBlocksPerMultiprocessor(&per_cu, (const void*)hymba_fwd, 512, LDS_BYTES);
        if (per_cu < 1) { fprintf(stderr, "occupancy query says %d blocks/CU\n", per_cu); per_cu = 1; }
        (void)hipGetLastError();
        grid = cus * 1;
        if (n_in != 32 || ws_size < WS_END) fprintf(stderr, "kernel_launch: unexpected n_in %d / ws %zu\n", n_in, ws_size);
    }
    Params p{};
    for (int i = 0; i < 32; ++i) p.in[i] = (const float*)d_in[i];
    p.out = (float*)d_out; p.ws = (unsigned char*)d_ws;
    (void)hipMemsetAsync((unsigned char*)d_ws + WS_SMALL + (size_t)SM_BAR * 4, 0, XCD_BAR_WORDS * 4, stream);
#if N_LAUNCH_MODE == 0
    p.ph_lo = 0; p.ph_hi = NPH;
    { void* args[] = {&p};
      hipError_t e = hipLaunchCooperativeKernel((const void*)hymba_fwd, dim3(grid), dim3(512), args, LDS_BYTES, stream);
      if (e != hipSuccess) fprintf(stderr, "cooperative launch failed: %s (grid %d)\n", hipGetErrorString(e), grid); }
#else
    for (int ph = 0; ph < NPH; ++ph) { p.ph_lo = ph; p.ph_hi = ph + 1;
        void* args[] = {&p};
        hipError_t e = hipLaunchCooperativeKernel((const void*)hymba_fwd, dim3(grid), dim3(512), args, LDS_BYTES, stream);
        if (e != hipSuccess) fprintf(stderr, "launch %d failed: %s (grid %d)\n", ph, hipGetErrorString(e), grid); }
#endif
}
```
